# Optimizing an MI355X kernel written in HIP

```python
import jax, jax.numpy as jnp
from jax import lax
import numpy as np

D_MODEL = 1024
BATCH = 2
SEQ = 8192
DEPTH = 4
DEC_BATCH = 128
DEC_SEQ = 1
PAST_LEN = 8192
PAGE_SIZE = 128

EPS = 1e-6
N_MIXERS = 4
N_RET = len(range(0, DEPTH, N_MIXERS))
N_SWA = len(range(1, DEPTH, N_MIXERS))
N_CONV = len(range(2, DEPTH, N_MIXERS))
N_POOL = len(range(3, DEPTH, N_MIXERS))
RET_HEADS = 4
RET_DK = D_MODEL // RET_HEADS
RET_DV = 2 * D_MODEL // RET_HEADS
RET_CHUNK = 128
RET_THETA = 10000.0
SWA_HEADS = 16
SWA_KV_HEADS = 4
SWA_HEAD_DIM = D_MODEL // SWA_HEADS
SWA_GROUP = SWA_HEADS // SWA_KV_HEADS
WINDOW = 128
SWA_BLOCK = WINDOW
ROPE_THETA = 500000.0
ROPE_DIM = SWA_HEAD_DIM // 4
CONV_WIDTH = 3
POOL_WINDOWS = (2, 4, 8, 16)
POOL_GROUPS = len(POOL_WINDOWS)
POOL_GROUP_DIM = D_MODEL // POOL_GROUPS
POOL_BUF = max(POOL_WINDOWS) - 1
N_MEM = 256
XATTN_HEADS = 4
XATTN_HEAD_DIM = D_MODEL // XATTN_HEADS
D_FF = ((8 * D_MODEL + 3 * 256 - 1) // (3 * 256)) * 256
WINDOW_BUF = min(WINDOW, PAST_LEN)

kernel_name = "hybrid_retention_swa_conv_pool_step"


def rmsnorm(x, g):
    xf = x.astype(jnp.float32)
    y = xf * lax.rsqrt(jnp.mean(xf * xf, axis=-1, keepdims=True) + EPS)
    return (y * g.astype(jnp.float32)).astype(x.dtype)


def rope(x, pos, rot_dim, theta):
    half = rot_dim // 2
    inv = 1.0 / (theta ** (jnp.arange(half, dtype=jnp.float32) / half))
    ang = pos.astype(jnp.float32)[:, None] * inv[None, :]
    cos = jnp.cos(ang)[None, :, None, :]
    sin = jnp.sin(ang)[None, :, None, :]
    xf = x.astype(jnp.float32)
    x1 = xf[..., :half]
    x2 = xf[..., half:rot_dim]
    out = jnp.concatenate([x1 * cos - x2 * sin, x2 * cos + x1 * sin, xf[..., rot_dim:]], axis=-1)
    return out.astype(x.dtype)


def retention_block(q, k, v, S, log_g):
    C = q.shape[2]
    idx = jnp.arange(C, dtype=jnp.float32)
    diff = idx[:, None] - idx[None, :]
    decay = jnp.where(diff >= 0, jnp.exp(log_g[:, None, None] * jnp.where(diff >= 0, diff, 0.0)), 0.0)
    inner = jnp.einsum('bhld,bhmd->bhlm', q, k) * decay[None]
    q_dec = q * jnp.exp(log_g[:, None] * (idx + 1.0)[None, :])[None, :, :, None]
    o = jnp.einsum('bhlm,bhmv->bhlv', inner, v) + jnp.einsum('bhld,bhdv->bhlv', q_dec, S)
    k_dec = k * jnp.exp(log_g[:, None] * (C - 1.0 - idx)[None, :])[None, :, :, None]
    S_new = jnp.exp(log_g * C)[None, :, None, None] * S + jnp.einsum('bhld,bhlv->bhdv', k_dec, v)
    return o, S_new


def retention_mix(h, pos, S0, w_in, w_out, chunk):
    B, L, _ = h.shape
    q, k, v, g = jnp.split(h @ w_in, [D_MODEL, 2 * D_MODEL, 4 * D_MODEL], axis=-1)
    q = rope(q.reshape(B, L, RET_HEADS, RET_DK), pos, RET_DK, RET_THETA)
    k = rope(k.reshape(B, L, RET_HEADS, RET_DK), pos, RET_DK, RET_THETA) * (RET_DK ** -0.5)
    v = v.reshape(B, L, RET_HEADS, RET_DV)
    log_g = jnp.log1p(-jnp.exp2(-5.0 - jnp.arange(RET_HEADS, dtype=jnp.float32)))
    nc = L // chunk

    def to_chunks(t):
        return t.astype(jnp.float32).reshape(B, nc, chunk, RET_HEADS, -1).transpose(1, 0, 3, 2, 4)

    def step(S, qkv):
        o, S = retention_block(qkv[0], qkv[1], qkv[2], S, log_g)
        return S, o

    S_fin, o = lax.scan(step, S0.astype(jnp.float32), (to_chunks(q), to_chunks(k), to_chunks(v)))
    o = o.transpose(1, 0, 3, 2, 4).reshape(B, L, RET_HEADS, RET_DV)
    mu = jnp.mean(o, axis=-1, keepdims=True)
    var = jnp.mean(jnp.square(o - mu), axis=-1, keepdims=True)
    o = ((o - mu) * lax.rsqrt(var + EPS)).reshape(B, L, 2 * D_MODEL).astype(h.dtype)
    y = (jax.nn.silu(g) * o) @ w_out
    return y, S_fin.astype(h.dtype)


def sink_attend(q, k, v, valid, sinks):
    Z, T = q.shape[:2]
    qg = q.reshape(Z, T, SWA_KV_HEADS, SWA_GROUP, SWA_HEAD_DIM)
    s = jnp.einsum('ztkgd,zskd->zkgts', qg, k, preferred_element_type=jnp.float32) * (SWA_HEAD_DIM ** -0.5)
    s = jnp.where(valid[:, None, None], s, -jnp.inf)
    sink = jnp.broadcast_to(sinks.astype(jnp.float32).reshape(1, SWA_KV_HEADS, SWA_GROUP, 1, 1), s.shape[:-1] + (1,))
    p = jax.nn.softmax(jnp.concatenate([s, sink], axis=-1), axis=-1)[..., :-1]
    o = jnp.einsum('zkgts,zskd->ztkgd', p.astype(v.dtype), v)
    return o.reshape(Z, T, SWA_HEADS * SWA_HEAD_DIM)


def swa_project(h, pos, w_qkv):
    B, L, _ = h.shape
    q, k, v = jnp.split(h @ w_qkv, [SWA_HEADS * SWA_HEAD_DIM, (SWA_HEADS + SWA_KV_HEADS) * SWA_HEAD_DIM], axis=-1)
    q = rope(q.reshape(B, L, SWA_HEADS, SWA_HEAD_DIM), pos, ROPE_DIM, ROPE_THETA)
    k = rope(k.reshape(B, L, SWA_KV_HEADS, SWA_HEAD_DIM), pos, ROPE_DIM, ROPE_THETA)
    v = v.reshape(B, L, SWA_KV_HEADS, SWA_HEAD_DIM)
    return q, k, v


def swa_prompt(h, w_qkv, w_o, sinks):
    B, L, _ = h.shape
    q, k, v = swa_project(h, jnp.arange(L), w_qkv)
    nb = L // SWA_BLOCK

    def band(t):
        tb = t.reshape(B, nb, SWA_BLOCK, SWA_KV_HEADS, SWA_HEAD_DIM)
        prev = jnp.concatenate([jnp.zeros_like(tb[:, :1]), tb[:, :-1]], axis=1)
        return jnp.concatenate([prev, tb], axis=2).reshape(B * nb, 2 * SWA_BLOCK, SWA_KV_HEADS, SWA_HEAD_DIM)

    blk = jnp.arange(nb)[:, None] * SWA_BLOCK
    qpos = blk + jnp.arange(SWA_BLOCK)[None, :]
    kpos = blk - SWA_BLOCK + jnp.arange(2 * SWA_BLOCK)[None, :]
    diff = qpos[:, :, None] - kpos[:, None, :]
    valid = (diff >= 0) & (diff <= WINDOW) & (kpos[:, None, :] >= 0)
    valid = jnp.tile(valid, (B, 1, 1))
    o = sink_attend(q.reshape(B * nb, SWA_BLOCK, SWA_HEADS, SWA_HEAD_DIM), band(k), band(v), valid, sinks)
    y = o.reshape(B, L, SWA_HEADS * SWA_HEAD_DIM) @ w_o
    return y, k[:, L - WINDOW_BUF:], v[:, L - WINDOW_BUF:]


def swa_sample(h, kbuf, vbuf, w_qkv, w_o, sinks):
    T = h.shape[1]
    pos = PAST_LEN + jnp.arange(T)
    q, k, v = swa_project(h, pos, w_qkv)
    kk = jnp.concatenate([kbuf.astype(k.dtype), k], axis=1)
    vv = jnp.concatenate([vbuf.astype(v.dtype), v], axis=1)
    kpos = PAST_LEN - WINDOW_BUF + jnp.arange(WINDOW_BUF + T)
    diff = pos[:, None] - kpos[None, :]
    valid = ((diff >= 0) & (diff <= WINDOW))[None]
    y = sink_attend(q, kk, vv, valid, sinks) @ w_o
    return y, kk[:, -WINDOW_BUF:], vv[:, -WINDOW_BUF:]


def conv_mix(h, buf, w_in, w_conv, w_out):
    L = h.shape[1]
    bg, cg, z = jnp.split(h @ w_in, 3, axis=-1)
    c_in = cg * z
    full = jnp.concatenate([buf.astype(c_in.dtype), c_in], axis=1)
    acc = w_conv[0] * full[:, 0:L]
    for j in range(1, CONV_WIDTH):
        acc = acc + w_conv[j] * full[:, j:j + L]
    y = (bg * acc) @ w_out
    return y, full[:, -(CONV_WIDTH - 1):]


def pool_mix(h, buf, pos0, w_grp, scale):
    B, L, _ = h.shape
    hf = h.astype(jnp.float32)
    full = jnp.concatenate([buf.astype(jnp.float32), hf], axis=1)
    cs = jnp.concatenate([jnp.zeros((B, 1, D_MODEL), jnp.float32), jnp.cumsum(full, axis=1)], axis=1)
    end = cs[:, POOL_BUF + 1:POOL_BUF + 1 + L]
    pos = pos0 + jnp.arange(L)
    pooled = []
    for gi, w in enumerate(POOL_WINDOWS):
        sl = slice(gi * POOL_GROUP_DIM, (gi + 1) * POOL_GROUP_DIM)
        start = cs[:, POOL_BUF + 1 - w:POOL_BUF + 1 - w + L, sl]
        cnt = jnp.minimum(pos + 1, w).astype(jnp.float32)[None, :, None]
        pooled.append((end[..., sl] - start) / cnt)
    d = (jnp.concatenate(pooled, axis=-1) - hf).reshape(B, L, POOL_GROUPS, POOL_GROUP_DIM).astype(h.dtype)
    y = jnp.einsum('blgc,gcd->blgd', d, w_grp).reshape(B, L, D_MODEL) * scale
    return y, full[:, -POOL_BUF:].astype(h.dtype)


def mem_kv(mem, g_mem, w_kv):
    B = mem.shape[0]
    k, v = jnp.split(rmsnorm(mem, g_mem) @ w_kv, 2, axis=-1)
    return (k.reshape(B, N_MEM, XATTN_HEADS, XATTN_HEAD_DIM), v.reshape(B, N_MEM, XATTN_HEADS, XATTN_HEAD_DIM))


def mem_attend(h, k, v, w_q, w_o):
    B, L, _ = h.shape
    q = (h @ w_q).reshape(B, L, XATTN_HEADS, XATTN_HEAD_DIM)
    s = jnp.einsum('blhd,bmhd->bhlm', q, k, preferred_element_type=jnp.float32) * (XATTN_HEAD_DIM ** -0.5)
    p = jax.nn.softmax(s, axis=-1)
    o = jnp.einsum('bhlm,bmhd->blhd', p.astype(v.dtype), v).reshape(B, L, D_MODEL)
    return o @ w_o


def swiglu(h, w_in, w_out):
    a, b = jnp.split(h @ w_in, 2, axis=-1)
    return (jax.nn.silu(a) * b) @ w_out


def setup_inputs(seed: int = 0) -> dict:
    key = jax.random.key(seed)
    ks = iter(jax.random.split(key, 32))

    def nrm(shape, scale=1.0):
        return jax.random.normal(next(ks), shape, jnp.float32) * scale

    D = D_MODEL
    return {
        "x_prompt": nrm((BATCH, SEQ, D)),
        "x_sample": nrm((DEC_BATCH, DEC_SEQ, D)),
        "state_ret": nrm((N_RET, DEC_BATCH, RET_HEADS, RET_DK, RET_DV), 0.5),
        "cache_swa_k": nrm((N_SWA, DEC_BATCH, WINDOW_BUF, SWA_KV_HEADS, SWA_HEAD_DIM)),
        "cache_swa_v": nrm((N_SWA, DEC_BATCH, WINDOW_BUF, SWA_KV_HEADS, SWA_HEAD_DIM)),
        "state_conv": nrm((N_CONV, DEC_BATCH, CONV_WIDTH - 1, D)),
        "state_pool": nrm((N_POOL, DEC_BATCH, POOL_BUF, D)),
        "cache_mem_k": nrm((DEPTH, DEC_BATCH, N_MEM, XATTN_HEADS, XATTN_HEAD_DIM)),
        "cache_mem_v": nrm((DEPTH, DEC_BATCH, N_MEM, XATTN_HEADS, XATTN_HEAD_DIM)),
        "mem_prompt": nrm((BATCH, N_MEM, D)),
        "norm_g": 1.0 + nrm((DEPTH, 3, D), 0.1),
        "mem_norm_g": 1.0 + nrm((DEPTH, D), 0.1),
        "final_norm_g": 1.0 + nrm((D,), 0.1),
        "ret_w_in": nrm((N_RET, D, 6 * D), D ** -0.5),
        "ret_w_out": nrm((N_RET, 2 * D, D), (2 * D) ** -0.5),
        "swa_w_qkv": nrm((N_SWA, D, (SWA_HEADS + 2 * SWA_KV_HEADS) * SWA_HEAD_DIM), D ** -0.5),
        "swa_w_o": nrm((N_SWA, SWA_HEADS * SWA_HEAD_DIM, D), (SWA_HEADS * SWA_HEAD_DIM) ** -0.5),
        "swa_sinks": nrm((N_SWA, SWA_HEADS)),
        "conv_w_in": nrm((N_CONV, D, 3 * D), D ** -0.5),
        "conv_w": nrm((N_CONV, CONV_WIDTH, D), CONV_WIDTH ** -0.5),
        "conv_w_out": nrm((N_CONV, D, D), D ** -0.5),
        "pool_w": nrm((N_POOL, POOL_GROUPS, POOL_GROUP_DIM, POOL_GROUP_DIM), POOL_GROUP_DIM ** -0.5),
        "pool_scale": 1.0 + nrm((N_POOL, D), 0.1),
        "xattn_w_q": nrm((DEPTH, D, D), D ** -0.5),
        "xattn_w_kv": nrm((DEPTH, D, 2 * D), D ** -0.5),
        "xattn_w_o": nrm((DEPTH, D, D), D ** -0.5),
        "ffn_w_in": nrm((DEPTH, D, 2 * D_FF), D ** -0.5),
        "ffn_w_out": nrm((DEPTH, D_FF, D), D_FF ** -0.5),
    }


def reference(x_prompt, x_sample, state_ret, cache_swa_k, cache_swa_v, state_conv, state_pool,
              cache_mem_k, cache_mem_v, mem_prompt, norm_g, mem_norm_g, final_norm_g,
              ret_w_in, ret_w_out, swa_w_qkv, swa_w_o, swa_sinks, conv_w_in, conv_w, conv_w_out,
              pool_w, pool_scale, xattn_w_q, xattn_w_kv, xattn_w_o, ffn_w_in, ffn_w_out):
    xp, xs = x_prompt, x_sample
    Bp, Lp, _ = xp.shape
    Bs, Ls, _ = xs.shape
    pos_p = jnp.arange(Lp)
    pos_s = PAST_LEN + jnp.arange(Ls)
    ret_p, ret_s, swk_p, swv_p, swk_s, swv_s = [], [], [], [], [], []
    conv_p, conv_s, pool_p, pool_s, memk_p, memv_p = [], [], [], [], [], []
    for i in range(DEPTH):
        j = i // N_MIXERS
        kind = i % N_MIXERS
        hp = rmsnorm(xp, norm_g[i, 0])
        hs = rmsnorm(xs, norm_g[i, 0])
        if kind == 0:
            S0 = jnp.zeros((Bp, RET_HEADS, RET_DK, RET_DV), jnp.float32)
            yp, sp = retention_mix(hp, pos_p, S0, ret_w_in[j], ret_w_out[j], RET_CHUNK)
            ys, ss = retention_mix(hs, pos_s, state_ret[j], ret_w_in[j], ret_w_out[j], Ls)
            ret_p.append(sp)
            ret_s.append(ss)
        elif kind == 1:
            yp, kp, vp = swa_prompt(hp, swa_w_qkv[j], swa_w_o[j], swa_sinks[j])
            ys, ks_, vs_ = swa_sample(hs, cache_swa_k[j], cache_swa_v[j], swa_w_qkv[j], swa_w_o[j], swa_sinks[j])
            swk_p.append(kp)
            swv_p.append(vp)
            swk_s.append(ks_)
            swv_s.append(vs_)
        elif kind == 2:
            zbuf = jnp.zeros((Bp, CONV_WIDTH - 1, D_MODEL), hp.dtype)
            yp, bp = conv_mix(hp, zbuf, conv_w_in[j], conv_w[j], conv_w_out[j])
            ys, bs = conv_mix(hs, state_conv[j], conv_w_in[j], conv_w[j], conv_w_out[j])
            conv_p.append(bp)
            conv_s.append(bs)
        else:
            zbuf = jnp.zeros((Bp, POOL_BUF, D_MODEL), hp.dtype)
            yp, bp = pool_mix(hp, zbuf, 0, pool_w[j], pool_scale[j])
            ys, bs = pool_mix(hs, state_pool[j], PAST_LEN, pool_w[j], pool_scale[j])
            pool_p.append(bp)
            pool_s.append(bs)
        xp = xp + yp
        xs = xs + ys
        mk, mv = mem_kv(mem_prompt, mem_norm_g[i], xattn_w_kv[i])
        memk_p.append(mk)
        memv_p.append(mv)
        xp = xp + mem_attend(rmsnorm(xp, norm_g[i, 1]), mk, mv, xattn_w_q[i], xattn_w_o[i])
        xs = xs + mem_attend(rmsnorm(xs, norm_g[i, 1]), cache_mem_k[i], cache_mem_v[i], xattn_w_q[i], xattn_w_o[i])
        xp = xp + swiglu(rmsnorm(xp, norm_g[i, 2]), ffn_w_in[i], ffn_w_out[i])
        xs = xs + swiglu(rmsnorm(xs, norm_g[i, 2]), ffn_w_in[i], ffn_w_out[i])
    y_prompt = rmsnorm(xp, final_norm_g)
    y_sample = rmsnorm(xs, final_norm_g)
    return (y_prompt, y_sample,
            jnp.stack(ret_p), jnp.stack(ret_s),
            jnp.stack(swk_p), jnp.stack(swv_p), jnp.stack(swk_s), jnp.stack(swv_s),
            jnp.stack(conv_p), jnp.stack(conv_s),
            jnp.stack(pool_p), jnp.stack(pool_s),
            jnp.stack(memk_p), jnp.stack(memv_p))
```

```cpp
#include <hip/hip_runtime.h>
#include <cstdio>
#include <cstdint>

#ifndef MK_ONE_LAUNCH
#define MK_ONE_LAUNCH 1
#endif

#ifndef DBG_LAST
#define DBG_LAST 1000
#endif
#define GAS __attribute__((address_space(1)))
#define LAS __attribute__((address_space(3)))
typedef unsigned short bf16;
typedef short bf16x8 __attribute__((ext_vector_type(8)));
typedef float f32x4 __attribute__((ext_vector_type(4)));
typedef float f32x2 __attribute__((ext_vector_type(2)));
typedef unsigned u32x4 __attribute__((ext_vector_type(4)));
typedef unsigned u32x2 __attribute__((ext_vector_type(2)));

constexpr int D = 1024, TP = 8192, MP = 2 * TP, NSMP = 128, MREAL = MP + NSMP, MT = MP + 256, NPAN = MT / 256;
constexpr int DFF = 2816;
constexpr float EPS = 1e-6f;
constexpr float LOG2E = 1.4426950408889634f;
__device__ __forceinline__ float lg2g(int h) { return h == 0 ? -0.04580368961312479f : h == 1 ? -0.02272007650008353f : h == 2 ? -0.011315313227834146f : -0.005646563141142063f; }

constexpr size_t O_Y = 0, O_YS = 16777216, O_RETP = O_YS + 131072, O_RETS = O_RETP + 1048576, O_SWKP = O_RETS + 67108864, O_SWVP = O_SWKP + 65536,
                 O_SWKS = O_SWVP + 65536, O_SWVS = O_SWKS + 4194304, O_CONVP = O_SWVS + 4194304, O_CONVS = O_CONVP + 4096, O_POOLP = O_CONVS + 262144,
                 O_POOLS = O_POOLP + 30720, O_MEMK = O_POOLS + 1966080, O_MEMV = O_MEMK + 2097152, O_END = O_MEMV + 2097152;

constexpr size_t al256(size_t x) { return (x + 255) & ~(size_t)255; }
constexpr size_t WS_CTL = 0;
constexpr size_t WS_SS = 1u << 20;
constexpr size_t WS_ST = WS_SS + al256((size_t)13 * MT * 8);
constexpr size_t ZERO_BYTES = al256(WS_ST + (size_t)MT * 8 * 8);
static_assert(ZERO_BYTES <= (4u << 20), "control region");
constexpr size_t WS_W = 4u << 20;
constexpr size_t W_RET_IN = WS_W, W_RET_OUT = W_RET_IN + (size_t)6144 * 1024 * 2, W_SWA_QKV = W_RET_OUT + (size_t)1024 * 2048 * 2,
                 W_SWA_O = W_SWA_QKV + (size_t)1536 * 1024 * 2, W_CONV_IN = W_SWA_O + (size_t)1024 * 1024 * 2, W_CONV_OUT = W_CONV_IN + (size_t)3072 * 1024 * 2,
                 W_POOL = W_CONV_OUT + (size_t)1024 * 1024 * 2, W_XQ = W_POOL + (size_t)4 * 256 * 256 * 2, W_XKV = W_XQ + (size_t)4 * 1024 * 1024 * 2,
                 W_XO = W_XKV + (size_t)4 * 2048 * 1024 * 2, W_FIN = W_XO + (size_t)4 * 1024 * 1024 * 2, W_FOUT = W_FIN + (size_t)4 * 5632 * 1024 * 2,
                 W_END = W_FOUT + (size_t)4 * 1024 * 2816 * 2;
constexpr size_t WS_TAB = al256(W_END);
constexpr size_t T_CR = WS_TAB, T_SR = T_CR + (size_t)8193 * 128 * 4, T_CRT = al256(T_SR + (size_t)8193 * 128 * 4), T_SRT = T_CRT + (size_t)128 * 8192 * 4,
                 T_CS = T_SRT + (size_t)128 * 8192 * 4, T_SN = al256(T_CS + (size_t)8193 * 8 * 4), T_END = al256(T_SN + (size_t)8193 * 8 * 4);
constexpr size_t WS_MEMN = T_END;
constexpr size_t WS_MK = WS_MEMN + (size_t)4 * 512 * 1024 * 2;
constexpr size_t WS_MVT = WS_MK + (size_t)4 * 512 * 1024 * 2;
constexpr size_t WS_XB = WS_MVT + (size_t)4 * 512 * 1024 * 2;
constexpr size_t WS_Q = WS_XB + (size_t)MT * 1024 * 2;
constexpr size_t WS_KB = WS_Q + (size_t)MT * 1024 * 2;
constexpr size_t WS_G = WS_KB + (size_t)MT * 1024 * 2;
constexpr size_t WS_KT = WS_G + (size_t)MT * 2048 * 2;
constexpr size_t WS_VS = WS_KT + (size_t)8 * 256 * 8192 * 2;
constexpr size_t WS_APQ = WS_VS + (size_t)256 * 512 * 512 * 2;
constexpr size_t WS_U = WS_APQ + (size_t)256 * 256 * 512 * 2;
constexpr size_t WS_O = WS_U + (size_t)256 * 512 * 256 * 4;
constexpr size_t WS_UB = WS_O + (size_t)MT * 2048 * 2;
constexpr size_t WS_PX = WS_UB + (size_t)MT * 2048 * 2;
constexpr size_t WS_OX = WS_PX + (size_t)MT * 1024 * 2;
constexpr size_t WS_HF = WS_OX + (size_t)MT * 1024 * 2;
constexpr size_t WS_SQ = WS_HF + (size_t)MT * 2816 * 2;
constexpr size_t WS_END = WS_SQ + (size_t)128 * 4096 * 4;

constexpr int RING_OFF = 0, RING_BYTES = 131072;
constexpr int EPIX_OFF = RING_BYTES;
constexpr int LDSCTL_OFF = EPIX_OFF + 16384, MISC_OFF = LDSCTL_OFF + 64;
constexpr int LDS_BYTES = LDSCTL_OFF + 256;

#define LDS_WAIT() asm volatile("s_waitcnt lgkmcnt(0)" ::: "memory")
#define VM_WAIT() asm volatile("s_waitcnt vmcnt(0)" ::: "memory")
__device__ __forceinline__ unsigned cvt_pk_bf16(float lo, float hi) { unsigned r; asm volatile("v_cvt_pk_bf16_f32 %0, %1, %2" : "=v"(r) : "v"(lo), "v"(hi)); return r; }
__device__ __forceinline__ u32x4 pack8(f32x4 a, f32x4 b) { u32x4 w; w.x = cvt_pk_bf16(a[0], a[1]); w.y = cvt_pk_bf16(a[2], a[3]); w.z = cvt_pk_bf16(b[0], b[1]); w.w = cvt_pk_bf16(b[2], b[3]); return w; }
__device__ __forceinline__ float bf2f(unsigned short b) { return __builtin_bit_cast(float, (unsigned)b << 16); }
__device__ __forceinline__ float bflo(unsigned w) { return __builtin_bit_cast(float, w << 16); }
__device__ __forceinline__ float bfhi(unsigned w) { return __builtin_bit_cast(float, w & 0xffff0000u); }
__device__ __forceinline__ float siluf(float x) { return x * __builtin_amdgcn_rcpf(1.f + __builtin_amdgcn_exp2f(-x * LOG2E)); }
typedef unsigned long long u64;
__device__ __forceinline__ u64 to_fx(float v) { return (u64)(long long)((double)v * 65536.0); }
__device__ __forceinline__ float from_fx(u64 v) { return (float)((double)(long long)v * (1.0 / 65536.0)); }
__device__ __forceinline__ void fx_add(u64* p, float v) { __hip_atomic_fetch_add(p, to_fx(v), __ATOMIC_RELAXED, __HIP_MEMORY_SCOPE_AGENT); }
__device__ __forceinline__ float rstd_of(u64 ss) { return __builtin_amdgcn_rsqf(from_fx(ss) * (1.f / 1024.f) + EPS); }
__device__ __forceinline__ float wave_sum(float v) {
#pragma unroll
    for (int o = 1; o < 64; o <<= 1) v += __shfl_xor(v, o);
    return v;
}
__device__ __forceinline__ float wave_max(float v) {
#pragma unroll
    for (int o = 1; o < 64; o <<= 1) v = fmaxf(v, __shfl_xor(v, o));
    return v;
}

namespace pg8 {
typedef unsigned short bf16_t;
constexpr int BM = 256, BK = 64, HALF = 128, HTB = HALF * BK * 2, STAGE_BYTES = 8 * HTB;
__host__ __device__ __forceinline__ int lds_byte(int r, int c) { const int st = (r >> 4) * 2 + (c >> 5), rr = r & 15, cc = c & 31, ob = rr * 64 + cc * 2; return st * 1024 + (ob ^ (((ob >> 9) & 1) << 5)); }
__host__ __device__ __forceinline__ void stage_rc(int b, int& R, int& C) { const int st = b / 1024, sb = b % 1024, swz = sb ^ (((sb >> 9) & 1) << 5); R = (st >> 1) * 16 + swz / 64; C = (st & 1) * 32 + (swz % 64) / 2; }
__host__ __device__ __forceinline__ int perm32(int rho) { const int n = rho >> 4, i = rho & 15; return 8 * (i >> 2) + 4 * n + (i & 3); }

struct Unit { int pm, pn; unsigned ao, bo; };
struct Gemm { const bf16_t* A; const bf16_t* Bt; int lda, ldb, K; };

template <class Dec> struct Sched {
    int nwg, G, c; Dec d;
    __device__ __forceinline__ bool next(int i, Unit& u) const { const long L = (long)i * G + c; if (L >= nwg) return false; d((int)L, u); return true; }
    __device__ __forceinline__ void a_ready(const Unit&) const {}
    __device__ __forceinline__ void done(const Unit&) const {}
};
struct DecGrid {
    int nM, nN; unsigned a0, am, an, b0, bm, bn;
    __device__ __forceinline__ void operator()(int L, Unit& u) const {
        const int nwg = nM * nN; int wgid = L; { const int q = nwg / 8, r = nwg % 8, xcd = wgid % 8, off = wgid / 8; wgid = (xcd < r ? xcd * (q + 1) : r * (q + 1) + (xcd - r) * q) + off; }
        const int nig = 8 * nN, gid = wgid / nig, fm = gid * 8, gsz = (nM - fm) < 8 ? (nM - fm) : 8;
        u.pm = fm + ((wgid % nig) % gsz); u.pn = (wgid % nig) / gsz;
        u.ao = a0 + (unsigned)u.pm * am + (unsigned)u.pn * an; u.bo = b0 + (unsigned)u.pm * bm + (unsigned)u.pn * bn;
    }
};

typedef f32x4 Acc[2][2][4][2];

template <class Epi, class SchedT, bool ALIGN_EPI = true, bool SP2 = true>
__device__ __forceinline__ void gemm_phase(LAS unsigned char* lds, const Gemm g, const SchedT& S, const Epi& E, const int wid) {
    static_assert(SP2, "only the SP2 loop is kept");
    int lane = __builtin_amdgcn_mbcnt_hi(~0u, __builtin_amdgcn_mbcnt_lo(~0u, 0u)); asm volatile("" : "+v"(lane));
    const int tid = wid * 64 + lane, wr = wid >> 2, wc = wid & 3, fr = lane & 15, fq = lane >> 4;
    const int K = g.K, nt = K / BK;
    unsigned voffA[2], voffB[2];
#pragma unroll
    for (int i = 0; i < 2; ++i) { int R, C; stage_rc(tid * 16 + i * 8192, R, C); const int Rb = Epi::PERM ? ((R & ~31) + perm32(R & 31)) : R;
        voffA[i] = (unsigned)(R * g.lda + C) * 2u; voffB[i] = (unsigned)(Rb * g.ldb + C) * 2u; }
    const size_t kstep = (size_t)(BK * 2);
    const size_t hstepA = (size_t)HALF * g.lda * 2, hstepB = (size_t)HALF * g.ldb * 2;
    const unsigned ldsw = (unsigned)wid * 1024u;
    const int aoff = lds_byte(wr * 64 + fr, fq * 8), boff = lds_byte(wc * 32 + fr, fq * 8);
#define PG8_SA(b, h) (((b) * 2 + (h)) * HTB)
#define PG8_SB(b, h) ((4 + (b) * 2 + (h)) * HTB)
#define PG8_STAGE(bufoff, gbase, voff) do { _Pragma("unroll") for (int _i = 0; _i < 2; ++_i) \
        __builtin_amdgcn_global_load_lds((const unsigned*)((const char*)(gbase) + (voff)[_i]), (LAS unsigned*)(lds + (bufoff) + ldsw + _i * 8192), 16, 0, 0); } while (0)
#define PG8_LDA(dst, b, h) do { _Pragma("unroll") for (int m = 0; m < 4; ++m) _Pragma("unroll") for (int k = 0; k < 2; ++k) dst[m][k] = *(const LAS bf16x8*)(lds + PG8_SA(b, h) + aoff + m * 2048 + k * 1024); } while (0)
#define PG8_LDB(dst, b, h) do { _Pragma("unroll") for (int n = 0; n < 2; ++n) _Pragma("unroll") for (int k = 0; k < 2; ++k) dst[n][k] = *(const LAS bf16x8*)(lds + PG8_SB(b, h) + boff + n * 2048 + k * 1024); } while (0)
#define PG8_MMA(ai, bj, At, Bt) do { __builtin_amdgcn_s_setprio(1); _Pragma("unroll") for (int m = 0; m < 4; ++m) _Pragma("unroll") for (int n = 0; n < 2; ++n) _Pragma("unroll") for (int k = 0; k < 2; ++k) \
        acc[ai][bj][m][n] = __builtin_amdgcn_mfma_f32_16x16x32_bf16(Bt[n][k], At[m][k], acc[ai][bj][m][n], 0, 0, 0); __builtin_amdgcn_s_setprio(0); } while (0)
#define PG8_WAIT_V(n) asm volatile("s_waitcnt vmcnt(" #n ")" ::: "memory")
#define PG8_WAIT_L(n) asm volatile("s_waitcnt lgkmcnt(" #n ")" ::: "memory")
#define PG8_BAR __builtin_amdgcn_s_barrier()
#define PG8_SCHED __builtin_amdgcn_sched_barrier(0)
    Unit cur, nxt; int ui = 0;
    if (!S.next(0, cur)) return;
    f32x4 acc[2][2][4][2];
#pragma unroll
    for (int a = 0; a < 2; ++a)
#pragma unroll
        for (int b = 0; b < 2; ++b)
#pragma unroll
            for (int m = 0; m < 4; ++m)
#pragma unroll
                for (int n = 0; n < 2; ++n) acc[a][b][m][n] = (f32x4){0.f, 0.f, 0.f, 0.f};
    bf16x8 At[4][2], B0[2][2], B1[2][2];
    const char* cA = (const char*)g.A + (size_t)cur.ao * 2; const char* cB = (const char*)g.Bt + (size_t)cur.bo * 2;
    S.a_ready(cur);
    PG8_STAGE(PG8_SB(0, 0), cB, voffB); PG8_STAGE(PG8_SB(0, 1), cB + hstepB, voffB); PG8_STAGE(PG8_SA(0, 0), cA, voffA); PG8_STAGE(PG8_SA(0, 1), cA + hstepA, voffA);
    if (wr == 1) PG8_BAR;
    PG8_WAIT_V(2); PG8_BAR;
    PG8_STAGE(PG8_SB(1, 0), cB + kstep, voffB); PG8_STAGE(PG8_SA(1, 0), cA + kstep, voffA); PG8_STAGE(PG8_SB(1, 1), cB + hstepB + kstep, voffB);
    PG8_WAIT_V(6); PG8_BAR;
    for (;;) {
        const bool has_next = S.next(ui + 1, nxt);
        const char* nA = has_next ? (const char*)g.A + (size_t)nxt.ao * 2 : cA; const char* nB = has_next ? (const char*)g.Bt + (size_t)nxt.bo * 2 : cB;
        for (int t = 0; t < nt; t += 2) {
            const bool last = (t == nt - 2);
            const char* a1 = cA + (size_t)(t + 1) * kstep;
            const char* a2 = last ? nA : cA + (size_t)(t + 2) * kstep; const char* b2 = last ? nB : cB + (size_t)(t + 2) * kstep;
            const char* a3 = a2 + kstep; const char* b3 = b2 + kstep;
            if (last && has_next) S.a_ready(nxt);
            PG8_LDB(B0, 0, 0); PG8_LDB(B1, 0, 1); PG8_SCHED; PG8_LDA(At, 0, 0); PG8_STAGE(PG8_SA(1, 1), a1 + hstepA, voffA);
            PG8_WAIT_V(8); PG8_WAIT_L(0); PG8_BAR; PG8_MMA(0, 0, At, B0); PG8_MMA(0, 1, At, B1); PG8_BAR; PG8_SCHED;
            PG8_LDA(At, 0, 1); PG8_STAGE(PG8_SB(0, 0), b2, voffB); PG8_STAGE(PG8_SB(0, 1), b2 + hstepB, voffB); PG8_STAGE(PG8_SA(0, 0), a2, voffA);
            PG8_WAIT_V(8); PG8_WAIT_L(0); PG8_BAR; PG8_MMA(1, 0, At, B0); PG8_MMA(1, 1, At, B1); PG8_BAR; PG8_SCHED;
            PG8_LDB(B0, 1, 0); PG8_LDB(B1, 1, 1); PG8_SCHED; PG8_LDA(At, 1, 0); PG8_STAGE(PG8_SA(0, 1), a2 + hstepA, voffA);
            PG8_WAIT_V(8); PG8_WAIT_L(0); PG8_BAR; PG8_MMA(0, 0, At, B0); PG8_MMA(0, 1, At, B1); PG8_BAR; PG8_SCHED;
            PG8_LDA(At, 1, 1); PG8_STAGE(PG8_SB(1, 0), b3, voffB); PG8_STAGE(PG8_SB(1, 1), b3 + hstepB, voffB); PG8_STAGE(PG8_SA(1, 0), a3, voffA);
            PG8_WAIT_V(8); PG8_WAIT_L(0); PG8_BAR; PG8_MMA(1, 0, At, B0); PG8_MMA(1, 1, At, B1); PG8_BAR; PG8_SCHED;
        }
        if constexpr (ALIGN_EPI) { if (wr == 0) PG8_BAR; }
        { int ln = __builtin_amdgcn_mbcnt_hi(~0u, __builtin_amdgcn_mbcnt_lo(~0u, 0u)); asm volatile("" : "+v"(ln));
          E(acc, cur, wr, wc, ln & 15, ln >> 4); }
        if (!has_next) break;
#pragma unroll
        for (int a = 0; a < 2; ++a)
#pragma unroll
            for (int b = 0; b < 2; ++b)
#pragma unroll
                for (int m = 0; m < 4; ++m)
#pragma unroll
                    for (int n = 0; n < 2; ++n) acc[a][b][m][n] = (f32x4){0.f, 0.f, 0.f, 0.f};
        cur = nxt; cA = nA; cB = nB; ++ui;
        if constexpr (ALIGN_EPI) { if (wr == 1) PG8_BAR; }
    }
    PG8_WAIT_V(0);
    if constexpr (!ALIGN_EPI) { if (wr == 0) PG8_BAR; }
    PG8_BAR;
#undef PG8_SA
#undef PG8_SB
#undef PG8_STAGE
#undef PG8_LDA
#undef PG8_LDB
#undef PG8_MMA
#undef PG8_WAIT_V
#undef PG8_WAIT_L
#undef PG8_BAR
#undef PG8_SCHED
}
}
using pg8::Unit; using pg8::Gemm; using pg8::Acc; using pg8::DecGrid;

#define XB_TMO      128
#define XB_XCNT(j)  (256  + 64 * (j))
#define XB_XSUB(j)  (1280 + 64 * (j))
#define XB_XGEN(j)  (2304 + 64 * (j))
#define XB_TOP      3328
#define XB_TOPGEN   3392
#define XCD_BAR_WORDS 3456
#define XB_SPIN_CAP (1u << 18)
__device__ __forceinline__ unsigned xb_ld(unsigned* p)              { return __hip_atomic_load(p, __ATOMIC_RELAXED, __HIP_MEMORY_SCOPE_AGENT); }
__device__ __forceinline__ unsigned xb_add(unsigned* p, unsigned v) { return __hip_atomic_fetch_add(p, v, __ATOMIC_RELAXED, __HIP_MEMORY_SCOPE_AGENT); }
__device__ __forceinline__ unsigned xb_xcc_id() { return (unsigned)__builtin_amdgcn_s_getreg((3 << 11) | 20) & 0xFu; }
#define XB_SPIN(cond, bar) do { unsigned _sp = 0; while (cond) { __builtin_amdgcn_s_sleep(1); \
    if ((++_sp & 255u) == 0u) { if (xb_ld(&(bar)[XB_TMO])) break; if (_sp > XB_SPIN_CAP) { atomicAdd(&(bar)[XB_TMO], 1u); break; } } } } while (0)
struct XcdBarrier { unsigned* bar; unsigned x; volatile LAS unsigned* st; };
__device__ __forceinline__ XcdBarrier xcd_barrier_post(unsigned* bar, volatile LAS unsigned* st) {
    XcdBarrier b; b.bar = bar; b.x = xb_xcc_id(); b.st = st;
    if (threadIdx.x == 0) (void)xb_add(&bar[XB_XCNT(b.x)], 1u);
    return b;
}
__device__ __forceinline__ void xcd_barrier_complete(unsigned* bar, unsigned x, unsigned& nloc, unsigned& nx) {
    const unsigned G = gridDim.x * gridDim.y * gridDim.z;
    unsigned sum, cnt, mine, sp = 0u;
    for (;;) {
        sum = 0u; cnt = 0u; mine = 0u;
#pragma unroll
        for (unsigned j = 0; j < 16; ++j) { const unsigned c = xb_ld(&bar[XB_XCNT(j)]); sum += c; cnt += (c > 0u) ? 1u : 0u; mine = (j == x) ? c : mine; }
        if (sum == G) break;
        __builtin_amdgcn_s_sleep(1);
        if ((++sp & 255u) == 0u) { if (xb_ld(&bar[XB_TMO])) break; if (sp > XB_SPIN_CAP) { atomicAdd(&bar[XB_TMO], 1u); break; } }
    }
    nloc = mine > 0u ? mine : 1u; nx = cnt > 0u ? cnt : 1u;
}
__device__ __forceinline__ void xcd_barrier(const XcdBarrier& b) {
    asm volatile("s_waitcnt vmcnt(0)" ::: "memory");
    __syncthreads();
    if (threadIdx.x == 0) {
        unsigned* bar = b.bar;
        __builtin_amdgcn_s_waitcnt(0);
        unsigned nloc = b.st[0], nx = b.st[1];
        if (nloc == 0u) { xcd_barrier_complete(bar, b.x, nloc, nx); b.st[0] = nloc; b.st[1] = nx; }
        const unsigned old = xb_add(&bar[XB_XSUB(b.x)], 1u);
        const unsigned gen = old / nloc;
        if (old + 1u == (gen + 1u) * nloc) {
            __builtin_amdgcn_fence(__ATOMIC_RELEASE, "agent");
            asm volatile("s_waitcnt vmcnt(0)" ::: "memory");
            const unsigned og = xb_add(&bar[XB_TOP], 1u);
            const unsigned tg = og / nx;
            if (og + 1u == (tg + 1u) * nx) xb_add(&bar[XB_TOPGEN], 1u);
            else XB_SPIN(xb_ld(&bar[XB_TOPGEN]) == tg, bar);
            __builtin_amdgcn_fence(__ATOMIC_ACQUIRE, "agent");
            xb_add(&bar[XB_XGEN(b.x)], 1u);
            asm volatile("s_waitcnt vmcnt(0)" ::: "memory");
        } else {
            XB_SPIN(xb_ld(&bar[XB_XGEN(b.x)]) == gen, bar);
            __builtin_amdgcn_fence(__ATOMIC_ACQUIRE, "agent");
            asm volatile("s_waitcnt vmcnt(0)" ::: "memory");
        }
    }
    __syncthreads();
}

struct Args { const float* in[28]; float* out; unsigned char* ws; int ph_lo, ph_hi; };
enum { I_XP = 0, I_XS, I_SRET, I_CSK, I_CSV, I_SCONV, I_SPOOL, I_CMK, I_CMV, I_MEM, I_NG, I_MNG, I_FNG, I_RWIN, I_RWOUT, I_SWQKV, I_SWO, I_SINK, I_CWIN, I_CW, I_CWOUT, I_PW, I_PSC, I_XWQ, I_XWKV, I_XWO, I_FWIN, I_FWOUT };

struct Ctx { LAS unsigned char* lds; int wave, vcu, G; };
__device__ __forceinline__ int olane() { int t = __builtin_amdgcn_mbcnt_hi(~0u, __builtin_amdgcn_mbcnt_lo(~0u, 0u)); asm volatile("" : "+v"(t)); return t; }
#define otid() (C.wave * 64 + olane())

__device__ __forceinline__ void conv_item(const float* W, int K, int N, int k0, int ns0, bf16* WT, int nd0, const float* gain, const float* cs, LAS float* scr, int lane) {
    const float csv = cs ? cs[ns0 + (lane & 31)] : 1.f;
#pragma unroll 8
    for (int i = 0; i < 32; ++i) { const int kk = 2 * i + (lane >> 5); float w = W[(size_t)(k0 + kk) * N + ns0 + (lane & 31)] * csv; if (gain) w *= gain[k0 + kk]; scr[kk * 33 + (lane & 31)] = w; }
    LDS_WAIT(); asm volatile("" ::: "memory");
    const int c = lane & 7;
#pragma unroll
    for (int j = 0; j < 4; ++j) { const int n = (lane >> 3) + 8 * j; const LAS float* s = scr + (8 * c) * 33 + n;
        u32x4 o; o.x = cvt_pk_bf16(s[0 * 33], s[1 * 33]); o.y = cvt_pk_bf16(s[2 * 33], s[3 * 33]); o.z = cvt_pk_bf16(s[4 * 33], s[5 * 33]); o.w = cvt_pk_bf16(s[6 * 33], s[7 * 33]);
        *(GAS u32x4*)(WT + (size_t)(nd0 + n) * K + k0 + 8 * c) = o; }
    LDS_WAIT(); asm volatile("" ::: "memory");
}
__device__ __forceinline__ int map_col(int mode, int nd) {
    if (mode == 0) return nd;
    if (mode == 1) return nd < 2048 ? nd : (nd < 4096 ? nd + 2048 : nd - 2048);
    if (mode == 2) { if (nd < 1024) return nd; const int t = nd - 1024; return 1024 + ((t >> 7) & 1) * 1024 + (t >> 8) * 128 + (t & 127); }
    return ((nd >> 7) & 1) * DFF + (nd >> 8) * 128 + (nd & 127);
}

__device__ __forceinline__ void p0_prologue(const Ctx& C, const Args& a) {
    unsigned char* ws = a.ws;
    LAS float* scr = (LAS float*)(C.lds + RING_OFF + C.wave * 16384);
    const int tid_ = otid(), lane_ = tid_ & 63;
    const int gw = C.vcu * 8 + C.wave, NGW = C.G * 8;
    int cum = 0;
#define JOB(Wp, K_, N_, Nd_, dstp, mode, gainp, csp) do { const int K__ = (K_), nblk = (Nd_) / 32, items = (K__ / 64) * nblk; \
        for (int it = (gw + NGW - (cum % NGW)) % NGW; it < items; it += NGW) { const int kb = it / nblk, nb = it % nblk; \
            conv_item((Wp), K__, (N_), 64 * kb, map_col((mode), 32 * nb), (bf16*)(dstp), 32 * nb, (gainp), (csp), scr, lane_); } cum += items; } while (0)
    const float* ng = a.in[I_NG];
    JOB(a.in[I_RWIN], 1024, 6144, 6144, ws + W_RET_IN, 1, ng + 0 * 1024, (const float*)nullptr);
    JOB(a.in[I_RWOUT], 2048, 1024, 1024, ws + W_RET_OUT, 0, (const float*)nullptr, (const float*)nullptr);
    JOB(a.in[I_SWQKV], 1024, 1536, 1536, ws + W_SWA_QKV, 0, ng + 3 * 1024, (const float*)nullptr);
    JOB(a.in[I_SWO], 1024, 1024, 1024, ws + W_SWA_O, 0, (const float*)nullptr, (const float*)nullptr);
    JOB(a.in[I_CWIN], 1024, 3072, 3072, ws + W_CONV_IN, 2, ng + 6 * 1024, (const float*)nullptr);
    JOB(a.in[I_CWOUT], 1024, 1024, 1024, ws + W_CONV_OUT, 0, (const float*)nullptr, (const float*)nullptr);
    for (int gi = 0; gi < 4; ++gi)
        JOB(a.in[I_PW] + (size_t)gi * 65536, 256, 256, 256, ws + W_POOL + (size_t)gi * 65536 * 2, 0, (const float*)nullptr, a.in[I_PSC] + gi * 256);
    for (int l = 0; l < 4; ++l) {
        JOB(a.in[I_XWQ] + (size_t)l * 1048576, 1024, 1024, 1024, ws + W_XQ + (size_t)l * 1048576 * 2, 0, ng + (3 * l + 1) * 1024, (const float*)nullptr);
        JOB(a.in[I_XWKV] + (size_t)l * 2097152, 1024, 2048, 2048, ws + W_XKV + (size_t)l * 2097152 * 2, 0, (const float*)nullptr, (const float*)nullptr);
        JOB(a.in[I_XWO] + (size_t)l * 1048576, 1024, 1024, 1024, ws + W_XO + (size_t)l * 1048576 * 2, 0, (const float*)nullptr, (const float*)nullptr);
        JOB(a.in[I_FWIN] + (size_t)l * 1024 * 5632, 1024, 5632, 5632, ws + W_FIN + (size_t)l * 1024 * 5632 * 2, 3, ng + (3 * l + 2) * 1024, (const float*)nullptr);
        JOB(a.in[I_FWOUT] + (size_t)l * 2816 * 1024, 2816, 1024, 1024, ws + W_FOUT + (size_t)l * 2816 * 1024 * 2, 0, (const float*)nullptr, (const float*)nullptr);
    }
#undef JOB
    bf16* XB = (bf16*)(ws + WS_XB); u64* SS = (u64*)(ws + WS_SS);
    for (int row = gw; row < MT; row += NGW) {
        GAS unsigned long long* o8 = (GAS unsigned long long*)(XB + (size_t)row * D) + lane_;
        if (row < MREAL) {
            const float* xr = row < MP ? a.in[I_XP] + (size_t)row * D : a.in[I_XS] + (size_t)(row - MP) * D;
            const GAS f32x4* xp = (const GAS f32x4*)xr + lane_; float s = 0.f;
#pragma unroll
            for (int j = 0; j < 4; ++j) { const f32x4 v = xp[64 * j]; s += (v.x * v.x + v.y * v.y) + (v.z * v.z + v.w * v.w);
                o8[64 * j] = (unsigned long long)cvt_pk_bf16(v.x, v.y) | ((unsigned long long)cvt_pk_bf16(v.z, v.w) << 32); }
            s = wave_sum(s); if (lane_ == 0) SS[row] = to_fx(s);
        } else {
#pragma unroll
            for (int j = 0; j < 4; ++j) o8[64 * j] = 0ull;
        }
    }
    bf16* MN = (bf16*)(ws + WS_MEMN);
    for (int row = gw; row < 512; row += NGW) {
        const GAS f32x4* xp = (const GAS f32x4*)(a.in[I_MEM] + (size_t)row * D) + lane_; f32x4 v[4]; float s = 0.f;
#pragma unroll
        for (int j = 0; j < 4; ++j) { v[j] = xp[64 * j]; s += (v[j].x * v[j].x + v[j].y * v[j].y) + (v[j].z * v[j].z + v[j].w * v[j].w); }
        const float r = __builtin_amdgcn_rsqf(wave_sum(s) * (1.f / 1024.f) + EPS);
        for (int l = 0; l < 4; ++l) { const GAS f32x4* gp = (const GAS f32x4*)(a.in[I_MNG] + l * D) + lane_;
            GAS unsigned long long* o8 = (GAS unsigned long long*)(MN + ((size_t)l * 512 + row) * D) + lane_;
#pragma unroll
            for (int j = 0; j < 4; ++j) { const f32x4 gg = gp[64 * j]; o8[64 * j] = (unsigned long long)cvt_pk_bf16(v[j].x * r * gg.x, v[j].y * r * gg.y) | ((unsigned long long)cvt_pk_bf16(v[j].z * r * gg.z, v[j].w * r * gg.w) << 32); } }
    }
    {
        const int gt = C.vcu * 512 + tid_, NGT = C.G * 512;
        float* CR = (float*)(ws + T_CR); float* SR = (float*)(ws + T_SR); float* CRT = (float*)(ws + T_CRT); float* SRT = (float*)(ws + T_SRT);
        for (int e = gt; e < 8193 * 128; e += NGT) { const int pos = e >> 7, i = e & 127;
            const double inv = exp(-9.210340371976184 * (double)i / 128.0); double s, c; sincos((double)pos * inv, &s, &c);
            CR[e] = (float)c; SR[e] = (float)s; if (pos < 8192) { CRT[(size_t)i * 8192 + pos] = (float)c; SRT[(size_t)i * 8192 + pos] = (float)s; } }
        float* CS = (float*)(ws + T_CS); float* SN = (float*)(ws + T_SN);
        for (int e = gt; e < 8193 * 8; e += NGT) { const int pos = e >> 3, i = e & 7;
            const double inv = exp(-13.122363377404328 * (double)i / 8.0); double s, c; sincos((double)pos * inv, &s, &c); CS[e] = (float)c; SN[e] = (float)s; }
    }
    {
        const int gt = C.vcu * 512 + tid_, NGT = C.G * 512;
        GAS u32x4* ub = (GAS u32x4*)(ws + WS_UB + (size_t)MREAL * 2048 * 2); for (int e = gt; e < 128 * 2048 * 2 / 16; e += NGT) ub[e] = (u32x4){0u, 0u, 0u, 0u};
        GAS u32x4* ox = (GAS u32x4*)(ws + WS_OX + (size_t)MREAL * 1024 * 2); for (int e = gt; e < 128 * 1024 * 2 / 16; e += NGT) ox[e] = (u32x4){0u, 0u, 0u, 0u};
    }
}

#define EPI_HDR static constexpr bool PERM = true, AFTER_DRAIN = false;
#define EPI_ARGS Acc& acc, const Unit& u, int wr, int wc, int fr, int fq
#define FOR_AI_M _Pragma("unroll") for (int ai = 0; ai < 2; ++ai) _Pragma("unroll") for (int m = 0; m < 4; ++m)
#define FOR_BJ _Pragma("unroll") for (int bj = 0; bj < 2; ++bj)
#define FOR_N _Pragma("unroll") for (int n = 0; n < 2; ++n)
#define TROW (ai * 128 + wr * 64 + m * 16 + fr)
__device__ __forceinline__ f32x4 silu4(f32x4 v) { return (f32x4){siluf(v[0]), siluf(v[1]), siluf(v[2]), siluf(v[3])}; }
__device__ __forceinline__ f32x4 ld4(const float* p) { return *(const f32x4*)p; }
__device__ __forceinline__ void st4(float* p, f32x4 v) { *(f32x4*)p = v; }
__device__ __forceinline__ void st8b(bf16* p, f32x4 a, f32x4 b) { *(u32x4*)p = pack8(a, b); }

struct EpiMemKV { EPI_HDR
    float* out; bf16* MK;
    __device__ __forceinline__ void operator()(EPI_ARGS) const {
        const int c0 = wc * 32 + fq * 8; const bool isk = u.pn < 4; float* ob = out + (isk ? O_MEMK : O_MEMV);
        FOR_AI_M { const size_t row = (size_t)u.pm * 256 + TROW;
            FOR_BJ { const size_t o = row * 1024 + (u.pn & 3) * 256 + bj * 128 + c0;
                st4(ob + o, acc[ai][bj][m][0]); st4(ob + o + 4, acc[ai][bj][m][1]);
                if (isk) st8b(MK + o, acc[ai][bj][m][0], acc[ai][bj][m][1]); } }
    }
};
struct EpiMemVT { EPI_HDR
    bf16* MVT;
    __device__ __forceinline__ void operator()(EPI_ARGS) const {
        const int c0 = wc * 32 + fq * 8; const int layer = u.pm >> 2, head = u.pm & 3;
        FOR_AI_M { const size_t row = ((size_t)(layer * 2 + u.pn) * 1024 + head * 256 + TROW);
            FOR_BJ st8b(MVT + row * 256 + bj * 128 + c0, acc[ai][bj][m][0], acc[ai][bj][m][1]); }
    }
};
struct EpiRetIn { EPI_HDR
    const u64* ss; const float* CR; const float* SR; bf16* Q; bf16* KB; bf16* APQ; bf16* Gt; float* SQ;
    __device__ __forceinline__ void operator()(EPI_ARGS) const {
        const int c0 = wc * 32 + fq * 8, pn = u.pn;
        FOR_AI_M { const int row = u.pm * 256 + TROW; const float r = rstd_of(ss[row]);
            if (pn < 8) {
                const bool samp = row >= MP; const int pos = samp ? 8192 : (row & 8191); const int h = pn & 3;
                f32x4 o1[2], o2[2];
                FOR_N { const f32x4 c = ld4(CR + (size_t)pos * 128 + c0 + 4 * n), s = ld4(SR + (size_t)pos * 128 + c0 + 4 * n);
                    const f32x4 x1 = acc[ai][0][m][n] * r, x2 = acc[ai][1][m][n] * r; o1[n] = x1 * c - x2 * s; o2[n] = x2 * c + x1 * s; }
                if (pn < 4) {
                    bf16* qd = Q + (size_t)row * 1024 + h * 256 + c0; st8b(qd, o1[0], o1[1]); st8b(qd + 128, o2[0], o2[1]);
                    if (!samp) { const int l = row & 255; const float dec = __builtin_amdgcn_exp2f((float)(l + 1) * lg2g(h));
                        const int bhc = ((row >> 13) * 4 + h) * 32 + ((row & 8191) >> 8);
                        bf16* ad = APQ + ((size_t)bhc * 256 + l) * 512 + 256 + c0; st8b(ad, o1[0] * dec, o1[1] * dec); st8b(ad + 128, o2[0] * dec, o2[1] * dec); }
                    else if (row < MREAL) { float* d = SQ + (size_t)(row - MP) * 4096 + h * 256 + c0; st4(d, o1[0]); st4(d + 4, o1[1]); st4(d + 128, o2[0]); st4(d + 132, o2[1]); }
                } else {
                    FOR_N { o1[n] = o1[n] * 0.0625f; o2[n] = o2[n] * 0.0625f; }
                    if (!samp) { bf16* kd = KB + (size_t)row * 1024 + h * 256 + c0; st8b(kd, o1[0], o1[1]); st8b(kd + 128, o2[0], o2[1]); }
                    else if (row < MREAL) { float* d = SQ + (size_t)(row - MP) * 4096 + 1024 + h * 256 + c0; st4(d, o1[0]); st4(d + 4, o1[1]); st4(d + 128, o2[0]); st4(d + 132, o2[1]); }
                }
            } else {
                FOR_BJ st8b(Gt + (size_t)row * 2048 + (pn - 8) * 256 + bj * 128 + c0, silu4(acc[ai][bj][m][0] * r), silu4(acc[ai][bj][m][1] * r));
            }
        }
    }
};
struct EpiRetVs { EPI_HDR
    const u64* ss; float* SQ;
    __device__ __forceinline__ void operator()(EPI_ARGS) const {
        const int c0 = wc * 32 + fq * 8;
#pragma unroll
        for (int m = 0; m < 4; ++m) { const int rl = wr * 64 + m * 16 + fr; const float r = rstd_of(ss[MP + rl]);
            FOR_BJ { float* d = SQ + (size_t)rl * 4096 + 2048 + u.pn * 256 + bj * 128 + c0; st4(d, acc[0][bj][m][0] * r); st4(d + 4, acc[0][bj][m][1] * r); } }
    }
};
struct EpiRetKT { EPI_HDR
    const u64* ss; const float* CRT; const float* SRT; bf16* KT;
    __device__ __forceinline__ void operator()(EPI_ARGS) const {
        const int c0 = wc * 32 + fq * 8, h = u.pm; const float lg = lg2g(h);
        f32x4 sc[2][2];
        FOR_BJ FOR_N { const int tok0 = u.pn * 256 + bj * 128 + c0 + 4 * n;
#pragma unroll
            for (int e = 0; e < 4; ++e) sc[bj][n][e] = rstd_of(ss[tok0 + e]) * 0.0625f * __builtin_amdgcn_exp2f((float)(255 - ((tok0 + e) & 255)) * lg); }
        const int b = u.pn >> 5;
#pragma unroll
        for (int m = 0; m < 4; ++m) { const int i = wr * 64 + m * 16 + fr;
            FOR_BJ { const int t0 = ((u.pn & 31) * 256) + bj * 128 + c0; f32x4 o1[2], o2[2];
                FOR_N { const f32x4 c = ld4(CRT + (size_t)i * 8192 + t0 + 4 * n), s = ld4(SRT + (size_t)i * 8192 + t0 + 4 * n);
                    const f32x4 x1 = acc[0][bj][m][n], x2 = acc[1][bj][m][n]; o1[n] = (x1 * c - x2 * s) * sc[bj][n]; o2[n] = (x2 * c + x1 * s) * sc[bj][n]; }
                bf16* d = KT + ((size_t)((b * 4 + h) * 256 + i)) * 8192 + t0; st8b(d, o1[0], o1[1]); st8b(d + (size_t)128 * 8192, o2[0], o2[1]); } }
    }
};
struct EpiRetVT { EPI_HDR
    const u64* ss; bf16* VS;
    __device__ __forceinline__ void operator()(EPI_ARGS) const {
        const int c0 = wc * 32 + fq * 8, h = u.pm >> 1, vh = u.pm & 1; const int bhc = ((u.pn >> 5) * 4 + h) * 32 + (u.pn & 31);
        f32x4 sc[2][2];
        FOR_BJ FOR_N { const u64* sp = ss + u.pn * 256 + bj * 128 + c0 + 4 * n;
#pragma unroll
            for (int e = 0; e < 4; ++e) sc[bj][n][e] = rstd_of(sp[e]); }
        FOR_AI_M { bf16* d = VS + ((size_t)bhc * 512 + vh * 256 + TROW) * 512 + c0;
            FOR_BJ st8b(d + bj * 128, acc[ai][bj][m][0] * sc[bj][0], acc[ai][bj][m][1] * sc[bj][1]); }
    }
};
struct EpiP { EPI_HDR
    bf16* APQ;
    __device__ __forceinline__ void operator()(EPI_ARGS) const {
        const int c0 = wc * 32 + fq * 8, h = u.pn; const float lg = lg2g(h); const int bhc = ((u.pm >> 5) * 4 + h) * 32 + (u.pm & 31);
        FOR_AI_M { const int l = TROW; bf16* d = APQ + ((size_t)bhc * 256 + l) * 512 + c0;
            FOR_BJ { f32x4 o[2];
                FOR_N {
#pragma unroll
                    for (int e = 0; e < 4; ++e) { const int df = l - (bj * 128 + c0 + 4 * n + e); o[n][e] = df >= 0 ? acc[ai][bj][m][n][e] * __builtin_amdgcn_exp2f((float)df * lg) : 0.f; } }
                st8b(d + bj * 128, o[0], o[1]); } }
    }
};
struct EpiU { EPI_HDR
    float* U;
    __device__ __forceinline__ void operator()(EPI_ARGS) const {
        const int c0 = wc * 32 + fq * 8;
        FOR_AI_M { float* d = U + ((size_t)u.pm * 256 + TROW) * 256 + c0;
            FOR_BJ { st4(d + bj * 128, acc[ai][bj][m][0]); st4(d + bj * 128 + 4, acc[ai][bj][m][1]); } }
    }
};
struct EpiO { EPI_HDR
    bf16* O; u64* ST;
    __device__ __forceinline__ void operator()(EPI_ARGS) const {
        const int c0 = wc * 32 + fq * 8; const int bhc = u.pm >> 1, vh = u.pm & 1, h = (bhc >> 5) & 3;
        const int row0 = (bhc >> 7) * 8192 + (bhc & 31) * 256;
        FOR_AI_M { const int row = row0 + TROW; float s1 = 0.f, s2 = 0.f;
            FOR_BJ { const f32x4 a = acc[ai][bj][m][0], b = acc[ai][bj][m][1];
                st8b(O + (size_t)row * 2048 + h * 512 + vh * 256 + bj * 128 + c0, a, b);
                s1 += (a[0] + a[1]) + (a[2] + a[3]) + (b[0] + b[1]) + (b[2] + b[3]);
                s2 += (a[0] * a[0] + a[1] * a[1]) + (a[2] * a[2] + a[3] * a[3]) + (b[0] * b[0] + b[1] * b[1]) + (b[2] * b[2] + b[3] * b[3]); }
            s1 += __shfl_xor(s1, 16); s1 += __shfl_xor(s1, 32); s2 += __shfl_xor(s2, 16); s2 += __shfl_xor(s2, 32);
            if (fq == 0) { fx_add(ST + (size_t)row * 8 + h * 2, s1); fx_add(ST + (size_t)row * 8 + h * 2 + 1, s2); } }
    }
};
struct EpiResidual { EPI_HDR
    const float* xold_p; const float* xold_s; float* xf; bf16* XB; u64* ssn;
    __device__ __forceinline__ void operator()(EPI_ARGS) const {
        const int c0 = wc * 32 + fq * 8;
        FOR_AI_M { const int row = u.pm * 256 + TROW; float sq = 0.f; const bool live = row < MREAL;
            if (live) { const float* xo = row < MP ? xold_p + (size_t)row * 1024 : xold_s + (size_t)(row - MP) * 1024;
                FOR_BJ { const int col = u.pn * 256 + bj * 128 + c0; const f32x4 a = ld4(xo + col) + acc[ai][bj][m][0], b = ld4(xo + col + 4) + acc[ai][bj][m][1];
                    st4(xf + (size_t)row * 1024 + col, a); st4(xf + (size_t)row * 1024 + col + 4, b); st8b(XB + (size_t)row * 1024 + col, a, b);
                    sq += (a[0] * a[0] + a[1] * a[1]) + (a[2] * a[2] + a[3] * a[3]) + (b[0] * b[0] + b[1] * b[1]) + (b[2] * b[2] + b[3] * b[3]); } }
            sq += __shfl_xor(sq, 16); sq += __shfl_xor(sq, 32);
            if (live && fq == 0) fx_add(ssn + row, sq); }
    }
};
struct EpiScale { EPI_HDR
    const u64* ss; float scale; bf16* out; int ld;
    __device__ __forceinline__ void operator()(EPI_ARGS) const {
        const int c0 = wc * 32 + fq * 8;
        FOR_AI_M { const int row = u.pm * 256 + TROW; const float r = rstd_of(ss[row]) * scale;
            FOR_BJ st8b(out + (size_t)row * ld + u.pn * 256 + bj * 128 + c0, acc[ai][bj][m][0] * r, acc[ai][bj][m][1] * r); }
    }
};
struct EpiSoftmax { EPI_HDR
    bf16* PX; LAS float* X;
    __device__ __forceinline__ void operator()(EPI_ARGS) const {
        const int c0 = wc * 32 + fq * 8;
        FOR_AI_M { float v = -3.0e38f;
            FOR_BJ FOR_N {
#pragma unroll
                for (int e = 0; e < 4; ++e) v = fmaxf(v, acc[ai][bj][m][n][e]); }
            v = fmaxf(v, __shfl_xor(v, 16)); v = fmaxf(v, __shfl_xor(v, 32));
            if (fq == 0) X[wc * 256 + TROW] = v; }
        asm volatile("s_waitcnt lgkmcnt(0)" ::: "memory"); __builtin_amdgcn_s_barrier(); asm volatile("" ::: "memory");
        FOR_AI_M { const int rl = TROW; const float M = fmaxf(fmaxf(X[rl], X[256 + rl]), fmaxf(X[512 + rl], X[768 + rl])); float s = 0.f;
            FOR_BJ FOR_N {
#pragma unroll
                for (int e = 0; e < 4; ++e) { const float p = __builtin_amdgcn_exp2f(acc[ai][bj][m][n][e] - M); acc[ai][bj][m][n][e] = p; s += p; } }
            s += __shfl_xor(s, 16); s += __shfl_xor(s, 32);
            if (fq == 0) X[1024 + wc * 256 + rl] = s; }
        asm volatile("s_waitcnt lgkmcnt(0)" ::: "memory"); __builtin_amdgcn_s_barrier(); asm volatile("" ::: "memory");
        FOR_AI_M { const int rl = TROW; const float inv = __builtin_amdgcn_rcpf((X[1024 + rl] + X[1280 + rl]) + (X[1536 + rl] + X[1792 + rl]));
            FOR_BJ st8b(PX + ((size_t)u.pm * 256 + rl) * 1024 + u.pn * 256 + bj * 128 + c0, acc[ai][bj][m][0] * inv, acc[ai][bj][m][1] * inv); }
        asm volatile("s_waitcnt lgkmcnt(0)" ::: "memory"); __builtin_amdgcn_s_barrier(); asm volatile("" ::: "memory");
    }
};
struct EpiPlain { EPI_HDR
    bf16* out; int ld;
    __device__ __forceinline__ void operator()(EPI_ARGS) const {
        const int c0 = wc * 32 + fq * 8;
        FOR_AI_M { const int row = u.pm * 256 + TROW;
            FOR_BJ st8b(out + (size_t)row * ld + u.pn * 256 + bj * 128 + c0, acc[ai][bj][m][0], acc[ai][bj][m][1]); }
    }
};
struct EpiSwiGLU { EPI_HDR
    const u64* ss; bf16* HF;
    __device__ __forceinline__ void operator()(EPI_ARGS) const {
        const int c0 = wc * 32 + fq * 8;
        FOR_AI_M { const int row = u.pm * 256 + TROW; const float r = rstd_of(ss[row]);
            st8b(HF + (size_t)row * DFF + u.pn * 128 + c0, silu4(acc[ai][0][m][0] * r) * (acc[ai][1][m][0] * r), silu4(acc[ai][0][m][1] * r) * (acc[ai][1][m][1] * r)); }
    }
};
struct EpiConvIn { EPI_HDR
    const u64* ss; bf16* BG; bf16* CI; float* out;
    __device__ __forceinline__ void operator()(EPI_ARGS) const {
        const int c0 = wc * 32 + fq * 8;
        FOR_AI_M { const int row = u.pm * 256 + TROW; const float r = rstd_of(ss[row]);
            if (u.pn < 4) { FOR_BJ st8b(BG + (size_t)row * 1024 + u.pn * 256 + bj * 128 + c0, acc[ai][bj][m][0] * r, acc[ai][bj][m][1] * r); }
            else { const int col = (u.pn - 4) * 128 + c0; const f32x4 a = (acc[ai][0][m][0] * r) * (acc[ai][1][m][0] * r), b = (acc[ai][0][m][1] * r) * (acc[ai][1][m][1] * r);
                st8b(CI + (size_t)row * 1024 + col, a, b);
                if (row < MP) { const int t = row & 8191; if (t >= 8190) { float* d = out + O_CONVP + ((size_t)(row >> 13) * 2 + (t - 8190)) * 1024 + col; st4(d, a); st4(d + 4, b); } }
                else if (row < MREAL) { float* d = out + O_CONVS + ((size_t)(row - MP) * 2 + 1) * 1024 + col; st4(d, a); st4(d + 4, b); } } }
    }
};
struct EpiSwaQKV { EPI_HDR
    const u64* ss; const float* CS; const float* SN; bf16* QS; bf16* KS; float* SWQ; float* out;
    __device__ __forceinline__ void operator()(EPI_ARGS) const {
        const int c0 = wc * 32 + fq * 8, pn = u.pn; const bool rot = ((wc & 1) == 0) && (fq < 2);
        FOR_AI_M { const int row = u.pm * 256 + TROW; const float r = rstd_of(ss[row]); const bool samp = row >= MP; const int pos = samp ? 8192 : (row & 8191);
            FOR_BJ { f32x4 v[2];
                FOR_N { v[n] = acc[ai][bj][m][n] * r;
                    if (pn < 5) { f32x4 pr;
#pragma unroll
                        for (int e = 0; e < 4; ++e) pr[e] = __shfl_xor(v[n][e], 16);
                        if (rot) { const f32x4 c = ld4(CS + (size_t)pos * 8 + 4 * n), s = ld4(SN + (size_t)pos * 8 + 4 * n); v[n] = (fq == 0) ? v[n] * c - pr * s : v[n] * c + pr * s; } } }
                const int tc = bj * 128 + c0;
                if (pn < 4) { const float qs = 0.125f * LOG2E; v[0] = v[0] * qs; v[1] = v[1] * qs;
                    if (!samp) st8b(QS + (size_t)row * 1024 + pn * 256 + tc, v[0], v[1]);
                    else if (row < MREAL) { float* d = SWQ + (size_t)(row - MP) * 1536 + pn * 256 + tc; st4(d, v[0]); st4(d + 4, v[1]); } }
                else if (pn == 4) {
                    if (!samp) { st8b(KS + (size_t)row * 256 + tc, v[0], v[1]); const int t = row & 8191;
                        if (t >= 8064) { float* d = out + O_SWKP + ((size_t)(row >> 13) * 128 + (t - 8064)) * 256 + tc; st4(d, v[0]); st4(d + 4, v[1]); } }
                    else if (row < MREAL) { float* d = SWQ + (size_t)(row - MP) * 1536 + 1024 + tc; st4(d, v[0]); st4(d + 4, v[1]); } }
                else {
                    if (!samp) { const int t = row & 8191; if (t >= 8064) { float* d = out + O_SWVP + ((size_t)(row >> 13) * 128 + (t - 8064)) * 256 + tc; st4(d, v[0]); st4(d + 4, v[1]); } }
                    else if (row < MREAL) { float* d = SWQ + (size_t)(row - MP) * 1536 + 1280 + tc; st4(d, v[0]); st4(d + 4, v[1]); } } } }
    }
};
struct EpiSwaVT { EPI_HDR
    const u64* ss; bf16* VT;
    __device__ __forceinline__ void operator()(EPI_ARGS) const {
        const int c0 = wc * 32 + fq * 8; const int b = u.pn >> 5, t0 = (u.pn & 31) * 256;
        f32x4 sc[2][2];
        FOR_BJ FOR_N { const u64* sp = ss + u.pn * 256 + bj * 128 + c0 + 4 * n;
#pragma unroll
            for (int e = 0; e < 4; ++e) sc[bj][n][e] = rstd_of(sp[e]); }
        FOR_AI_M { bf16* d = VT + ((size_t)(b * 256 + TROW)) * 8192 + t0 + c0;
            FOR_BJ st8b(d + bj * 128, acc[ai][bj][m][0] * sc[bj][0], acc[ai][bj][m][1] * sc[bj][1]); }
    }
};

struct DecMem { __device__ __forceinline__ void operator()(int L, Unit& u) const { u.pm = L >> 3; u.pn = L & 7; u.ao = (unsigned)u.pm * 256u * 1024u; u.bo = ((unsigned)(u.pm >> 1) * 2048u + (unsigned)u.pn * 256u) * 1024u; } };
struct DecMemT { __device__ __forceinline__ void operator()(int L, Unit& u) const { u.pm = L >> 1; u.pn = L & 1; u.ao = ((unsigned)(u.pm >> 2) * 2048u + 1024u + (unsigned)(u.pm & 3) * 256u) * 1024u; u.bo = ((unsigned)(u.pm >> 2) * 512u + (unsigned)u.pn * 256u) * 1024u; } };
struct DecU { __device__ __forceinline__ void operator()(int L, Unit& u) const { const unsigned bhc = (unsigned)L >> 1, vh = L & 1; u.pm = L; u.pn = 0; u.ao = (bhc * 512u + vh * 256u) * 512u; u.bo = (bhc >> 5) * 256u * 8192u + (bhc & 31u) * 256u; } };
struct DecO { __device__ __forceinline__ void operator()(int L, Unit& u) const { const unsigned bhc = (unsigned)L >> 1, vh = L & 1; u.pm = L; u.pn = 0; u.ao = bhc * 256u * 512u; u.bo = (bhc * 512u + vh * 256u) * 512u; } };
struct DecXS { int layer; __device__ __forceinline__ void operator()(int L, Unit& u) const { u.pm = L >> 2; u.pn = L & 3; u.ao = (unsigned)u.pm * 256u * 1024u + (unsigned)u.pn * 256u; u.bo = ((unsigned)(layer * 2 + (u.pm >> 5)) * 256u) * 1024u + (unsigned)u.pn * 256u; } };
struct DecXPV { int layer; __device__ __forceinline__ void operator()(int L, Unit& u) const { u.pm = L >> 2; u.pn = L & 3; u.ao = (unsigned)u.pm * 256u * 1024u + (unsigned)u.pn * 256u; u.bo = ((unsigned)(layer * 2 + (u.pm >> 5)) * 1024u + (unsigned)u.pn * 256u) * 256u; } };

__device__ __forceinline__ f32x4 mfma16(bf16x8 a, bf16x8 b, f32x4 c) { return __builtin_amdgcn_mfma_f32_16x16x32_bf16(a, b, c, 0, 0, 0); }

__device__ __forceinline__ void swa_unit(const Ctx& C, int unit, const bf16* QS, const bf16* KS, const bf16* VT, const float* sinks, bf16* AO) {
    const int kvh = unit & 3, qb = (unit >> 2) & 63, b = unit >> 8;
    const int lane_ = otid() & 63; const int w = C.wave, l15 = lane_ & 15, g = lane_ >> 4;
    const int head = kvh * 4 + (w >> 1);
    const float sink = sinks[head] * LOG2E;
    for (int qt = 0; qt < 4; ++qt) {
        const int q0 = qb * 128 + (w & 1) * 64 + qt * 16;
        const size_t qrow = (size_t)b * 8192 + q0 + l15;
        bf16x8 qf[2];
#pragma unroll
        for (int st = 0; st < 2; ++st) qf[st] = *(const bf16x8*)(QS + qrow * 1024 + head * 64 + st * 32 + 8 * g);
        const int kt0 = q0 / 16 - 9;
        f32x4 s[10];
#pragma unroll
        for (int kt = 0; kt < 10; ++kt) { int key = (kt0 + kt) * 16 + l15; key = key < 0 ? 0 : key;
            const bf16* kp = KS + ((size_t)b * 8192 + key) * 256 + kvh * 64 + 8 * g;
            const bf16x8 k0 = *(const bf16x8*)kp, k1 = *(const bf16x8*)(kp + 32);
            f32x4 a = (f32x4){0.f, 0.f, 0.f, 0.f}; a = mfma16(k0, qf[0], a); a = mfma16(k1, qf[1], a); s[kt] = a; }
        float mx = sink;
#pragma unroll
        for (int kt = 0; kt < 10; ++kt)
#pragma unroll
            for (int e = 0; e < 4; ++e) { const int key = (kt0 + kt) * 16 + 4 * g + e, df = q0 + l15 - key; const bool ok = key >= 0 && df >= 0 && df <= 128;
                s[kt][e] = ok ? s[kt][e] : -3.0e38f; mx = fmaxf(mx, s[kt][e]); }
        mx = fmaxf(mx, __shfl_xor(mx, 16)); mx = fmaxf(mx, __shfl_xor(mx, 32));
        float sum = 0.f;
#pragma unroll
        for (int kt = 0; kt < 10; ++kt)
#pragma unroll
            for (int e = 0; e < 4; ++e) { const float p = __builtin_amdgcn_exp2f(s[kt][e] - mx); s[kt][e] = p; sum += p; }
        sum += __shfl_xor(sum, 16); sum += __shfl_xor(sum, 32);
        sum += __builtin_amdgcn_exp2f(sink - mx);
        const float inv = 1.f / sum;
        f32x4 o[4];
#pragma unroll
        for (int dt = 0; dt < 4; ++dt) o[dt] = (f32x4){0.f, 0.f, 0.f, 0.f};
#pragma unroll
        for (int ks = 0; ks < 5; ++ks) {
            const u32x4 pw = pack8(s[2 * ks], s[2 * ks + 1]); const bf16x8 pf = __builtin_bit_cast(bf16x8, pw);
            int kb0 = (kt0 + 2 * ks) * 16 + 4 * g, kb1 = kb0 + 16; kb0 = kb0 < 0 ? 0 : kb0; kb1 = kb1 < 0 ? 0 : kb1;
#pragma unroll
            for (int dt = 0; dt < 4; ++dt) { const bf16* vp = VT + ((size_t)(b * 256 + kvh * 64 + dt * 16 + l15)) * 8192;
                const u32x2 v0 = *(const u32x2*)(vp + kb0), v1 = *(const u32x2*)(vp + kb1);
                const u32x4 vw = (u32x4){v0.x, v0.y, v1.x, v1.y};
                o[dt] = mfma16(__builtin_bit_cast(bf16x8, vw), pf, o[dt]); } }
#pragma unroll
        for (int dt = 0; dt < 4; ++dt) { u32x2 wv; wv.x = cvt_pk_bf16(o[dt][0] * inv, o[dt][1] * inv); wv.y = cvt_pk_bf16(o[dt][2] * inv, o[dt][3] * inv);
            *(u32x2*)(AO + qrow * 1024 + head * 64 + dt * 16 + 4 * g) = wv; }
    }
}

__device__ __forceinline__ void swa_sample_unit(const Ctx& C, int b, const float* SWQ, const float* ck, const float* cv, const float* sinks, float* out, bf16* AO) {
    LAS float* KV = (LAS float*)(C.lds);
    LAS float* SC = (LAS float*)(C.lds + 132096);
    const int tid = otid(), lane = tid & 63, w = C.wave;
    const float* q = SWQ + (size_t)b * 1536;
    for (int pass = 0; pass < 2; ++pass) {
        const float* cache = (pass == 0 ? ck : cv) + (size_t)b * 128 * 256; float* oc = out + (pass == 0 ? O_SWKS : O_SWVS) + (size_t)b * 128 * 256;
        const float* nw = q + (pass == 0 ? 1024 : 1280);
#pragma unroll 4
        for (int i = 0; i < 16; ++i) { const int idx = tid + 512 * i, j = idx >> 6, c4 = idx & 63; const f32x4 v = ld4(cache + (size_t)j * 256 + 4 * c4);
            *(LAS f32x4*)(KV + j * 256 + 4 * c4) = v; if (j >= 1) st4(oc + (size_t)(j - 1) * 256 + 4 * c4, v); }
        if (tid < 64) { const f32x4 v = ld4(nw + 4 * tid); *(LAS f32x4*)(KV + 128 * 256 + 4 * tid) = v; st4(oc + (size_t)127 * 256 + 4 * tid, v); }
        __syncthreads();
        if (pass == 0) {
            const int jq = lane >> 4, dq = lane & 15;
            for (int hh = 0; hh < 2; ++hh) { const int h = 2 * w + hh, kvh = h >> 2; const f32x4 q4 = ld4(q + h * 64 + 4 * dq);
                for (int j0 = 0; j0 < 132; j0 += 4) { const int j = j0 + jq; const int jc = j < 129 ? j : 128;
                    const f32x4 k4 = *(const LAS f32x4*)(KV + jc * 256 + kvh * 64 + 4 * dq);
                    float p = (q4[0] * k4[0] + q4[1] * k4[1]) + (q4[2] * k4[2] + q4[3] * k4[3]);
                    p += __shfl_xor(p, 1); p += __shfl_xor(p, 2); p += __shfl_xor(p, 4); p += __shfl_xor(p, 8);
                    if (dq == 0 && j < 129) SC[h * 132 + j] = p; } }
            __syncthreads();
            for (int hh = 0; hh < 2; ++hh) { const int h = 2 * w + hh; const float sink = sinks[h] * LOG2E;
                const float s0 = SC[h * 132 + lane], s1 = SC[h * 132 + 64 + lane], s2 = lane == 0 ? SC[h * 132 + 128] : -3.0e38f;
                const float mx = fmaxf(wave_max(fmaxf(fmaxf(s0, s1), s2)), sink);
                const float p0 = __builtin_amdgcn_exp2f(s0 - mx), p1 = __builtin_amdgcn_exp2f(s1 - mx), p2 = lane == 0 ? __builtin_amdgcn_exp2f(s2 - mx) : 0.f;
                const float inv = 1.f / (wave_sum(p0 + p1 + p2) + __builtin_amdgcn_exp2f(sink - mx));
                SC[h * 132 + lane] = p0 * inv; SC[h * 132 + 64 + lane] = p1 * inv; if (lane == 0) SC[h * 132 + 128] = p2 * inv; }
            __syncthreads();
        } else {
            const int h = tid >> 5, d2 = tid & 31, kvh = h >> 2; float o0 = 0.f, o1 = 0.f;
#pragma unroll 4
            for (int j = 0; j < 129; ++j) { const float p = SC[h * 132 + j]; const f32x2 v = *(const LAS f32x2*)(KV + j * 256 + kvh * 64 + 2 * d2); o0 += p * v.x; o1 += p * v.y; }
            *(unsigned*)(AO + (size_t)(MP + b) * 1024 + h * 64 + 2 * d2) = cvt_pk_bf16(o0, o1);
            __syncthreads();
        }
    }
}

__device__ __forceinline__ void ret_sample_unit(const Ctx& C, int unit, const float* SQ, const float* state, const bf16* Gt, float* out, bf16* UB) {
    const int b = unit >> 2, h = unit & 3, tid = otid(), lane_ = tid & 63;
    LAS float* QK = (LAS float*)(C.lds);
    LAS float* RED = (LAS float*)(C.lds + 2048);
    LAS float* R2 = (LAS float*)(C.lds + 2048 + 8192);
    QK[tid] = SQ[(size_t)b * 4096 + (tid < 256 ? h * 256 + tid : 1024 + h * 256 + (tid - 256))];
    const int rg = tid >> 7, c4 = tid & 127;
    const f32x4 v4 = ld4(SQ + (size_t)b * 4096 + 2048 + h * 512 + 4 * c4);
    __syncthreads();
    const float gh = __builtin_amdgcn_exp2f(lg2g(h));
    const float* S = state + ((size_t)(b * 4 + h) * 256) * 512 + 4 * c4; float* So = out + O_RETS + ((size_t)(b * 4 + h) * 256) * 512 + 4 * c4;
    f32x4 a = (f32x4){0.f, 0.f, 0.f, 0.f};
    for (int it = 0; it < 64; it += 8) { f32x4 s[8];
#pragma unroll
        for (int k = 0; k < 8; ++k) s[k] = ld4(S + (size_t)((it + k) * 4 + rg) * 512);
#pragma unroll
        for (int k = 0; k < 8; ++k) { const int d = (it + k) * 4 + rg; const f32x4 sn = s[k] * gh + v4 * QK[256 + d]; st4(So + (size_t)d * 512, sn); a += sn * QK[d]; } }
    *(LAS f32x4*)(RED + rg * 512 + 4 * c4) = a;
    __syncthreads();
    f32x4 o = (f32x4){0.f, 0.f, 0.f, 0.f};
    if (tid < 128) { o = *(LAS f32x4*)(RED + 4 * tid) + *(LAS f32x4*)(RED + 512 + 4 * tid) + *(LAS f32x4*)(RED + 1024 + 4 * tid) + *(LAS f32x4*)(RED + 1536 + 4 * tid);
        const float s1 = wave_sum((o[0] + o[1]) + (o[2] + o[3])); if (lane_ == 0) R2[C.wave] = s1; }
    __syncthreads();
    const float mu = (R2[0] + R2[1]) * (1.f / 512.f);
    if (tid < 128) { const f32x4 dd = o - mu; const float s2 = wave_sum((dd[0] * dd[0] + dd[1] * dd[1]) + (dd[2] * dd[2] + dd[3] * dd[3])); if (lane_ == 0) R2[8 + C.wave] = s2; }
    __syncthreads();
    if (tid < 128) { const float rstd = __builtin_amdgcn_rsqf((R2[8] + R2[9]) * (1.f / 512.f) + EPS);
        const u32x2 gw = *(const u32x2*)(Gt + (size_t)(MP + b) * 2048 + h * 512 + 4 * tid);
        u32x2 wv; wv.x = cvt_pk_bf16(bflo(gw.x) * (o[0] - mu) * rstd, bfhi(gw.x) * (o[1] - mu) * rstd); wv.y = cvt_pk_bf16(bflo(gw.y) * (o[2] - mu) * rstd, bfhi(gw.y) * (o[3] - mu) * rstd);
        *(u32x2*)(UB + (size_t)(MP + b) * 2048 + h * 512 + 4 * tid) = wv; }
    __syncthreads();
}

__device__ __forceinline__ void xs_sample_unit(const Ctx& C, int unit, const bf16* QX, const float* cmk, const float* cmv, bf16* OX) {
    const int b = unit >> 2, h = unit & 3, tid = otid(), lane = tid & 63, w = C.wave;
    LAS float* SC = (LAS float*)(C.lds);
    LAS float* RED = (LAS float*)(C.lds + 1024);
    const u32x2 qw = *(const u32x2*)(QX + (size_t)(MP + b) * 1024 + h * 256 + 4 * lane);
    const f32x4 q4 = (f32x4){bflo(qw.x), bfhi(qw.x), bflo(qw.y), bfhi(qw.y)};
    const float* Kp = cmk + ((size_t)b * 256) * 1024 + h * 256 + 4 * lane; const float* Vp = cmv + ((size_t)b * 256) * 1024 + h * 256 + 4 * lane;
    for (int i0 = 0; i0 < 32; i0 += 8) { f32x4 k[8];
#pragma unroll
        for (int k8 = 0; k8 < 8; ++k8) k[k8] = ld4(Kp + (size_t)(w * 32 + i0 + k8) * 1024);
#pragma unroll
        for (int k8 = 0; k8 < 8; ++k8) { const float p = wave_sum((q4[0] * k[k8][0] + q4[1] * k[k8][1]) + (q4[2] * k[k8][2] + q4[3] * k[k8][3])); if (lane == 0) SC[w * 32 + i0 + k8] = p; } }
    __syncthreads();
    const float mx = wave_max(fmaxf(fmaxf(SC[lane], SC[64 + lane]), fmaxf(SC[128 + lane], SC[192 + lane])));
    const float sum = wave_sum((__builtin_amdgcn_exp2f(SC[lane] - mx) + __builtin_amdgcn_exp2f(SC[64 + lane] - mx)) + (__builtin_amdgcn_exp2f(SC[128 + lane] - mx) + __builtin_amdgcn_exp2f(SC[192 + lane] - mx)));
    f32x4 a = (f32x4){0.f, 0.f, 0.f, 0.f};
    for (int i0 = 0; i0 < 32; i0 += 8) { f32x4 v[8];
#pragma unroll
        for (int k8 = 0; k8 < 8; ++k8) v[k8] = ld4(Vp + (size_t)(w * 32 + i0 + k8) * 1024);
#pragma unroll
        for (int k8 = 0; k8 < 8; ++k8) a += v[k8] * __builtin_amdgcn_exp2f(SC[w * 32 + i0 + k8] - mx); }
    *(LAS f32x4*)(RED + w * 256 + 4 * lane) = a;
    __syncthreads();
    if (tid < 64) { f32x4 o = (f32x4){0.f, 0.f, 0.f, 0.f};
#pragma unroll
        for (int k = 0; k < 8; ++k) o += *(LAS f32x4*)(RED + k * 256 + 4 * tid);
        const float inv = 1.f / sum; u32x2 wv; wv.x = cvt_pk_bf16(o[0] * inv, o[1] * inv); wv.y = cvt_pk_bf16(o[2] * inv, o[3] * inv);
        *(u32x2*)(OX + (size_t)(MP + b) * 1024 + h * 256 + 4 * tid) = wv; }
    __syncthreads();
}

enum { PH_PRO = 0, PH_R_IN, PH_R_PU, PH_R_SCAN, PH_R_O, PH_R_NORM, PH_R_OUT, PH_C0,
       PH_S_QKV = PH_C0 + 6, PH_S_ATT, PH_S_OUT, PH_C1, PH_V_IN = PH_C1 + 6, PH_V_MIX, PH_V_OUT, PH_C2, PH_P_MIX = PH_C2 + 6, PH_P_OUT, PH_C3, PH_FINAL = PH_C3 + 6, NPH };

struct KS { unsigned char* ws; float* out; int lo, hi, G, bx; };
#define IN(k) (K.lo <= (k) && (k) < K.hi)
#define SEAM(k) do { if (MK_ONE_LAUNCH && IN(k) && IN((k) + 1)) xcd_barrier(bar); } while (0)
#define ROT(n) ((K.bx + (n)) % K.G)

template <int L, int BASE>
__device__ __forceinline__ void common_layer(const Ctx& C, const Args& args, const KS& K, const XcdBarrier& bar) {
    unsigned char* ws = K.ws; LAS unsigned char* ring = C.lds + RING_OFF; const int G = K.G;
    u64* SS = (u64*)(ws + WS_SS); float* xf = K.out; bf16* XB = (bf16*)(ws + WS_XB);
    if (IN(BASE + 0)) {
        Gemm g{XB, (const bf16*)(ws + W_XQ + (size_t)L * 1048576 * 2), 1024, 1024, 1024};
        pg8::Sched<DecGrid> S{NPAN * 4, G, K.bx, DecGrid{NPAN, 4, 0u, 262144u, 0u, 0u, 0u, 262144u}};
        EpiScale E{SS + (size_t)(3 * L + 1) * MT, LOG2E * 0.0625f, (bf16*)(ws + WS_Q), 1024};
        pg8::gemm_phase<EpiScale, pg8::Sched<DecGrid>>(ring, g, S, E, C.wave);
    }
    SEAM(BASE + 0);
    if (IN(BASE + 1)) {
        {
            Gemm g{(const bf16*)(ws + WS_Q), (const bf16*)(ws + WS_MK), 1024, 1024, 256};
            pg8::Sched<DecXS> S{256, G, K.bx, DecXS{L}};
            EpiSoftmax E{(bf16*)(ws + WS_PX), (LAS float*)(C.lds + EPIX_OFF)};
            pg8::gemm_phase<EpiSoftmax, pg8::Sched<DecXS>>(ring, g, S, E, C.wave);
        }
        __syncthreads();
        for (int un = C.vcu; un < 512; un += G)
            xs_sample_unit(C, un, (const bf16*)(ws + WS_Q), args.in[I_CMK] + (size_t)L * 128 * 256 * 1024, args.in[I_CMV] + (size_t)L * 128 * 256 * 1024, (bf16*)(ws + WS_OX));
    }
    SEAM(BASE + 1);
    if (IN(BASE + 2)) {
        Gemm g{(const bf16*)(ws + WS_PX), (const bf16*)(ws + WS_MVT), 1024, 256, 256};
        pg8::Sched<DecXPV> S{256, G, K.bx, DecXPV{L}};
        EpiPlain E{(bf16*)(ws + WS_OX), 1024};
        pg8::gemm_phase<EpiPlain, pg8::Sched<DecXPV>>(ring, g, S, E, C.wave);
    }
    SEAM(BASE + 2);
    if (IN(BASE + 3)) {
        Gemm g{(const bf16*)(ws + WS_OX), (const bf16*)(ws + W_XO + (size_t)L * 1048576 * 2), 1024, 1024, 1024};
        pg8::Sched<DecGrid> S{NPAN * 4, G, K.bx, DecGrid{NPAN, 4, 0u, 262144u, 0u, 0u, 0u, 262144u}};
        EpiResidual E{xf, xf + (size_t)MP * 1024, xf, XB, SS + (size_t)(3 * L + 2) * MT};
        pg8::gemm_phase<EpiResidual, pg8::Sched<DecGrid>>(ring, g, S, E, C.wave);
    }
    SEAM(BASE + 3);
    if (IN(BASE + 4)) {
        Gemm g{XB, (const bf16*)(ws + W_FIN + (size_t)L * 1024 * 5632 * 2), 1024, 1024, 1024};
        pg8::Sched<DecGrid> S{NPAN * 22, G, K.bx, DecGrid{NPAN, 22, 0u, 262144u, 0u, 0u, 0u, 262144u}};
        EpiSwiGLU E{SS + (size_t)(3 * L + 2) * MT, (bf16*)(ws + WS_HF)};
        pg8::gemm_phase<EpiSwiGLU, pg8::Sched<DecGrid>>(ring, g, S, E, C.wave);
    }
    SEAM(BASE + 4);
    if (IN(BASE + 5)) {
        Gemm g{(const bf16*)(ws + WS_HF), (const bf16*)(ws + W_FOUT + (size_t)L * 2816 * 1024 * 2), DFF, DFF, DFF};
        pg8::Sched<DecGrid> S{NPAN * 4, G, K.bx, DecGrid{NPAN, 4, 0u, 256u * DFF, 0u, 0u, 0u, 256u * DFF}};
        EpiResidual E{xf, xf + (size_t)MP * 1024, xf, XB, SS + (size_t)(3 * L + 3) * MT};
        pg8::gemm_phase<EpiResidual, pg8::Sched<DecGrid>>(ring, g, S, E, C.wave);
    }
    SEAM(BASE + 5);
}

__global__ void __launch_bounds__(512, 2) hybrid_fwd(Args args) {
    extern __shared__ __attribute__((aligned(16))) unsigned char lds_raw[];
    Ctx C; C.lds = (LAS unsigned char*)lds_raw; C.wave = __builtin_amdgcn_readfirstlane((int)threadIdx.x >> 6);
    C.G = gridDim.x; { const int bx = blockIdx.x; C.vcu = (C.G % 8 == 0) ? (bx % 8) * (C.G / 8) + bx / 8 : bx; }
    unsigned char* ws = args.ws;
    volatile LAS unsigned* MISC = (volatile LAS unsigned*)(C.lds + MISC_OFF);
    for (int u = threadIdx.x; u < (LDS_BYTES - LDSCTL_OFF) / 4; u += 512) ((LAS unsigned*)(C.lds + LDSCTL_OFF))[u] = 0u;
    __syncthreads();
    XcdBarrier bar; bar.bar = (unsigned*)(ws + WS_CTL) + 4096; bar.x = 0; bar.st = nullptr;
    if (MK_ONE_LAUNCH) bar = xcd_barrier_post((unsigned*)(ws + WS_CTL) + 4096, MISC + 8);
    KS K; K.ws = ws; K.out = args.out; K.lo = args.ph_lo; K.hi = args.ph_hi; K.G = C.G; K.bx = (int)blockIdx.x;
    const int G = C.G;
    LAS unsigned char* ring = C.lds + RING_OFF;
    u64* SS = (u64*)(ws + WS_SS); u64* ST = (u64*)(ws + WS_ST); float* xf = args.out; bf16* XB = (bf16*)(ws + WS_XB);
    const int gw = C.vcu * 8 + C.wave, NGW = G * 8, NGT = G * 512;

    if (IN(PH_PRO)) {
        if (DBG_LAST < 1000) { const int gt0 = C.vcu * 512 + otid(); GAS u32x4* o4 = (GAS u32x4*)args.out; for (size_t e = gt0; e < O_END / 4; e += (size_t)NGT) o4[e] = (u32x4){0u, 0u, 0u, 0u}; }
        p0_prologue(C, args); }
    SEAM(PH_PRO);

    if (IN(PH_R_IN)) {
        {
            Gemm g{XB, (const bf16*)(ws + W_RET_IN), 1024, 1024, 1024};
            pg8::Sched<DecGrid> S{NPAN * 16, G, K.bx, DecGrid{NPAN, 16, 0u, 262144u, 0u, 0u, 0u, 262144u}};
            EpiRetIn E{SS, (const float*)(ws + T_CR), (const float*)(ws + T_SR), (bf16*)(ws + WS_Q), (bf16*)(ws + WS_KB), (bf16*)(ws + WS_APQ), (bf16*)(ws + WS_G), (float*)(ws + WS_SQ)};
            pg8::gemm_phase<EpiRetIn, pg8::Sched<DecGrid>>(ring, g, S, E, C.wave);
        }
        {
            Gemm g{XB, (const bf16*)(ws + W_RET_IN), 1024, 1024, 1024};
            pg8::Sched<DecGrid> S{8, G, ROT(16), DecGrid{1, 8, 64u * 262144u, 0u, 0u, 4096u * 1024u, 0u, 262144u}};
            EpiRetVs E{SS, (float*)(ws + WS_SQ)};
            pg8::gemm_phase<EpiRetVs, pg8::Sched<DecGrid>>(ring, g, S, E, C.wave);
        }
        {
            Gemm g{(const bf16*)(ws + W_RET_IN), XB, 1024, 1024, 1024};
            pg8::Sched<DecGrid> S{256, G, ROT(24), DecGrid{4, 64, 1024u * 1024u, 262144u, 0u, 0u, 0u, 262144u}};
            EpiRetKT E{SS, (const float*)(ws + T_CRT), (const float*)(ws + T_SRT), (bf16*)(ws + WS_KT)};
            pg8::gemm_phase<EpiRetKT, pg8::Sched<DecGrid>>(ring, g, S, E, C.wave);
        }
        {
            Gemm g{(const bf16*)(ws + W_RET_IN), XB, 1024, 1024, 1024};
            pg8::Sched<DecGrid> S{512, G, ROT(24), DecGrid{8, 64, 4096u * 1024u, 262144u, 0u, 0u, 0u, 262144u}};
            EpiRetVT E{SS, (bf16*)(ws + WS_VS)};
            pg8::gemm_phase<EpiRetVT, pg8::Sched<DecGrid>>(ring, g, S, E, C.wave);
        }
        {
            Gemm g{(const bf16*)(ws + WS_MEMN), (const bf16*)(ws + W_XKV), 1024, 1024, 1024};
            pg8::Sched<DecMem> S{64, G, ROT(24), DecMem{}};
            EpiMemKV E{args.out, (bf16*)(ws + WS_MK)};
            pg8::gemm_phase<EpiMemKV, pg8::Sched<DecMem>>(ring, g, S, E, C.wave);
        }
        {
            Gemm g{(const bf16*)(ws + W_XKV), (const bf16*)(ws + WS_MEMN), 1024, 1024, 1024};
            pg8::Sched<DecMemT> S{32, G, ROT(88), DecMemT{}};
            EpiMemVT E{(bf16*)(ws + WS_MVT)};
            pg8::gemm_phase<EpiMemVT, pg8::Sched<DecMemT>>(ring, g, S, E, C.wave);
        }
    }
    SEAM(PH_R_IN);
    if (IN(PH_R_PU)) {
        {
            Gemm g{(const bf16*)(ws + WS_Q), (const bf16*)(ws + WS_KB), 1024, 1024, 256};
            pg8::Sched<DecGrid> S{256, G, K.bx, DecGrid{64, 4, 0u, 262144u, 256u, 0u, 262144u, 256u}};
            EpiP E{(bf16*)(ws + WS_APQ)};
            pg8::gemm_phase<EpiP, pg8::Sched<DecGrid>>(ring, g, S, E, C.wave);
        }
        {
            Gemm g{(const bf16*)(ws + WS_VS), (const bf16*)(ws + WS_KT), 512, 8192, 256};
            pg8::Sched<DecU> S{512, G, K.bx, DecU{}};
            EpiU E{(float*)(ws + WS_U)};
            pg8::gemm_phase<EpiU, pg8::Sched<DecU>>(ring, g, S, E, C.wave);
        }
        __syncthreads();
        for (int un = C.vcu; un < 512; un += G) ret_sample_unit(C, un, (const float*)(ws + WS_SQ), args.in[I_SRET], (const bf16*)(ws + WS_G), args.out, (bf16*)(ws + WS_UB));
    }
    SEAM(PH_R_PU);
    if (IN(PH_R_SCAN)) {
        const float* U = (const float*)(ws + WS_U); bf16* VS = (bf16*)(ws + WS_VS); const int gt = C.vcu * 512 + otid();
        for (int item = gt; item < 262144; item += NGT) { const int d4 = item & 63, v = (item >> 6) & 511, bh = item >> 15, h = bh & 3;
            const float gC = __builtin_amdgcn_exp2f(256.f * lg2g(h)); f32x4 s = (f32x4){0.f, 0.f, 0.f, 0.f};
            for (int c0 = 0; c0 < 32; c0 += 8) { f32x4 uu[8];
#pragma unroll
                for (int k = 0; k < 8; ++k) uu[k] = ld4(U + ((size_t)(bh * 32 + c0 + k) * 512 + v) * 256 + 4 * d4);
#pragma unroll
                for (int k = 0; k < 8; ++k) { u32x2 wv; wv.x = cvt_pk_bf16(s[0], s[1]); wv.y = cvt_pk_bf16(s[2], s[3]);
                    *(u32x2*)(VS + ((size_t)(bh * 32 + c0 + k) * 512 + v) * 512 + 256 + 4 * d4) = wv; s = s * gC + uu[k]; } }
#pragma unroll
            for (int e = 0; e < 4; ++e) args.out[O_RETP + ((size_t)bh * 256 + 4 * d4 + e) * 512 + v] = s[e]; }
    }
    SEAM(PH_R_SCAN);
    if (IN(PH_R_O)) {
        Gemm g{(const bf16*)(ws + WS_APQ), (const bf16*)(ws + WS_VS), 512, 512, 512};
        pg8::Sched<DecO> S{512, G, K.bx, DecO{}};
        EpiO E{(bf16*)(ws + WS_O), ST};
        pg8::gemm_phase<EpiO, pg8::Sched<DecO>>(ring, g, S, E, C.wave);
    }
    SEAM(PH_R_O);
    if (IN(PH_R_NORM)) {
        const bf16* O = (const bf16*)(ws + WS_O); const bf16* Gt = (const bf16*)(ws + WS_G); bf16* UB = (bf16*)(ws + WS_UB); const int lane_ = otid() & 63;
        for (int row = gw; row < MP; row += NGW) {
#pragma unroll
            for (int h = 0; h < 4; ++h) { const float mu = from_fx(ST[(size_t)row * 8 + 2 * h]) * (1.f / 512.f); const float var = fmaxf(from_fx(ST[(size_t)row * 8 + 2 * h + 1]) * (1.f / 512.f) - mu * mu, 0.f);
                const float rstd = __builtin_amdgcn_rsqf(var + EPS); const size_t o = (size_t)row * 2048 + h * 512 + 8 * lane_;
                const u32x4 ov = *(const u32x4*)(O + o), gv = *(const u32x4*)(Gt + o); u32x4 r;
#pragma unroll
                for (int k = 0; k < 4; ++k) r[k] = cvt_pk_bf16(bflo(gv[k]) * (bflo(ov[k]) - mu) * rstd, bfhi(gv[k]) * (bfhi(ov[k]) - mu) * rstd);
                *(u32x4*)(UB + o) = r; } }
    }
    SEAM(PH_R_NORM);
    if (IN(PH_R_OUT)) {
        Gemm g{(const bf16*)(ws + WS_UB), (const bf16*)(ws + W_RET_OUT), 2048, 2048, 2048};
        pg8::Sched<DecGrid> S{NPAN * 4, G, K.bx, DecGrid{NPAN, 4, 0u, 256u * 2048u, 0u, 0u, 0u, 256u * 2048u}};
        EpiResidual E{args.in[I_XP], args.in[I_XS], xf, XB, SS + (size_t)1 * MT};
        pg8::gemm_phase<EpiResidual, pg8::Sched<DecGrid>>(ring, g, S, E, C.wave);
    }
    SEAM(PH_R_OUT);
    common_layer<0, PH_C0>(C, args, K, bar);

    if (IN(PH_S_QKV)) {
        {
            Gemm g{XB, (const bf16*)(ws + W_SWA_QKV), 1024, 1024, 1024};
            pg8::Sched<DecGrid> S{NPAN * 6, G, K.bx, DecGrid{NPAN, 6, 0u, 262144u, 0u, 0u, 0u, 262144u}};
            EpiSwaQKV E{SS + (size_t)3 * MT, (const float*)(ws + T_CS), (const float*)(ws + T_SN), (bf16*)(ws + WS_Q), (bf16*)(ws + WS_KB), (float*)(ws + WS_SQ), args.out};
            pg8::gemm_phase<EpiSwaQKV, pg8::Sched<DecGrid>>(ring, g, S, E, C.wave);
        }
        {
            Gemm g{(const bf16*)(ws + W_SWA_QKV), XB, 1024, 1024, 1024};
            pg8::Sched<DecGrid> S{64, G, ROT(134), DecGrid{1, 64, 1280u * 1024u, 0u, 0u, 0u, 0u, 262144u}};
            EpiSwaVT E{SS + (size_t)3 * MT, (bf16*)(ws + WS_KT)};
            pg8::gemm_phase<EpiSwaVT, pg8::Sched<DecGrid>>(ring, g, S, E, C.wave);
        }
    }
    SEAM(PH_S_QKV);
    if (IN(PH_S_ATT)) {
        for (int un = C.vcu; un < 512; un += G) swa_unit(C, un, (const bf16*)(ws + WS_Q), (const bf16*)(ws + WS_KB), (const bf16*)(ws + WS_KT), args.in[I_SINK], (bf16*)(ws + WS_OX));
        __syncthreads();
        for (int b = G - 1 - C.vcu; b < 128; b += G) swa_sample_unit(C, b, (const float*)(ws + WS_SQ), args.in[I_CSK], args.in[I_CSV], args.in[I_SINK], args.out, (bf16*)(ws + WS_OX));
    }
    SEAM(PH_S_ATT);
    if (IN(PH_S_OUT)) {
        Gemm g{(const bf16*)(ws + WS_OX), (const bf16*)(ws + W_SWA_O), 1024, 1024, 1024};
        pg8::Sched<DecGrid> S{NPAN * 4, G, K.bx, DecGrid{NPAN, 4, 0u, 262144u, 0u, 0u, 0u, 262144u}};
        EpiResidual E{xf, xf + (size_t)MP * 1024, xf, XB, SS + (size_t)4 * MT};
        pg8::gemm_phase<EpiResidual, pg8::Sched<DecGrid>>(ring, g, S, E, C.wave);
    }
    SEAM(PH_S_OUT);
    common_layer<1, PH_C1>(C, args, K, bar);

    if (IN(PH_V_IN)) {
        Gemm g{XB, (const bf16*)(ws + W_CONV_IN), 1024, 1024, 1024};
        pg8::Sched<DecGrid> S{NPAN * 12, G, K.bx, DecGrid{NPAN, 12, 0u, 262144u, 0u, 0u, 0u, 262144u}};
        EpiConvIn E{SS + (size_t)6 * MT, (bf16*)(ws + WS_Q), (bf16*)(ws + WS_KB), args.out};
        pg8::gemm_phase<EpiConvIn, pg8::Sched<DecGrid>>(ring, g, S, E, C.wave);
    }
    SEAM(PH_V_IN);
    if (IN(PH_V_MIX)) {
        const bf16* BG = (const bf16*)(ws + WS_Q); const bf16* CI = (const bf16*)(ws + WS_KB); bf16* UB = (bf16*)(ws + WS_UB); const float* cw = args.in[I_CW]; const int lane_ = otid() & 63;
        for (int row = gw; row < MREAL; row += NGW) {
#pragma unroll
            for (int hf = 0; hf < 2; ++hf) { const int col = hf * 512 + 8 * lane_; float c0[8], c1[8], c2[8];
                if (row < MP) { const int t = row & 8191;
                    const u32x4 z = (u32x4){0u, 0u, 0u, 0u};
                    const u32x4 a0 = t >= 2 ? *(const u32x4*)(CI + (size_t)(row - 2) * 1024 + col) : z, a1 = t >= 1 ? *(const u32x4*)(CI + (size_t)(row - 1) * 1024 + col) : z, a2 = *(const u32x4*)(CI + (size_t)row * 1024 + col);
#pragma unroll
                    for (int k = 0; k < 4; ++k) { c0[2 * k] = bflo(a0[k]); c0[2 * k + 1] = bfhi(a0[k]); c1[2 * k] = bflo(a1[k]); c1[2 * k + 1] = bfhi(a1[k]); c2[2 * k] = bflo(a2[k]); c2[2 * k + 1] = bfhi(a2[k]); }
                } else { const int b = row - MP; const float* sc = args.in[I_SCONV] + (size_t)b * 2048 + col; const float* cn = args.out + O_CONVS + ((size_t)b * 2 + 1) * 1024 + col; float* co = args.out + O_CONVS + ((size_t)b * 2) * 1024 + col;
#pragma unroll
                    for (int k = 0; k < 8; ++k) { c0[k] = sc[k]; c1[k] = sc[1024 + k]; c2[k] = cn[k]; co[k] = c1[k]; } }
                const u32x4 bgv = *(const u32x4*)(BG + (size_t)row * 1024 + col); float o[8];
#pragma unroll
                for (int k = 0; k < 8; ++k) { const float bgk = (k & 1) ? bfhi(bgv[k >> 1]) : bflo(bgv[k >> 1]); o[k] = bgk * (cw[col + k] * c0[k] + cw[1024 + col + k] * c1[k] + cw[2048 + col + k] * c2[k]); }
                u32x4 r; r.x = cvt_pk_bf16(o[0], o[1]); r.y = cvt_pk_bf16(o[2], o[3]); r.z = cvt_pk_bf16(o[4], o[5]); r.w = cvt_pk_bf16(o[6], o[7]);
                *(u32x4*)(UB + (size_t)row * 1024 + col) = r; } }
    }
    SEAM(PH_V_MIX);
    if (IN(PH_V_OUT)) {
        Gemm g{(const bf16*)(ws + WS_UB), (const bf16*)(ws + W_CONV_OUT), 1024, 1024, 1024};
        pg8::Sched<DecGrid> S{NPAN * 4, G, K.bx, DecGrid{NPAN, 4, 0u, 262144u, 0u, 0u, 0u, 262144u}};
        EpiResidual E{xf, xf + (size_t)MP * 1024, xf, XB, SS + (size_t)7 * MT};
        pg8::gemm_phase<EpiResidual, pg8::Sched<DecGrid>>(ring, g, S, E, C.wave);
    }
    SEAM(PH_V_OUT);
    common_layer<2, PH_C2>(C, args, K, bar);

    if (IN(PH_P_MIX)) {
        const u64* ss = SS + (size_t)9 * MT; const float* ng = args.in[I_NG] + 9 * 1024; bf16* UB = (bf16*)(ws + WS_UB); const int lane_ = otid() & 63;
        for (int item = gw; item < MREAL * 4; item += NGW) { const int row = item >> 2, gi = item & 3, w = 2 << gi, col = gi * 256 + 4 * lane_;
            const f32x4 g4 = ld4(ng + col); const f32x4 hn = ld4(xf + (size_t)row * 1024 + col) * rstd_of(ss[row]) * g4; f32x4 sum = hn; float cnt;
            if (row < MP) { const int t = row & 8191; const int n = (t + 1 < w) ? t + 1 : w; cnt = (float)n;
                for (int j = 1; j < n; ++j) sum += ld4(xf + (size_t)(row - j) * 1024 + col) * rstd_of(ss[row - j]) * g4;
                if (t >= 8177) st4(args.out + O_POOLP + ((size_t)(row >> 13) * 15 + (t - 8177)) * 1024 + col, hn);
            } else { const int b = row - MP; cnt = (float)w; const float* sp = args.in[I_SPOOL] + (size_t)b * 15 * 1024 + col;
                for (int j = 1; j < w; ++j) sum += ld4(sp + (size_t)(15 - j) * 1024);
                if (gi == 0) { }
                float* po = args.out + O_POOLS + (size_t)b * 15 * 1024 + col;
                for (int i = 0; i < 14; ++i) st4(po + (size_t)i * 1024, ld4(sp + (size_t)(i + 1) * 1024));
                st4(po + (size_t)14 * 1024, hn); }
            const f32x4 dd = sum * (1.f / cnt) - hn; u32x2 wv; wv.x = cvt_pk_bf16(dd[0], dd[1]); wv.y = cvt_pk_bf16(dd[2], dd[3]);
            *(u32x2*)(UB + (size_t)row * 1024 + col) = wv; }
    }
    SEAM(PH_P_MIX);
    if (IN(PH_P_OUT)) {
        Gemm g{(const bf16*)(ws + WS_UB), (const bf16*)(ws + W_POOL), 1024, 256, 256};
        pg8::Sched<DecGrid> S{NPAN * 4, G, K.bx, DecGrid{NPAN, 4, 0u, 262144u, 256u, 0u, 0u, 65536u}};
        EpiResidual E{xf, xf + (size_t)MP * 1024, xf, XB, SS + (size_t)10 * MT};
        pg8::gemm_phase<EpiResidual, pg8::Sched<DecGrid>>(ring, g, S, E, C.wave);
    }
    SEAM(PH_P_OUT);
    common_layer<3, PH_C3>(C, args, K, bar);

    if (IN(PH_FINAL)) {
        const u64* ss = SS + (size_t)12 * MT; const float* fg = args.in[I_FNG]; const int lane_ = otid() & 63;
        for (int row = gw; row < MREAL; row += NGW) { const float r = rstd_of(ss[row]); GAS f32x4* xp = (GAS f32x4*)(xf + (size_t)row * 1024) + lane_; const GAS f32x4* gp = (const GAS f32x4*)fg + lane_;
#pragma unroll
            for (int j = 0; j < 4; ++j) xp[64 * j] = xp[64 * j] * r * gp[64 * j]; }
    }
}
#undef IN
#undef SEAM

extern "C" void kernel_launch(void* const* d_in, const int* in_sizes, int n_in, void* d_out, int out_size, void* d_ws, size_t ws_size, hipStream_t stream) {
    static int grid = 0;
    if (grid == 0) {
        if (n_in != 28 || (size_t)out_size != O_END || ws_size < WS_END) { fprintf(stderr, "kernel_launch: unexpected shapes (n_in %d out %d ws %zu need %zu)\n", n_in, out_size, ws_size, (size_t)WS_END); grid = -1; return; }
        int dev = 0, cus = 0, per_cu = 0;
        if (hipGetDevice(&dev) != hipSuccess || hipDeviceGetAttribute(&cus, hipDeviceAttributeMultiprocessorCount, dev) != hipSuccess) { grid = -1; return; }
        if (hipFuncSetAttribute((const void*)hybrid_fwd, hipFuncAttributeMaxDynamicSharedMemorySize, LDS_BYTES) != hipSuccess) { fprintf(stderr, "kernel_launch: hipFuncSetAttribute failed\n"); grid = -1; return; }
        if (hipOccupancyMaxActiveBlocksPerMultiprocessor(&per_cu, (const void*)hybrid_fwd, 512, LDS_BYTES) != hipSuccess || per_cu < 1) fprintf(stderr, "kernel_launch: occupancy query reports %d\n", per_cu);
        (void)hipGetLastError();
        grid = cus;
    }
    if (grid < 0) return;
    if (hipMemsetAsync((char*)d_ws, 0, ZERO_BYTES, stream) != hipSuccess) { fprintf(stderr, "kernel_launch: memset failed\n"); return; }
    Args a{};
    for (int i = 0; i < 28; ++i) a.in[i] = (const float*)d_in[i];
    a.out = (float*)d_out; a.ws = (unsigned char*)d_ws;
#if MK_ONE_LAUNCH
    a.ph_lo = 0; a.ph_hi = (DBG_LAST < 1000) ? DBG_LAST + 1 : NPH;
    hipLaunchKernelGGL(hybrid_fwd, dim3(grid), dim3(512), LDS_BYTES, stream, a);
#else
    for (int p = 0; p < NPH; ++p) { a.ph_lo = p; a.ph_hi = p + 1; hipLaunchKernelGGL(hybrid_fwd, dim3(grid), dim3(512), LDS_BYTES, stream, a); }
#endif
    const hipError_t le = hipPeekAtLastError();
    if (le != hipSuccess) fprintf(stderr, "kernel_launch: launch failed: %s\n", hipGetErrorName(le));
}
```

```cpp
#include <hip/hip_runtime.h>
#include <cstdio>
#include <cstdint>

#ifndef MK_ONE_LAUNCH
#define MK_ONE_LAUNCH 1
#endif

#ifndef DBG_LAST
#define DBG_LAST 1000
#endif
#ifndef AMP_MASK
#define AMP_MASK 0ull
#endif
#define AMP_FACTOR 9ull
#define GAS __attribute__((address_space(1)))
#define LAS __attribute__((address_space(3)))
typedef unsigned short bf16;
typedef short bf16x8 __attribute__((ext_vector_type(8)));
typedef float f32x4 __attribute__((ext_vector_type(4)));
typedef float f32x2 __attribute__((ext_vector_type(2)));
typedef unsigned u32x4 __attribute__((ext_vector_type(4)));
typedef unsigned u32x2 __attribute__((ext_vector_type(2)));

constexpr int D = 1024, TP = 8192, MP = 2 * TP, NSMP = 128, MREAL = MP + NSMP, MT = MP + 256, NPAN = MT / 256;
constexpr int DFF = 2816;
constexpr float EPS = 1e-6f;
constexpr float LOG2E = 1.4426950408889634f;
__device__ __forceinline__ float lg2g(int h) { return h == 0 ? -0.04580368961312479f : h == 1 ? -0.02272007650008353f : h == 2 ? -0.011315313227834146f : -0.005646563141142063f; }

constexpr size_t O_Y = 0, O_YS = 16777216, O_RETP = O_YS + 131072, O_RETS = O_RETP + 1048576, O_SWKP = O_RETS + 67108864, O_SWVP = O_SWKP + 65536,
                 O_SWKS = O_SWVP + 65536, O_SWVS = O_SWKS + 4194304, O_CONVP = O_SWVS + 4194304, O_CONVS = O_CONVP + 4096, O_POOLP = O_CONVS + 262144,
                 O_POOLS = O_POOLP + 30720, O_MEMK = O_POOLS + 1966080, O_MEMV = O_MEMK + 2097152, O_END = O_MEMV + 2097152;

constexpr size_t al256(size_t x) { return (x + 255) & ~(size_t)255; }
constexpr size_t WS_CTL = 0;
constexpr size_t WS_PC = 32768;
constexpr size_t WS_PC2 = 36864;
constexpr size_t WS_SS = 1u << 20;
constexpr size_t WS_ST = WS_SS + al256((size_t)13 * MT * 8);
constexpr size_t ZERO_BYTES = al256(WS_ST + (size_t)MT * 8 * 8);
static_assert(ZERO_BYTES <= (4u << 20), "control region");
constexpr size_t WS_W = 4u << 20;
constexpr size_t W_RET_IN = WS_W, W_RET_OUT = W_RET_IN + (size_t)6144 * 1024 * 2, W_SWA_QKV = W_RET_OUT + (size_t)1024 * 2048 * 2,
                 W_SWA_O = W_SWA_QKV + (size_t)1536 * 1024 * 2, W_CONV_IN = W_SWA_O + (size_t)1024 * 1024 * 2, W_CONV_OUT = W_CONV_IN + (size_t)3072 * 1024 * 2,
                 W_POOL = W_CONV_OUT + (size_t)1024 * 1024 * 2, W_XQ = W_POOL + (size_t)4 * 256 * 256 * 2, W_XKV = W_XQ + (size_t)4 * 1024 * 1024 * 2,
                 W_XO = W_XKV + (size_t)4 * 2048 * 1024 * 2, W_FIN = W_XO + (size_t)4 * 1024 * 1024 * 2, W_FOUT = W_FIN + (size_t)4 * 5632 * 1024 * 2,
                 W_END = W_FOUT + (size_t)4 * 1024 * 2816 * 2;
constexpr size_t WS_TAB = al256(W_END);
constexpr size_t T_CR = WS_TAB, T_SR = T_CR + (size_t)8193 * 128 * 4, T_CRT = al256(T_SR + (size_t)8193 * 128 * 4), T_SRT = T_CRT + (size_t)128 * 8192 * 4,
                 T_CS = T_SRT + (size_t)128 * 8192 * 4, T_SN = al256(T_CS + (size_t)8193 * 8 * 4), T_END = al256(T_SN + (size_t)8193 * 8 * 4);
constexpr size_t WS_MEMN = T_END;
constexpr size_t WS_MK = WS_MEMN + (size_t)4 * 512 * 1024 * 2;
constexpr size_t WS_MVT = WS_MK + (size_t)4 * 512 * 1024 * 2;
constexpr size_t WS_XB = WS_MVT + (size_t)4 * 2 * 1024 * 1024 * 2;
constexpr size_t WS_Q = WS_XB + (size_t)MT * 1024 * 2;
constexpr size_t WS_KB = WS_Q + (size_t)MT * 1024 * 2;
constexpr size_t WS_G = WS_KB + (size_t)MT * 1024 * 2;
constexpr size_t WS_KT = WS_G + (size_t)MT * 2048 * 2;
constexpr size_t WS_VS = WS_KT + (size_t)256 * 256 * 512 * 2;
constexpr size_t WS_APQ = WS_VS + (size_t)256 * 512 * 512 * 2;
constexpr size_t WS_U = WS_APQ + (size_t)256 * 256 * 512 * 2;
constexpr size_t WS_O = WS_U + (size_t)256 * 512 * 256 * 4;
constexpr size_t WS_UB = WS_O + (size_t)MT * 2048 * 2;
constexpr size_t WS_PX = WS_UB + (size_t)MT * 2048 * 2;
constexpr size_t WS_OX = WS_PX + (size_t)MT * 1024 * 2;
constexpr size_t WS_HF = WS_OX + (size_t)MT * 1024 * 2;
constexpr size_t WS_SQ = WS_HF + (size_t)MT * 2816 * 2;
constexpr size_t W_XQN = WS_SQ + (size_t)128 * 4096 * 4;
constexpr size_t WS_WQK = W_XQN + (size_t)4 * 1024 * 1024 * 2;
constexpr size_t WS_VWO = WS_WQK + (size_t)8 * 1024 * 1024 * 2;
constexpr size_t WS_MV = WS_MVT;
constexpr size_t WS_END = WS_VWO + (size_t)8 * 1024 * 1024 * 2;

constexpr int RING_OFF = 0, RING_BYTES = 131072;
constexpr int EPIX_OFF = RING_BYTES;
constexpr int LDSCTL_OFF = EPIX_OFF + 16384, MISC_OFF = LDSCTL_OFF + 64;
constexpr int LDS_BYTES = LDSCTL_OFF + 256;

#define LDS_WAIT() asm volatile("s_waitcnt lgkmcnt(0)" ::: "memory")
#define VM_WAIT() asm volatile("s_waitcnt vmcnt(0)" ::: "memory")
__device__ __forceinline__ unsigned cvt_pk_bf16(float lo, float hi) { unsigned r; asm volatile("v_cvt_pk_bf16_f32 %0, %1, %2" : "=v"(r) : "v"(lo), "v"(hi)); return r; }
__device__ __forceinline__ u32x4 pack8(f32x4 a, f32x4 b) { u32x4 w; w.x = cvt_pk_bf16(a[0], a[1]); w.y = cvt_pk_bf16(a[2], a[3]); w.z = cvt_pk_bf16(b[0], b[1]); w.w = cvt_pk_bf16(b[2], b[3]); return w; }
__device__ __forceinline__ f32x4 ld4(const float* p) { return *(const f32x4*)p; }
__device__ __forceinline__ f32x4 ld4nt(const float* p) { return __builtin_nontemporal_load((const f32x4*)p); }
__device__ __forceinline__ void st4(float* p, f32x4 v) { *(f32x4*)p = v; }
__device__ __forceinline__ float bf2f(unsigned short b) { return __builtin_bit_cast(float, (unsigned)b << 16); }
__device__ __forceinline__ float bflo(unsigned w) { return __builtin_bit_cast(float, w << 16); }
__device__ __forceinline__ float bfhi(unsigned w) { return __builtin_bit_cast(float, w & 0xffff0000u); }
__device__ __forceinline__ float siluf(float x) { return x * __builtin_amdgcn_rcpf(1.f + __builtin_amdgcn_exp2f(-x * LOG2E)); }
typedef unsigned long long u64;
__device__ __forceinline__ u64 to_fx(float v) { return (u64)(long long)((double)v * 65536.0); }
__device__ __forceinline__ float from_fx(u64 v) { return (float)((double)(long long)v * (1.0 / 65536.0)); }
__device__ __forceinline__ void fx_add(u64* p, float v) { __hip_atomic_fetch_add(p, to_fx(v), __ATOMIC_RELAXED, __HIP_MEMORY_SCOPE_AGENT); }
__device__ __forceinline__ float rstd_of(u64 ss) { return __builtin_amdgcn_rsqf(from_fx(ss) * (1.f / 1024.f) + EPS); }
__device__ __forceinline__ float wave_sum(float v) {
#pragma unroll
    for (int o = 1; o < 64; o <<= 1) v += __shfl_xor(v, o);
    return v;
}
__device__ __forceinline__ float wave_max(float v) {
#pragma unroll
    for (int o = 1; o < 64; o <<= 1) v = fmaxf(v, __shfl_xor(v, o));
    return v;
}

namespace pg8 {
typedef unsigned short bf16_t;
constexpr int BM = 256, BK = 64, HALF = 128, HTB = HALF * BK * 2, STAGE_BYTES = 8 * HTB;
__host__ __device__ __forceinline__ int lds_byte(int r, int c) { const int st = (r >> 4) * 2 + (c >> 5), rr = r & 15, cc = c & 31, ob = rr * 64 + cc * 2; return st * 1024 + (ob ^ (((ob >> 9) & 1) << 5)); }
__host__ __device__ __forceinline__ void stage_rc(int b, int& R, int& C) { const int st = b / 1024, sb = b % 1024, swz = sb ^ (((sb >> 9) & 1) << 5); R = (st >> 1) * 16 + swz / 64; C = (st & 1) * 32 + (swz % 64) / 2; }
__host__ __device__ __forceinline__ int perm32(int rho) { const int n = rho >> 4, i = rho & 15; return 8 * (i >> 2) + 4 * n + (i & 3); }

struct Unit { int pm, pn; unsigned ao, bo; };
struct Gemm { const bf16_t* A; const bf16_t* Bt; int lda, ldb, K; };

struct NoSide { __device__ __forceinline__ void operator()(int) const {} };
template <class Dec, class Side = NoSide> struct Sched {
    int nwg, G, c; Dec d; Side side;
    __device__ __forceinline__ bool next(int i, Unit& u) const { const long L = (long)i * G + c; if (L >= nwg) return false; d((int)L, u); return true; }
    __device__ __forceinline__ void a_ready(const Unit&) const {}
    __device__ __forceinline__ void done(const Unit&, int ui) const { side(ui); }
};
struct DecGrid {
    int nM, nN; unsigned a0, am, an, b0, bm, bn;
    __device__ __forceinline__ void operator()(int L, Unit& u) const {
        const int nwg = nM * nN; int wgid = L; { const int q = nwg / 8, r = nwg % 8, xcd = wgid % 8, off = wgid / 8; wgid = (xcd < r ? xcd * (q + 1) : r * (q + 1) + (xcd - r) * q) + off; }
        const int nig = 8 * nN, gid = wgid / nig, fm = gid * 8, gsz = (nM - fm) < 8 ? (nM - fm) : 8;
        u.pm = fm + ((wgid % nig) % gsz); u.pn = (wgid % nig) / gsz;
        u.ao = a0 + (unsigned)u.pm * am + (unsigned)u.pn * an; u.bo = b0 + (unsigned)u.pm * bm + (unsigned)u.pn * bn;
    }
};

typedef f32x4 Acc[2][2][4][2];

template <class Epi, class SchedT, bool ALIGN_EPI = true, bool SP2 = true>
__device__ __forceinline__ void gemm_phase(LAS unsigned char* lds, const Gemm g, const SchedT& S, const Epi& E, const int wid) {
    static_assert(SP2, "only the SP2 loop is kept");
    int lane; asm volatile("v_mbcnt_lo_u32_b32 %0, -1, 0\n\tv_mbcnt_hi_u32_b32 %0, -1, %0" : "=v"(lane));
    const int tid = wid * 64 + lane, wr = wid >> 2, wc = wid & 3, fr = lane & 15, fq = lane >> 4;
    const int K = g.K, nt = K / BK;
    unsigned voffA[2], voffB[2];
#pragma unroll
    for (int i = 0; i < 2; ++i) { int R, C; stage_rc(tid * 16 + i * 8192, R, C); const int Rb = Epi::PERM ? ((R & ~31) + perm32(R & 31)) : R;
        voffA[i] = (unsigned)(R * g.lda + C) * 2u; voffB[i] = (unsigned)(Rb * g.ldb + C) * 2u; }
    const size_t kstep = (size_t)(BK * 2);
    const size_t hstepA = (size_t)HALF * g.lda * 2, hstepB = (size_t)HALF * g.ldb * 2;
    const unsigned ldsw = (unsigned)wid * 1024u;
    const int aoff = lds_byte(wr * 64 + fr, fq * 8), boff = lds_byte(wc * 32 + fr, fq * 8);
#define PG8_SA(b, h) (((b) * 2 + (h)) * HTB)
#define PG8_SB(b, h) ((4 + (b) * 2 + (h)) * HTB)
#define PG8_STAGE(bufoff, gbase, voff) do { _Pragma("unroll") for (int _i = 0; _i < 2; ++_i) \
        __builtin_amdgcn_global_load_lds((const unsigned*)((const char*)(gbase) + (voff)[_i]), (LAS unsigned*)(lds + (bufoff) + ldsw + _i * 8192), 16, 0, 0); } while (0)
#define PG8_LDA(dst, b, h) do { _Pragma("unroll") for (int m = 0; m < 4; ++m) _Pragma("unroll") for (int k = 0; k < 2; ++k) dst[m][k] = *(const LAS bf16x8*)(lds + PG8_SA(b, h) + aoff + m * 2048 + k * 1024); } while (0)
#define PG8_LDB(dst, b, h) do { _Pragma("unroll") for (int n = 0; n < 2; ++n) _Pragma("unroll") for (int k = 0; k < 2; ++k) dst[n][k] = *(const LAS bf16x8*)(lds + PG8_SB(b, h) + boff + n * 2048 + k * 1024); } while (0)
#define PG8_MMA(ai, bj, At, Bt) do { __builtin_amdgcn_s_setprio(1); _Pragma("unroll") for (int m = 0; m < 4; ++m) _Pragma("unroll") for (int n = 0; n < 2; ++n) _Pragma("unroll") for (int k = 0; k < 2; ++k) \
        acc[ai][bj][m][n] = __builtin_amdgcn_mfma_f32_16x16x32_bf16(Bt[n][k], At[m][k], acc[ai][bj][m][n], 0, 0, 0); __builtin_amdgcn_s_setprio(0); } while (0)
#define PG8_WAIT_V(n) asm volatile("s_waitcnt vmcnt(" #n ")" ::: "memory")
#define PG8_WAIT_L(n) asm volatile("s_waitcnt lgkmcnt(" #n ")" ::: "memory")
#define PG8_BAR __builtin_amdgcn_s_barrier()
#define PG8_SCHED __builtin_amdgcn_sched_barrier(0)
    Unit cur, nxt; int ui = 0;
    if (!S.next(0, cur)) return;
    f32x4 acc[2][2][4][2];
#pragma unroll
    for (int a = 0; a < 2; ++a)
#pragma unroll
        for (int b = 0; b < 2; ++b)
#pragma unroll
            for (int m = 0; m < 4; ++m)
#pragma unroll
                for (int n = 0; n < 2; ++n) acc[a][b][m][n] = (f32x4){0.f, 0.f, 0.f, 0.f};
    bf16x8 At[4][2], B0[2][2], B1[2][2];
    const char* cA = (const char*)g.A + (size_t)cur.ao * 2; const char* cB = (const char*)g.Bt + (size_t)cur.bo * 2;
    S.a_ready(cur);
    PG8_STAGE(PG8_SB(0, 0), cB, voffB); PG8_STAGE(PG8_SB(0, 1), cB + hstepB, voffB); PG8_STAGE(PG8_SA(0, 0), cA, voffA); PG8_STAGE(PG8_SA(0, 1), cA + hstepA, voffA);
    if (wr == 1) PG8_BAR;
    PG8_WAIT_V(2); PG8_BAR;
    PG8_STAGE(PG8_SB(1, 0), cB + kstep, voffB); PG8_STAGE(PG8_SA(1, 0), cA + kstep, voffA); PG8_STAGE(PG8_SB(1, 1), cB + hstepB + kstep, voffB);
    PG8_WAIT_V(6); PG8_BAR;
    for (;;) {
        const bool has_next = S.next(ui + 1, nxt);
        const char* nA = has_next ? (const char*)g.A + (size_t)nxt.ao * 2 : cA; const char* nB = has_next ? (const char*)g.Bt + (size_t)nxt.bo * 2 : cB;
        for (int t = 0; t < nt; t += 2) {
            const bool last = (t == nt - 2);
            const char* a1 = cA + (size_t)(t + 1) * kstep;
            const char* a2 = last ? nA : cA + (size_t)(t + 2) * kstep; const char* b2 = last ? nB : cB + (size_t)(t + 2) * kstep;
            const char* a3 = a2 + kstep; const char* b3 = b2 + kstep;
            if (last && has_next) S.a_ready(nxt);
            PG8_LDB(B0, 0, 0); PG8_LDB(B1, 0, 1); PG8_SCHED; PG8_LDA(At, 0, 0); PG8_STAGE(PG8_SA(1, 1), a1 + hstepA, voffA);
            PG8_WAIT_V(8); PG8_WAIT_L(0); PG8_BAR; PG8_MMA(0, 0, At, B0); PG8_MMA(0, 1, At, B1); PG8_BAR; PG8_SCHED;
            PG8_LDA(At, 0, 1); PG8_STAGE(PG8_SB(0, 0), b2, voffB); PG8_STAGE(PG8_SB(0, 1), b2 + hstepB, voffB); PG8_STAGE(PG8_SA(0, 0), a2, voffA);
            PG8_WAIT_V(8); PG8_WAIT_L(0); PG8_BAR; PG8_MMA(1, 0, At, B0); PG8_MMA(1, 1, At, B1); PG8_BAR; PG8_SCHED;
            PG8_LDB(B0, 1, 0); PG8_LDB(B1, 1, 1); PG8_SCHED; PG8_LDA(At, 1, 0); PG8_STAGE(PG8_SA(0, 1), a2 + hstepA, voffA);
            PG8_WAIT_V(8); PG8_WAIT_L(0); PG8_BAR; PG8_MMA(0, 0, At, B0); PG8_MMA(0, 1, At, B1); PG8_BAR; PG8_SCHED;
            PG8_LDA(At, 1, 1); PG8_STAGE(PG8_SB(1, 0), b3, voffB); PG8_STAGE(PG8_SB(1, 1), b3 + hstepB, voffB); PG8_STAGE(PG8_SA(1, 0), a3, voffA);
            PG8_WAIT_V(8); PG8_WAIT_L(0); PG8_BAR; PG8_MMA(1, 0, At, B0); PG8_MMA(1, 1, At, B1); PG8_BAR; PG8_SCHED;
        }
        if constexpr (ALIGN_EPI) { if (wr == 0) PG8_BAR; }
        { int ln; asm volatile("v_mbcnt_lo_u32_b32 %0, -1, 0\n\tv_mbcnt_hi_u32_b32 %0, -1, %0" : "=v"(ln));
          E(acc, cur, wr, wc, ln & 15, ln >> 4); }
        S.done(cur, ui);
        if (!has_next) break;
#pragma unroll
        for (int a = 0; a < 2; ++a)
#pragma unroll
            for (int b = 0; b < 2; ++b)
#pragma unroll
                for (int m = 0; m < 4; ++m)
#pragma unroll
                    for (int n = 0; n < 2; ++n) acc[a][b][m][n] = (f32x4){0.f, 0.f, 0.f, 0.f};
        cur = nxt; cA = nA; cB = nB; ++ui;
        if constexpr (ALIGN_EPI) { if (wr == 1) PG8_BAR; }
    }
    PG8_WAIT_V(0);
    if constexpr (!ALIGN_EPI) { if (wr == 0) PG8_BAR; }
    PG8_BAR;
#undef PG8_SA
#undef PG8_SB
#undef PG8_STAGE
#undef PG8_LDA
#undef PG8_LDB
#undef PG8_MMA
#undef PG8_WAIT_V
#undef PG8_WAIT_L
#undef PG8_BAR
#undef PG8_SCHED
}
}
using pg8::Unit; using pg8::Gemm; using pg8::Acc; using pg8::DecGrid;

#define XB_TMO      128
#define XB_XCNT(j)  (256  + 64 * (j))
#define XB_XSUB(j)  (1280 + 64 * (j))
#define XB_XGEN(j)  (2304 + 64 * (j))
#define XB_TOP      3328
#define XB_TOPGEN   3392
#define XCD_BAR_WORDS 3456
#define XB_SPIN_CAP (1u << 18)
__device__ __forceinline__ unsigned xb_ld(unsigned* p)              { return __hip_atomic_load(p, __ATOMIC_RELAXED, __HIP_MEMORY_SCOPE_AGENT); }
__device__ __forceinline__ unsigned xb_add(unsigned* p, unsigned v) { return __hip_atomic_fetch_add(p, v, __ATOMIC_RELAXED, __HIP_MEMORY_SCOPE_AGENT); }
__device__ __forceinline__ unsigned xb_xcc_id() { return (unsigned)__builtin_amdgcn_s_getreg((3 << 11) | 20) & 0xFu; }
#define XB_SPIN(cond, bar) do { unsigned _sp = 0; while (cond) { __builtin_amdgcn_s_sleep(1); \
    if ((++_sp & 255u) == 0u) { if (xb_ld(&(bar)[XB_TMO])) break; if (_sp > XB_SPIN_CAP) { atomicAdd(&(bar)[XB_TMO], 1u); break; } } } } while (0)
struct XcdBarrier { unsigned* bar; unsigned x; volatile LAS unsigned* st; };
__device__ __forceinline__ XcdBarrier xcd_barrier_post(unsigned* bar, volatile LAS unsigned* st) {
    XcdBarrier b; b.bar = bar; b.x = xb_xcc_id(); b.st = st;
    if (threadIdx.x == 0) (void)xb_add(&bar[XB_XCNT(b.x)], 1u);
    return b;
}
__device__ __forceinline__ void xcd_barrier_complete(unsigned* bar, unsigned x, unsigned& nloc, unsigned& nx) {
    const unsigned G = gridDim.x * gridDim.y * gridDim.z;
    unsigned sum, cnt, mine, sp = 0u;
    for (;;) {
        sum = 0u; cnt = 0u; mine = 0u;
#pragma unroll
        for (unsigned j = 0; j < 16; ++j) { const unsigned c = xb_ld(&bar[XB_XCNT(j)]); sum += c; cnt += (c > 0u) ? 1u : 0u; mine = (j == x) ? c : mine; }
        if (sum == G) break;
        __builtin_amdgcn_s_sleep(1);
        if ((++sp & 255u) == 0u) { if (xb_ld(&bar[XB_TMO])) break; if (sp > XB_SPIN_CAP) { atomicAdd(&bar[XB_TMO], 1u); break; } }
    }
    nloc = mine > 0u ? mine : 1u; nx = cnt > 0u ? cnt : 1u;
}
__device__ __forceinline__ void xcd_barrier(const XcdBarrier& b) {
    asm volatile("s_waitcnt vmcnt(0)" ::: "memory");
    __syncthreads();
    if (threadIdx.x == 0) {
        unsigned* bar = b.bar;
        __builtin_amdgcn_s_waitcnt(0);
        unsigned nloc = b.st[0], nx = b.st[1];
        if (nloc == 0u) { xcd_barrier_complete(bar, b.x, nloc, nx); b.st[0] = nloc; b.st[1] = nx; }
        const unsigned old = xb_add(&bar[XB_XSUB(b.x)], 1u);
        const unsigned gen = old / nloc;
        if (old + 1u == (gen + 1u) * nloc) {
            __builtin_amdgcn_fence(__ATOMIC_RELEASE, "agent");
            asm volatile("s_waitcnt vmcnt(0)" ::: "memory");
            const unsigned og = xb_add(&bar[XB_TOP], 1u);
            const unsigned tg = og / nx;
            if (og + 1u == (tg + 1u) * nx) xb_add(&bar[XB_TOPGEN], 1u);
            else XB_SPIN(xb_ld(&bar[XB_TOPGEN]) == tg, bar);
            __builtin_amdgcn_fence(__ATOMIC_ACQUIRE, "agent");
            xb_add(&bar[XB_XGEN(b.x)], 1u);
            asm volatile("s_waitcnt vmcnt(0)" ::: "memory");
        } else {
            XB_SPIN(xb_ld(&bar[XB_XGEN(b.x)]) == gen, bar);
            __builtin_amdgcn_fence(__ATOMIC_ACQUIRE, "agent");
            asm volatile("s_waitcnt vmcnt(0)" ::: "memory");
        }
    }
    __syncthreads();
}

struct Args { const float* in[28]; float* out; unsigned char* ws; int ph_lo, ph_hi; };
enum { I_XP = 0, I_XS, I_SRET, I_CSK, I_CSV, I_SCONV, I_SPOOL, I_CMK, I_CMV, I_MEM, I_NG, I_MNG, I_FNG, I_RWIN, I_RWOUT, I_SWQKV, I_SWO, I_SINK, I_CWIN, I_CW, I_CWOUT, I_PW, I_PSC, I_XWQ, I_XWKV, I_XWO, I_FWIN, I_FWOUT };

template <int I> __device__ __forceinline__ const float* kin() { const float* p = nullptr;
#if defined(__HIP_DEVICE_COMPILE__)
    auto ka = __builtin_amdgcn_kernarg_segment_ptr();
    asm volatile("s_load_dwordx2 %0, %1, %2\n\ts_waitcnt lgkmcnt(0)" : "=s"(p) : "s"(ka), "n"(I * 8));
#endif
    return p; }
#define KIN(i) kin<(i)>()
struct Ctx { LAS unsigned char* lds; int wave, vcu, G; };
__device__ __forceinline__ int olane() { int t; asm volatile("v_mbcnt_lo_u32_b32 %0, -1, 0\n\tv_mbcnt_hi_u32_b32 %0, -1, %0" : "=v"(t)); return t; }
#define otid() (C.wave * 64 + olane())

__device__ __forceinline__ void conv_item(const float* W, int K, int N, int k0, int ns0, bf16* WT, int nd0, const float* gain, const float* cs, LAS float* scr, int lane) {
    const int q = lane & 15, kq = lane >> 4;
    const f32x4 csv = cs ? ld4(cs + ns0 + 4 * q) : (f32x4){1.f, 1.f, 1.f, 1.f};
    f32x4 v[16];
#pragma unroll
    for (int i = 0; i < 16; ++i) v[i] = ld4(W + (size_t)(k0 + 4 * i + kq) * N + ns0 + 4 * q);
#pragma unroll
    for (int i = 0; i < 16; ++i) { const int kk = 4 * i + kq; const f32x4 w = v[i] * csv * (gain ? gain[k0 + kk] : 1.f); LAS float* d = scr + kk * 65 + 4 * q; d[0] = w[0]; d[1] = w[1]; d[2] = w[2]; d[3] = w[3]; }
    LDS_WAIT(); asm volatile("" ::: "memory");
    const int c = lane & 7;
#pragma unroll
    for (int j = 0; j < 8; ++j) { const int n = (lane >> 3) + 8 * j; const LAS float* sp = scr + (8 * c) * 65 + n;
        u32x4 o; o.x = cvt_pk_bf16(sp[0 * 65], sp[1 * 65]); o.y = cvt_pk_bf16(sp[2 * 65], sp[3 * 65]); o.z = cvt_pk_bf16(sp[4 * 65], sp[5 * 65]); o.w = cvt_pk_bf16(sp[6 * 65], sp[7 * 65]);
        *(GAS u32x4*)(WT + (size_t)(nd0 + n) * K + k0 + 8 * c) = o; }
    LDS_WAIT(); asm volatile("" ::: "memory");
}
__device__ __forceinline__ int map_col(int mode, int nd) {
    if (mode == 0) return nd;
    if (mode == 1) return nd < 2048 ? nd : (nd < 4096 ? nd + 2048 : nd - 2048);
    if (mode == 2) { if (nd < 1024) return nd; const int t = nd - 1024; return 1024 + ((t >> 7) & 1) * 1024 + (t >> 8) * 128 + (t & 127); }
    return ((nd >> 7) & 1) * DFF + (nd >> 8) * 128 + (nd & 127);
}

__device__ __forceinline__ void p0_prologue(const Ctx& C, const Args& a) {
    unsigned char* ws = a.ws;
    LAS float* scr = (LAS float*)(C.lds + RING_OFF + C.wave * 16896);
    const int tid_ = otid(), lane_ = tid_ & 63;
    const int gw = C.vcu * 8 + C.wave, NGW = C.G * 8;
    int cum = 0;
#define JOB(Wp, K_, N_, Nd_, dstp, mode, gainp, csp) do { const int K__ = (K_), nblk = (Nd_) / 64, items = (K__ / 64) * nblk; \
        for (int it = (gw + NGW - (cum % NGW)) % NGW; it < items; it += NGW) { const int kb = it / nblk, nb = it % nblk; \
            conv_item((Wp), K__, (N_), 64 * kb, map_col((mode), 64 * nb), (bf16*)(dstp), 64 * nb, (gainp), (csp), scr, lane_); } cum += items; } while (0)
    const float* ng = KIN(I_NG);
    JOB(KIN(I_RWIN), 1024, 6144, 6144, ws + W_RET_IN, 1, ng + 0 * 1024, (const float*)nullptr);
    JOB(KIN(I_RWOUT), 2048, 1024, 1024, ws + W_RET_OUT, 0, (const float*)nullptr, (const float*)nullptr);
    JOB(KIN(I_SWQKV), 1024, 1536, 1536, ws + W_SWA_QKV, 0, ng + 3 * 1024, (const float*)nullptr);
    JOB(KIN(I_SWO), 1024, 1024, 1024, ws + W_SWA_O, 0, (const float*)nullptr, (const float*)nullptr);
    JOB(KIN(I_CWIN), 1024, 3072, 3072, ws + W_CONV_IN, 2, ng + 6 * 1024, (const float*)nullptr);
    JOB(KIN(I_CWOUT), 1024, 1024, 1024, ws + W_CONV_OUT, 0, (const float*)nullptr, (const float*)nullptr);
    for (int gi = 0; gi < 4; ++gi)
        JOB(KIN(I_PW) + (size_t)gi * 65536, 256, 256, 256, ws + W_POOL + (size_t)gi * 65536 * 2, 0, (const float*)nullptr, KIN(I_PSC) + gi * 256);
    for (int l = 0; l < 4; ++l) {
        JOB(KIN(I_XWQ) + (size_t)l * 1048576, 1024, 1024, 1024, ws + W_XQ + (size_t)l * 1048576 * 2, 0, ng + (3 * l + 1) * 1024, (const float*)nullptr);
        JOB(KIN(I_XWKV) + (size_t)l * 2097152, 1024, 2048, 2048, ws + W_XKV + (size_t)l * 2097152 * 2, 0, (const float*)nullptr, (const float*)nullptr);
        JOB(KIN(I_XWO) + (size_t)l * 1048576, 1024, 1024, 1024, ws + W_XO + (size_t)l * 1048576 * 2, 0, (const float*)nullptr, (const float*)nullptr);
        JOB(KIN(I_FWIN) + (size_t)l * 1024 * 5632, 1024, 5632, 5632, ws + W_FIN + (size_t)l * 1024 * 5632 * 2, 3, ng + (3 * l + 2) * 1024, (const float*)nullptr);
        JOB(KIN(I_FWOUT) + (size_t)l * 2816 * 1024, 2816, 1024, 1024, ws + W_FOUT + (size_t)l * 2816 * 1024 * 2, 0, (const float*)nullptr, (const float*)nullptr);
    }
#undef JOB
    {   bf16* WN = (bf16*)(ws + W_XQN);
        for (int row = gw; row < 4096; row += NGW) { const float gsc = ng[(3 * (row >> 10) + 1) * 1024 + (row & 1023)];
            const GAS f32x4* xp = (const GAS f32x4*)(KIN(I_XWQ) + (size_t)row * 1024) + lane_; GAS unsigned long long* o8 = (GAS unsigned long long*)(WN + (size_t)row * 1024) + lane_;
#pragma unroll
            for (int j = 0; j < 4; ++j) { const f32x4 v = xp[64 * j] * gsc; o8[64 * j] = (unsigned long long)cvt_pk_bf16(v.x, v.y) | ((unsigned long long)cvt_pk_bf16(v.z, v.w) << 32); } } }
    bf16* XB = (bf16*)(ws + WS_XB); u64* SS = (u64*)(ws + WS_SS);
    for (int row = gw; row < MT; row += NGW) {
        GAS unsigned long long* o8 = (GAS unsigned long long*)(XB + (size_t)row * D) + lane_;
        if (row < MREAL) {
            const float* xr = row < MP ? KIN(I_XP) + (size_t)row * D : KIN(I_XS) + (size_t)(row - MP) * D;
            const GAS f32x4* xp = (const GAS f32x4*)xr + lane_; float s = 0.f;
#pragma unroll
            for (int j = 0; j < 4; ++j) { const f32x4 v = xp[64 * j]; s += (v.x * v.x + v.y * v.y) + (v.z * v.z + v.w * v.w);
                o8[64 * j] = (unsigned long long)cvt_pk_bf16(v.x, v.y) | ((unsigned long long)cvt_pk_bf16(v.z, v.w) << 32); }
            s = wave_sum(s); if (lane_ == 0) SS[row] = to_fx(s);
        } else {
#pragma unroll
            for (int j = 0; j < 4; ++j) o8[64 * j] = 0ull;
        }
    }
    bf16* MN = (bf16*)(ws + WS_MEMN);
    for (int row = gw; row < 512; row += NGW) {
        const GAS f32x4* xp = (const GAS f32x4*)(KIN(I_MEM) + (size_t)row * D) + lane_; f32x4 v[4]; float s = 0.f;
#pragma unroll
        for (int j = 0; j < 4; ++j) { v[j] = xp[64 * j]; s += (v[j].x * v[j].x + v[j].y * v[j].y) + (v[j].z * v[j].z + v[j].w * v[j].w); }
        const float r = __builtin_amdgcn_rsqf(wave_sum(s) * (1.f / 1024.f) + EPS);
        for (int l = 0; l < 4; ++l) { const GAS f32x4* gp = (const GAS f32x4*)(KIN(I_MNG) + l * D) + lane_;
            GAS unsigned long long* o8 = (GAS unsigned long long*)(MN + ((size_t)l * 512 + row) * D) + lane_;
#pragma unroll
            for (int j = 0; j < 4; ++j) { const f32x4 gg = gp[64 * j]; o8[64 * j] = (unsigned long long)cvt_pk_bf16(v[j].x * r * gg.x, v[j].y * r * gg.y) | ((unsigned long long)cvt_pk_bf16(v[j].z * r * gg.z, v[j].w * r * gg.w) << 32); } }
    }
    {
        const int gt = C.vcu * 512 + tid_, NGT = C.G * 512;
        float* CR = (float*)(ws + T_CR); float* SR = (float*)(ws + T_SR); float* CRT = (float*)(ws + T_CRT); float* SRT = (float*)(ws + T_SRT);
        for (int e = gt; e < 8193 * 128; e += NGT) { const int pos = e >> 7, i = e & 127;
            const double rev = (double)pos * (exp(-9.210340371976184 * (double)i / 128.0) * 0.15915494309189535);
            const float fr = (float)(rev - rint(rev)); const float c = __builtin_amdgcn_cosf(fr), s = __builtin_amdgcn_sinf(fr);
            CR[e] = c; SR[e] = s; if (pos < 8192) { CRT[(size_t)i * 8192 + pos] = c; SRT[(size_t)i * 8192 + pos] = s; } }
        float* CS = (float*)(ws + T_CS); float* SN = (float*)(ws + T_SN);
        for (int e = gt; e < 8193 * 8; e += NGT) { const int pos = e >> 3, i = e & 7;
            const double rev = (double)pos * (exp(-13.122363377404328 * (double)i / 8.0) * 0.15915494309189535); const float fr = (float)(rev - rint(rev)); CS[e] = __builtin_amdgcn_cosf(fr); SN[e] = __builtin_amdgcn_sinf(fr); }
    }
    {
        const int gt = C.vcu * 512 + tid_, NGT = C.G * 512;
        GAS u32x4* zz = (GAS u32x4*)(ws + WS_SS + (size_t)MT * 8); for (int e = gt; e < (int)((ZERO_BYTES - WS_SS - (size_t)MT * 8) / 16); e += NGT) zz[e] = (u32x4){0u, 0u, 0u, 0u};
        GAS u32x4* ub = (GAS u32x4*)(ws + WS_UB + (size_t)MREAL * 2048 * 2); for (int e = gt; e < 128 * 2048 * 2 / 16; e += NGT) ub[e] = (u32x4){0u, 0u, 0u, 0u};
        GAS u32x4* ox = (GAS u32x4*)(ws + WS_OX + (size_t)MREAL * 1024 * 2); for (int e = gt; e < 128 * 1024 * 2 / 16; e += NGT) ox[e] = (u32x4){0u, 0u, 0u, 0u};
    }
}

#define EPI_HDR static constexpr bool PERM = true, AFTER_DRAIN = false;
#define EPI_ARGS Acc& acc, const Unit& u, int wr, int wc, int fr, int fq
#define FOR_AI_M _Pragma("unroll") for (int ai = 0; ai < 2; ++ai) _Pragma("unroll") for (int m = 0; m < 4; ++m)
#define FOR_BJ _Pragma("unroll") for (int bj = 0; bj < 2; ++bj)
#define FOR_N _Pragma("unroll") for (int n = 0; n < 2; ++n)
#define TROW (ai * 128 + wr * 64 + m * 16 + fr)
#define LOAD_RSTD8(rr, ssp, rowbase) float rr[2][4]; { u64 t_[2][4]; FOR_AI_M t_[ai][m] = (ssp)[(rowbase) + TROW]; FOR_AI_M rr[ai][m] = rstd_of(t_[ai][m]); }
__device__ __forceinline__ f32x4 silu4(f32x4 v) { return (f32x4){siluf(v[0]), siluf(v[1]), siluf(v[2]), siluf(v[3])}; }
__device__ __forceinline__ void st8b(bf16* p, f32x4 a, f32x4 b) { *(u32x4*)p = pack8(a, b); }

struct EpiMemKV { EPI_HDR
    float* out; bf16* MK; bf16* MV;
    __device__ __forceinline__ void operator()(EPI_ARGS) const {
        const int c0 = wc * 32 + fq * 8; const bool isk = u.pn < 4; float* ob = out + (isk ? O_MEMK : O_MEMV);
        FOR_AI_M { const size_t row = (size_t)u.pm * 256 + TROW;
            FOR_BJ { const size_t o = row * 1024 + (u.pn & 3) * 256 + bj * 128 + c0;
                st4(ob + o, acc[ai][bj][m][0]); st4(ob + o + 4, acc[ai][bj][m][1]);
                st8b((isk ? MK : MV) + o, acc[ai][bj][m][0], acc[ai][bj][m][1]); } }
    }
};
struct EpiMemVT { EPI_HDR
    bf16* MVT;
    __device__ __forceinline__ void operator()(EPI_ARGS) const {
        const int c0 = wc * 32 + fq * 8; const int layer = u.pm >> 2, head = u.pm & 3;
        FOR_AI_M { const size_t row = ((size_t)(layer * 2 + u.pn) * 1024 + head * 256 + TROW);
            FOR_BJ st8b(MVT + row * 1024 + bj * 128 + c0, acc[ai][bj][m][0], acc[ai][bj][m][1]); }
    }
};
struct EpiRetIn { EPI_HDR
    const u64* ss; const float* CR; const float* SR; bf16* Q; bf16* KB; bf16* APQ; bf16* Gt; float* SQ;
    __device__ __forceinline__ void operator()(EPI_ARGS) const {
        const int c0 = wc * 32 + fq * 8, pn = u.pn;
        LOAD_RSTD8(rr, ss, u.pm * 256)
        FOR_AI_M { const int row = u.pm * 256 + TROW; const float r = rr[ai][m];
            if (pn < 8) {
                const bool samp = row >= MP; const int pos = samp ? 8192 : (row & 8191); const int h = pn & 3;
                f32x4 o1[2], o2[2];
                FOR_N { const f32x4 c = ld4(CR + (size_t)pos * 128 + c0 + 4 * n), s = ld4(SR + (size_t)pos * 128 + c0 + 4 * n);
                    const f32x4 x1 = acc[ai][0][m][n] * r, x2 = acc[ai][1][m][n] * r; o1[n] = x1 * c - x2 * s; o2[n] = x2 * c + x1 * s; }
                if (pn < 4) {
                    bf16* qd = Q + (size_t)row * 1024 + h * 256 + c0; st8b(qd, o1[0], o1[1]); st8b(qd + 128, o2[0], o2[1]);
                    if (!samp) { const int l = row & 255; const float dec = __builtin_amdgcn_exp2f((float)(l + 1) * lg2g(h));
                        const int bhc = ((row >> 13) * 4 + h) * 32 + ((row & 8191) >> 8);
                        bf16* ad = APQ + ((size_t)bhc * 256 + l) * 512 + 256 + c0; st8b(ad, o1[0] * dec, o1[1] * dec); st8b(ad + 128, o2[0] * dec, o2[1] * dec); }
                    else if (row < MREAL) { float* d = SQ + (size_t)(row - MP) * 4096 + h * 256 + c0; st4(d, o1[0]); st4(d + 4, o1[1]); st4(d + 128, o2[0]); st4(d + 132, o2[1]); }
                } else {
                    FOR_N { o1[n] = o1[n] * 0.0625f; o2[n] = o2[n] * 0.0625f; }
                    if (!samp) { bf16* kd = KB + (size_t)row * 1024 + h * 256 + c0; st8b(kd, o1[0], o1[1]); st8b(kd + 128, o2[0], o2[1]); }
                    else if (row < MREAL) { float* d = SQ + (size_t)(row - MP) * 4096 + 1024 + h * 256 + c0; st4(d, o1[0]); st4(d + 4, o1[1]); st4(d + 128, o2[0]); st4(d + 132, o2[1]); }
                }
            } else {
                FOR_BJ st8b(Gt + (size_t)row * 2048 + (pn - 8) * 256 + bj * 128 + c0, silu4(acc[ai][bj][m][0] * r), silu4(acc[ai][bj][m][1] * r));
            }
        }
    }
    __device__ __forceinline__ void quad(int rs, int pn, int tc, f32x4 v0, f32x4 v1, int g) const {
        const float r = rstd_of(ss[MP + rs]); v0 = v0 * r; v1 = v1 * r;
        if (pn < 8) { const f32x4 c = ld4(CR + (size_t)8192 * 128 + tc), s = ld4(SR + (size_t)8192 * 128 + tc); f32x4 o1 = v0 * c - v1 * s, o2 = v1 * c + v0 * s;
            if (pn >= 4) { o1 = o1 * 0.0625f; o2 = o2 * 0.0625f; }
            float* d = SQ + (size_t)rs * 4096 + (pn >= 4 ? 1024 : 0) + (pn & 3) * 256 + tc; st4(d, o1); st4(d + 128, o2); }
        else if (pn < 16) { bf16* d = Gt + (size_t)(MP + rs) * 2048 + (pn - 8) * 256 + tc; const f32x4 a = silu4(v0), b = silu4(v1);
            *(u32x2*)d = (u32x2){cvt_pk_bf16(a[0], a[1]), cvt_pk_bf16(a[2], a[3])}; *(u32x2*)(d + 128) = (u32x2){cvt_pk_bf16(b[0], b[1]), cvt_pk_bf16(b[2], b[3])}; }
        else { float* d = SQ + (size_t)rs * 4096 + 2048 + (pn - 16) * 256 + tc; st4(d, v0); st4(d + 128, v1); }
    }
};
struct EpiRetVs { EPI_HDR
    const u64* ss; float* SQ;
    __device__ __forceinline__ void operator()(EPI_ARGS) const {
        const int c0 = wc * 32 + fq * 8;
#pragma unroll
        for (int m = 0; m < 4; ++m) { const int rl = wr * 64 + m * 16 + fr; const float r = rstd_of(ss[MP + rl]);
            FOR_BJ { float* d = SQ + (size_t)rl * 4096 + 2048 + u.pn * 256 + bj * 128 + c0; st4(d, acc[0][bj][m][0] * r); st4(d + 4, acc[0][bj][m][1] * r); } }
    }
};
struct EpiRetKT { EPI_HDR
    const u64* ss; const float* CRT; const float* SRT; bf16* KT;
    __device__ __forceinline__ void operator()(EPI_ARGS) const {
        const int c0 = wc * 32 + fq * 8, h = u.pm; const float lg = lg2g(h);
        f32x4 sc[2][2];
        FOR_BJ FOR_N { const int tok0 = u.pn * 256 + bj * 128 + c0 + 4 * n;
#pragma unroll
            for (int e = 0; e < 4; ++e) sc[bj][n][e] = rstd_of(ss[tok0 + e]) * 0.0625f * __builtin_amdgcn_exp2f((float)(255 - ((tok0 + e) & 255)) * lg); }
        const int b = u.pn >> 5;
#pragma unroll
        for (int m = 0; m < 4; ++m) { const int i = wr * 64 + m * 16 + fr;
            f32x4 tc[2][2], ts[2][2];
            FOR_BJ FOR_N { const int t0 = ((u.pn & 31) * 256) + bj * 128 + c0; tc[bj][n] = ld4(CRT + (size_t)i * 8192 + t0 + 4 * n); ts[bj][n] = ld4(SRT + (size_t)i * 8192 + t0 + 4 * n); }
            FOR_BJ { f32x4 o1[2], o2[2];
                FOR_N { const f32x4 c = tc[bj][n], s = ts[bj][n];
                    const f32x4 x1 = acc[0][bj][m][n], x2 = acc[1][bj][m][n]; o1[n] = (x1 * c - x2 * s) * sc[bj][n]; o2[n] = (x2 * c + x1 * s) * sc[bj][n]; }
                bf16* d = KT + ((size_t)(((b * 4 + h) * 32 + (u.pn & 31)) * 256 + i)) * 512 + bj * 128 + c0; st8b(d, o1[0], o1[1]); st8b(d + (size_t)128 * 512, o2[0], o2[1]); } }
    }
};
struct EpiRetVT { EPI_HDR
    const u64* ss; bf16* VS;
    __device__ __forceinline__ void operator()(EPI_ARGS) const {
        const int c0 = wc * 32 + fq * 8, h = u.pm >> 1, vh = u.pm & 1; const int bhc = ((u.pn >> 5) * 4 + h) * 32 + (u.pn & 31);
        f32x4 sc[2][2];
        FOR_BJ FOR_N { const u64* sp = ss + u.pn * 256 + bj * 128 + c0 + 4 * n;
#pragma unroll
            for (int e = 0; e < 4; ++e) sc[bj][n][e] = rstd_of(sp[e]); }
        FOR_AI_M { bf16* d = VS + ((size_t)bhc * 512 + vh * 256 + TROW) * 512 + c0;
            FOR_BJ st8b(d + bj * 128, acc[ai][bj][m][0] * sc[bj][0], acc[ai][bj][m][1] * sc[bj][1]); }
    }
};
struct EpiP { EPI_HDR
    bf16* APQ;
    __device__ __forceinline__ void operator()(EPI_ARGS) const {
        const int c0 = wc * 32 + fq * 8, h = u.pn; const float lg = lg2g(h); const int bhc = ((u.pm >> 5) * 4 + h) * 32 + (u.pm & 31);
        FOR_AI_M { const int l = TROW; bf16* d = APQ + ((size_t)bhc * 256 + l) * 512 + c0;
            FOR_BJ { f32x4 o[2];
                FOR_N {
#pragma unroll
                    for (int e = 0; e < 4; ++e) { const int df = l - (bj * 128 + c0 + 4 * n + e); o[n][e] = df >= 0 ? acc[ai][bj][m][n][e] * __builtin_amdgcn_exp2f((float)df * lg) : 0.f; } }
                st8b(d + bj * 128, o[0], o[1]); } }
    }
};
struct EpiU { static constexpr bool PERM = false, AFTER_DRAIN = false;
    bf16* U;
    __device__ __forceinline__ void operator()(EPI_ARGS) const {
        FOR_AI_M { bf16* d = U + ((size_t)u.pm * 256 + TROW) * 256 + wc * 32 + fq * 4;
            FOR_BJ FOR_N { const f32x4 v = acc[ai][bj][m][n]; *(u32x2*)(d + bj * 128 + n * 16) = (u32x2){cvt_pk_bf16(v[0], v[1]), cvt_pk_bf16(v[2], v[3])}; } }
    }
};
struct EpiO { EPI_HDR
    bf16* O; u64* ST;
    __device__ __forceinline__ void operator()(EPI_ARGS) const {
        const int c0 = wc * 32 + fq * 8; const int bhc = u.pm >> 1, vh = u.pm & 1, h = (bhc >> 5) & 3;
        const int row0 = (bhc >> 7) * 8192 + (bhc & 31) * 256;
        FOR_AI_M { const int row = row0 + TROW; float s1 = 0.f, s2 = 0.f;
            FOR_BJ { const f32x4 a = acc[ai][bj][m][0], b = acc[ai][bj][m][1];
                st8b(O + (size_t)row * 2048 + h * 512 + vh * 256 + bj * 128 + c0, a, b);
                s1 += (a[0] + a[1]) + (a[2] + a[3]) + (b[0] + b[1]) + (b[2] + b[3]);
                s2 += (a[0] * a[0] + a[1] * a[1]) + (a[2] * a[2] + a[3] * a[3]) + (b[0] * b[0] + b[1] * b[1]) + (b[2] * b[2] + b[3] * b[3]); }
            s1 += __shfl_xor(s1, 16); s1 += __shfl_xor(s1, 32); s2 += __shfl_xor(s2, 16); s2 += __shfl_xor(s2, 32);
            if (fq == 0) { fx_add(ST + (size_t)row * 8 + h * 2, s1); fx_add(ST + (size_t)row * 8 + h * 2 + 1, s2); } }
    }
};
struct EpiONorm { EPI_HDR
    const bf16* Gt; bf16* UB; u64* ST; unsigned* pc; unsigned* bar;
    __device__ __forceinline__ void operator()(EPI_ARGS) const {
        const int c0 = wc * 32 + fq * 8; const int bhc = u.pm >> 1, vh = u.pm & 1, h = (bhc >> 5) & 3;
        const int row0 = (bhc >> 7) * 8192 + (bhc & 31) * 256;
        FOR_AI_M { const int row = row0 + TROW; float s1 = 0.f, s2 = 0.f;
            FOR_BJ { const f32x4 a = acc[ai][bj][m][0], b = acc[ai][bj][m][1];
                s1 += (a[0] + a[1]) + (a[2] + a[3]) + (b[0] + b[1]) + (b[2] + b[3]);
                s2 += (a[0] * a[0] + a[1] * a[1]) + (a[2] * a[2] + a[3] * a[3]) + (b[0] * b[0] + b[1] * b[1]) + (b[2] * b[2] + b[3] * b[3]); }
            s1 += __shfl_xor(s1, 16); s1 += __shfl_xor(s1, 32); s2 += __shfl_xor(s2, 16); s2 += __shfl_xor(s2, 32);
            if (fq == 0) { fx_add(ST + (size_t)row * 8 + h * 2, s1); fx_add(ST + (size_t)row * 8 + h * 2 + 1, s2); } }
        u32x4 gv[4][2];
#pragma unroll
        for (int m = 0; m < 4; ++m)
#pragma unroll
            for (int bj = 0; bj < 2; ++bj) gv[m][bj] = *(const u32x4*)(Gt + (size_t)(row0 + wr * 64 + m * 16 + fr) * 2048 + h * 512 + vh * 256 + bj * 128 + c0);
        asm volatile("s_waitcnt vmcnt(0)" ::: "memory"); __builtin_amdgcn_s_barrier(); asm volatile("" ::: "memory");
        if (wr == 0 && wc == 0 && fr == 0 && fq == 0) { (void)xb_add(pc + bhc, 1u); XB_SPIN(xb_ld(pc + bhc) < 2u, bar); }
        __builtin_amdgcn_s_barrier(); asm volatile("" ::: "memory");
        float mu[2][4], rs[2][4];
        { u64 t1[2][4], t2[2][4];
#pragma unroll
          for (int ai = 0; ai < 2; ++ai)
#pragma unroll
            for (int m = 0; m < 4; ++m) { const int row = row0 + TROW; t1[ai][m] = __hip_atomic_load(ST + (size_t)row * 8 + h * 2, __ATOMIC_RELAXED, __HIP_MEMORY_SCOPE_AGENT); t2[ai][m] = __hip_atomic_load(ST + (size_t)row * 8 + h * 2 + 1, __ATOMIC_RELAXED, __HIP_MEMORY_SCOPE_AGENT); }
#pragma unroll
          for (int ai = 0; ai < 2; ++ai)
#pragma unroll
            for (int m = 0; m < 4; ++m) { mu[ai][m] = from_fx(t1[ai][m]) * (1.f / 512.f); rs[ai][m] = __builtin_amdgcn_rsqf(fmaxf(from_fx(t2[ai][m]) * (1.f / 512.f) - mu[ai][m] * mu[ai][m], 0.f) + EPS); } }
#pragma unroll
        for (int ai = 0; ai < 2; ++ai) {
            if (ai == 1) {
#pragma unroll
                for (int m = 0; m < 4; ++m)
#pragma unroll
                    for (int bj = 0; bj < 2; ++bj) gv[m][bj] = *(const u32x4*)(Gt + (size_t)(row0 + 128 + wr * 64 + m * 16 + fr) * 2048 + h * 512 + vh * 256 + bj * 128 + c0);
            }
#pragma unroll
            for (int m = 0; m < 4; ++m) { const int row = row0 + TROW;
#pragma unroll
                for (int bj = 0; bj < 2; ++bj) { const size_t o = (size_t)row * 2048 + h * 512 + vh * 256 + bj * 128 + c0; const u32x4 g4 = gv[m][bj];
                    const f32x4 a = (acc[ai][bj][m][0] - mu[ai][m]) * rs[ai][m] * (f32x4){bflo(g4.x), bfhi(g4.x), bflo(g4.y), bfhi(g4.y)}, b = (acc[ai][bj][m][1] - mu[ai][m]) * rs[ai][m] * (f32x4){bflo(g4.z), bfhi(g4.z), bflo(g4.w), bfhi(g4.w)};
                    st8b(UB + o, a, b); } } }
    }
};
struct EpiResidual { EPI_HDR
    const float* xin_p; const float* xin_s; bf16* XB; u64* ssn;
    __device__ __forceinline__ void operator()(EPI_ARGS) const {
        const int c0 = wc * 32 + fq * 8;
        if (xin_p) {
        FOR_AI_M { const int row = u.pm * 256 + TROW; float sq = 0.f;
            FOR_BJ { const int col = u.pn * 256 + bj * 128 + c0; f32x4 a, b;
                { const float* xo = xin_p + (size_t)row * 1024 + col; a = ld4(xo); b = ld4(xo + 4); }
                a += acc[ai][bj][m][0]; b += acc[ai][bj][m][1];
                st8b(XB + (size_t)row * 1024 + col, a, b);
                sq += (a[0] * a[0] + a[1] * a[1]) + (a[2] * a[2] + a[3] * a[3]) + (b[0] * b[0] + b[1] * b[1]) + (b[2] * b[2] + b[3] * b[3]); }
            sq += __shfl_xor(sq, 16); sq += __shfl_xor(sq, 32);
            if (fq == 0) fx_add(ssn + row, sq); }
        } else {
#pragma unroll
        for (int ai = 0; ai < 2; ++ai) { u32x4 ov[4][2];
#pragma unroll
            for (int m = 0; m < 4; ++m) FOR_BJ ov[m][bj] = *(const u32x4*)(XB + (size_t)(u.pm * 256 + TROW) * 1024 + u.pn * 256 + bj * 128 + c0);
#pragma unroll
            for (int m = 0; m < 4; ++m) { const int row = u.pm * 256 + TROW; float sq = 0.f;
                FOR_BJ { const int col = u.pn * 256 + bj * 128 + c0; const u32x4 o = ov[m][bj];
                    const f32x4 a = (f32x4){bflo(o.x), bfhi(o.x), bflo(o.y), bfhi(o.y)} + acc[ai][bj][m][0], b = (f32x4){bflo(o.z), bfhi(o.z), bflo(o.w), bfhi(o.w)} + acc[ai][bj][m][1];
                    st8b(XB + (size_t)row * 1024 + col, a, b);
                    sq += (a[0] * a[0] + a[1] * a[1]) + (a[2] * a[2] + a[3] * a[3]) + (b[0] * b[0] + b[1] * b[1]) + (b[2] * b[2] + b[3] * b[3]); }
                sq += __shfl_xor(sq, 16); sq += __shfl_xor(sq, 32);
                if (fq == 0) fx_add(ssn + row, sq); } }
        }
    }
    __device__ __forceinline__ void quad(int rs, int pn, int tc, f32x4 v0, f32x4 v1, int g) const {
        const int row = MP + rs, col = pn * 256 + tc; bf16* bd = XB + (size_t)row * 1024 + col; f32x4 a, b;
        if (xin_s) { const float* xo = xin_s + (size_t)rs * 1024 + col; a = ld4(xo); b = ld4(xo + 128); }
        else { const u32x2 o0 = *(const u32x2*)bd, o1 = *(const u32x2*)(bd + 128); a = (f32x4){bflo(o0.x), bfhi(o0.x), bflo(o0.y), bfhi(o0.y)}; b = (f32x4){bflo(o1.x), bfhi(o1.x), bflo(o1.y), bfhi(o1.y)}; }
        a += v0; b += v1;
        *(u32x2*)bd = (u32x2){cvt_pk_bf16(a[0], a[1]), cvt_pk_bf16(a[2], a[3])}; *(u32x2*)(bd + 128) = (u32x2){cvt_pk_bf16(b[0], b[1]), cvt_pk_bf16(b[2], b[3])};
        float sq = (a[0] * a[0] + a[1] * a[1]) + (a[2] * a[2] + a[3] * a[3]) + (b[0] * b[0] + b[1] * b[1]) + (b[2] * b[2] + b[3] * b[3]);
        sq += __shfl_xor(sq, 16); sq += __shfl_xor(sq, 32);
        if (g == 0) fx_add(ssn + row, sq);
    }
};
struct EpiResFinal { EPI_HDR
    const bf16* XB; u64* ssn; const float* fg; float* y; unsigned* pc; unsigned* bar;
    __device__ __forceinline__ void operator()(EPI_ARGS) const {
        const int c0 = wc * 32 + fq * 8;
        FOR_AI_M { const int row = u.pm * 256 + TROW; float sq = 0.f;
            FOR_BJ { const int col = u.pn * 256 + bj * 128 + c0;
                const u32x4 o = *(const u32x4*)(XB + (size_t)row * 1024 + col);
                const f32x4 a = (f32x4){bflo(o.x), bfhi(o.x), bflo(o.y), bfhi(o.y)} + acc[ai][bj][m][0], b = (f32x4){bflo(o.z), bfhi(o.z), bflo(o.w), bfhi(o.w)} + acc[ai][bj][m][1];
                acc[ai][bj][m][0] = a; acc[ai][bj][m][1] = b;
                sq += (a[0] * a[0] + a[1] * a[1]) + (a[2] * a[2] + a[3] * a[3]) + (b[0] * b[0] + b[1] * b[1]) + (b[2] * b[2] + b[3] * b[3]); }
            sq += __shfl_xor(sq, 16); sq += __shfl_xor(sq, 32);
            if (fq == 0) fx_add(ssn + row, sq); }
        asm volatile("s_waitcnt vmcnt(0)" ::: "memory"); __builtin_amdgcn_s_barrier(); asm volatile("" ::: "memory");
        if (wr == 0 && wc == 0 && fr == 0 && fq == 0) { (void)xb_add(pc + u.pm, 1u); XB_SPIN(xb_ld(pc + u.pm) < 4u, bar); }
        __builtin_amdgcn_s_barrier(); asm volatile("" ::: "memory");
        u64 t[2][4]; f32x4 gg[2][2];
        FOR_AI_M t[ai][m] = __hip_atomic_load(ssn + u.pm * 256 + TROW, __ATOMIC_RELAXED, __HIP_MEMORY_SCOPE_AGENT);
        FOR_BJ { const int col = u.pn * 256 + bj * 128 + c0; gg[bj][0] = ld4(fg + col); gg[bj][1] = ld4(fg + col + 4); }
        FOR_AI_M { const int row = u.pm * 256 + TROW; const float r = rstd_of(t[ai][m]);
            FOR_BJ { float* yo = y + (size_t)row * 1024 + u.pn * 256 + bj * 128 + c0;
                st4(yo, acc[ai][bj][m][0] * r * gg[bj][0]); st4(yo + 4, acc[ai][bj][m][1] * r * gg[bj][1]); } }
    }
};
struct EpiScale { EPI_HDR
    const u64* ss; float scale; bf16* out; int ld;
    __device__ __forceinline__ void operator()(EPI_ARGS) const {
        const int c0 = wc * 32 + fq * 8;
        FOR_AI_M { const int row = u.pm * 256 + TROW; const float r = rstd_of(ss[row]) * scale;
            FOR_BJ st8b(out + (size_t)row * ld + u.pn * 256 + bj * 128 + c0, acc[ai][bj][m][0] * r, acc[ai][bj][m][1] * r); }
    }
    __device__ __forceinline__ void quad(int rs, int pn, int tc, f32x4 v0, f32x4 v1, int g) const {
        const float r = rstd_of(ss[MP + rs]) * scale; v0 = v0 * r; v1 = v1 * r; bf16* d = out + (size_t)(MP + rs) * ld + pn * 256 + tc;
        *(u32x2*)d = (u32x2){cvt_pk_bf16(v0[0], v0[1]), cvt_pk_bf16(v0[2], v0[3])}; *(u32x2*)(d + 128) = (u32x2){cvt_pk_bf16(v1[0], v1[1]), cvt_pk_bf16(v1[2], v1[3])};
    }
};
struct EpiSoftmax { EPI_HDR
    bf16* PX; LAS float* X;
    __device__ __forceinline__ void operator()(EPI_ARGS) const {
        const int c0 = wc * 32 + fq * 8;
        FOR_AI_M { float v = -3.0e38f;
            FOR_BJ FOR_N {
#pragma unroll
                for (int e = 0; e < 4; ++e) v = fmaxf(v, acc[ai][bj][m][n][e]); }
            v = fmaxf(v, __shfl_xor(v, 16)); v = fmaxf(v, __shfl_xor(v, 32));
            if (fq == 0) X[wc * 256 + TROW] = v; }
        asm volatile("s_waitcnt lgkmcnt(0)" ::: "memory"); __builtin_amdgcn_s_barrier(); asm volatile("" ::: "memory");
        FOR_AI_M { const int rl = TROW; const float M = fmaxf(fmaxf(X[rl], X[256 + rl]), fmaxf(X[512 + rl], X[768 + rl])); float s = 0.f;
            FOR_BJ FOR_N {
#pragma unroll
                for (int e = 0; e < 4; ++e) { const float p = __builtin_amdgcn_exp2f(acc[ai][bj][m][n][e] - M); acc[ai][bj][m][n][e] = p; s += p; } }
            s += __shfl_xor(s, 16); s += __shfl_xor(s, 32);
            if (fq == 0) X[1024 + wc * 256 + rl] = s; }
        asm volatile("s_waitcnt lgkmcnt(0)" ::: "memory"); __builtin_amdgcn_s_barrier(); asm volatile("" ::: "memory");
        FOR_AI_M { const int rl = TROW; const float inv = __builtin_amdgcn_rcpf((X[1024 + rl] + X[1280 + rl]) + (X[1536 + rl] + X[1792 + rl]));
            FOR_BJ st8b(PX + ((size_t)u.pm * 256 + rl) * 1024 + u.pn * 256 + bj * 128 + c0, acc[ai][bj][m][0] * inv, acc[ai][bj][m][1] * inv); }
        asm volatile("s_waitcnt lgkmcnt(0)" ::: "memory"); __builtin_amdgcn_s_barrier(); asm volatile("" ::: "memory");
    }
};
struct EpiSoftmaxR { EPI_HDR
    const u64* ss; bf16* PX; LAS float* X;
    __device__ __forceinline__ void operator()(EPI_ARGS) const {
        const int c0 = wc * 32 + fq * 8;
        FOR_AI_M { const float r = rstd_of(ss[u.pm * 256 + TROW]); float v = -3.0e38f;
            FOR_BJ FOR_N { const f32x4 t = acc[ai][bj][m][n] * r; acc[ai][bj][m][n] = t; v = fmaxf(fmaxf(v, fmaxf(t[0], t[1])), fmaxf(t[2], t[3])); }
            v = fmaxf(v, __shfl_xor(v, 16)); v = fmaxf(v, __shfl_xor(v, 32));
            if (fq == 0) X[wc * 256 + TROW] = v; }
        asm volatile("s_waitcnt lgkmcnt(0)" ::: "memory"); __builtin_amdgcn_s_barrier(); asm volatile("" ::: "memory");
        FOR_AI_M { const int rl = TROW; const float M = fmaxf(fmaxf(X[rl], X[256 + rl]), fmaxf(X[512 + rl], X[768 + rl])); float s = 0.f;
            FOR_BJ FOR_N {
#pragma unroll
                for (int e = 0; e < 4; ++e) { const float p = __builtin_amdgcn_exp2f(acc[ai][bj][m][n][e] - M); acc[ai][bj][m][n][e] = p; s += p; } }
            s += __shfl_xor(s, 16); s += __shfl_xor(s, 32);
            if (fq == 0) X[1024 + wc * 256 + rl] = s; }
        asm volatile("s_waitcnt lgkmcnt(0)" ::: "memory"); __builtin_amdgcn_s_barrier(); asm volatile("" ::: "memory");
        FOR_AI_M { const int rl = TROW; const float inv = __builtin_amdgcn_rcpf((X[1024 + rl] + X[1280 + rl]) + (X[1536 + rl] + X[1792 + rl]));
            FOR_BJ st8b(PX + ((size_t)u.pm * 256 + rl) * 1024 + u.pn * 256 + bj * 128 + c0, acc[ai][bj][m][0] * inv, acc[ai][bj][m][1] * inv); }
        asm volatile("s_waitcnt lgkmcnt(0)" ::: "memory"); __builtin_amdgcn_s_barrier(); asm volatile("" ::: "memory");
    }
};
struct EpiAbs { EPI_HDR
    bf16* out;
    __device__ __forceinline__ void operator()(EPI_ARGS) const {
        const int c0 = wc * 32 + fq * 8; const float sc = u.pm < 32 ? LOG2E * 0.0625f : 1.f;
        FOR_AI_M { const int row = u.pm * 256 + TROW;
            FOR_BJ st8b(out + (size_t)row * 1024 + u.pn * 256 + bj * 128 + c0, acc[ai][bj][m][0] * sc, acc[ai][bj][m][1] * sc); }
    }
};
struct EpiPlain { EPI_HDR
    bf16* out; int ld;
    __device__ __forceinline__ void operator()(EPI_ARGS) const {
        const int c0 = wc * 32 + fq * 8;
        FOR_AI_M { const int row = u.pm * 256 + TROW;
            FOR_BJ st8b(out + (size_t)row * ld + u.pn * 256 + bj * 128 + c0, acc[ai][bj][m][0], acc[ai][bj][m][1]); }
    }
};
struct EpiPlainNP { static constexpr bool PERM = false, AFTER_DRAIN = false;
    bf16* out; int ld;
    __device__ __forceinline__ void operator()(EPI_ARGS) const {
        FOR_AI_M { const int row = u.pm * 256 + TROW;
            FOR_BJ FOR_N { const f32x4 v = acc[ai][bj][m][n];
                *(u32x2*)(out + (size_t)row * ld + u.pn * 256 + bj * 128 + wc * 32 + n * 16 + fq * 4) = (u32x2){cvt_pk_bf16(v[0], v[1]), cvt_pk_bf16(v[2], v[3])}; } }
    }
};
struct EpiSwiGLU { EPI_HDR
    const u64* ss; bf16* HF;
    __device__ __forceinline__ void operator()(EPI_ARGS) const {
        const int c0 = wc * 32 + fq * 8;
        LOAD_RSTD8(rr, ss, u.pm * 256)
        FOR_AI_M { const int row = u.pm * 256 + TROW; const float r = rr[ai][m];
            const f32x4 o0 = silu4(acc[ai][0][m][0] * r) * (acc[ai][1][m][0] * r), o1 = silu4(acc[ai][0][m][1] * r) * (acc[ai][1][m][1] * r);
            st8b(HF + (size_t)row * DFF + u.pn * 128 + c0, o0, o1); }
    }
    __device__ __forceinline__ void quad(int rs, int pn, int tc, f32x4 v0, f32x4 v1, int g) const {
        const float r = rstd_of(ss[MP + rs]); const f32x4 o = silu4(v0 * r) * (v1 * r);
        *(u32x2*)(HF + (size_t)(MP + rs) * DFF + pn * 128 + tc) = (u32x2){cvt_pk_bf16(o[0], o[1]), cvt_pk_bf16(o[2], o[3])};
    }
};
struct EpiConvIn { EPI_HDR
    const u64* ss; bf16* BG; bf16* CI; float* out;
    __device__ __forceinline__ void operator()(EPI_ARGS) const {
        const int c0 = wc * 32 + fq * 8;
        LOAD_RSTD8(rr, ss, u.pm * 256)
        FOR_AI_M { const int row = u.pm * 256 + TROW; const float r = rr[ai][m];
            if (u.pn < 4) { FOR_BJ st8b(BG + (size_t)row * 1024 + u.pn * 256 + bj * 128 + c0, acc[ai][bj][m][0] * r, acc[ai][bj][m][1] * r); }
            else { const int col = (u.pn - 4) * 128 + c0; const f32x4 a = (acc[ai][0][m][0] * r) * (acc[ai][1][m][0] * r), b = (acc[ai][0][m][1] * r) * (acc[ai][1][m][1] * r);
                st8b(CI + (size_t)row * 1024 + col, a, b);
                if (row < MP) { const int t = row & 8191; if (t >= 8190) { float* d = out + O_CONVP + ((size_t)(row >> 13) * 2 + (t - 8190)) * 1024 + col; st4(d, a); st4(d + 4, b); } }
                else if (row < MREAL) { float* d = out + O_CONVS + ((size_t)(row - MP) * 2 + 1) * 1024 + col; st4(d, a); st4(d + 4, b); } } }
    }
    __device__ __forceinline__ void quad(int rs, int pn, int tc, f32x4 v0, f32x4 v1, int g) const {
        const float r = rstd_of(ss[MP + rs]); v0 = v0 * r; v1 = v1 * r;
        if (pn < 4) { bf16* d = BG + (size_t)(MP + rs) * 1024 + pn * 256 + tc; *(u32x2*)d = (u32x2){cvt_pk_bf16(v0[0], v0[1]), cvt_pk_bf16(v0[2], v0[3])}; *(u32x2*)(d + 128) = (u32x2){cvt_pk_bf16(v1[0], v1[1]), cvt_pk_bf16(v1[2], v1[3])}; }
        else { const f32x4 c = v0 * v1; const int col = (pn - 4) * 128 + tc; *(u32x2*)(CI + (size_t)(MP + rs) * 1024 + col) = (u32x2){cvt_pk_bf16(c[0], c[1]), cvt_pk_bf16(c[2], c[3])};
            st4(out + O_CONVS + ((size_t)rs * 2 + 1) * 1024 + col, c); }
    }
};
struct EpiSwaQKV { EPI_HDR
    const u64* ss; const float* CS; const float* SN; bf16* QS; bf16* KS; float* SWQ; float* out;
    __device__ __forceinline__ void operator()(EPI_ARGS) const {
        const int c0 = wc * 32 + fq * 8, pn = u.pn; const bool rot = ((wc & 1) == 0) && (fq < 2);
        LOAD_RSTD8(rr, ss, u.pm * 256)
        FOR_AI_M { const int row = u.pm * 256 + TROW; const float r = rr[ai][m]; const bool samp = row >= MP; const int pos = samp ? 8192 : (row & 8191);
            FOR_BJ { f32x4 v[2];
                FOR_N { v[n] = acc[ai][bj][m][n] * r;
                    if (pn < 5) { f32x4 pr;
#pragma unroll
                        for (int e = 0; e < 4; ++e) pr[e] = __shfl_xor(v[n][e], 16);
                        if (rot) { const f32x4 c = ld4(CS + (size_t)pos * 8 + 4 * n), s = ld4(SN + (size_t)pos * 8 + 4 * n); v[n] = (fq == 0) ? v[n] * c - pr * s : v[n] * c + pr * s; } } }
                const int tc = bj * 128 + c0;
                if (pn < 4) { const float qs = 0.125f * LOG2E; v[0] = v[0] * qs; v[1] = v[1] * qs;
                    if (!samp) st8b(QS + (size_t)row * 1024 + pn * 256 + tc, v[0], v[1]);
                    else if (row < MREAL) { float* d = SWQ + (size_t)(row - MP) * 1536 + pn * 256 + tc; st4(d, v[0]); st4(d + 4, v[1]); } }
                else if (pn == 4) {
                    if (!samp) { st8b(KS + (size_t)row * 256 + tc, v[0], v[1]); const int t = row & 8191;
                        if (t >= 8064) { float* d = out + O_SWKP + ((size_t)(row >> 13) * 128 + (t - 8064)) * 256 + tc; st4(d, v[0]); st4(d + 4, v[1]); } }
                    else if (row < MREAL) { float* d = SWQ + (size_t)(row - MP) * 1536 + 1024 + tc; st4(d, v[0]); st4(d + 4, v[1]); } }
                else {
                    if (!samp) { const int t = row & 8191; if (t >= 8064) { float* d = out + O_SWVP + ((size_t)(row >> 13) * 128 + (t - 8064)) * 256 + tc; st4(d, v[0]); st4(d + 4, v[1]); } }
                    else if (row < MREAL) { float* d = SWQ + (size_t)(row - MP) * 1536 + 1280 + tc; st4(d, v[0]); st4(d + 4, v[1]); } } } }
    }
    __device__ __forceinline__ void quad(int rs, int pn, int tc, f32x4 v0, f32x4 v1, int g) const {
        const float r = rstd_of(ss[MP + rs]); v0 = v0 * r; v1 = v1 * r;
        if (pn < 5) { f32x4 p0, p1;
#pragma unroll
            for (int e = 0; e < 4; ++e) { p0[e] = __shfl_xor(v0[e], 32); p1[e] = __shfl_xor(v1[e], 32); }
            if ((tc & 63) < 16) { const f32x4 c = ld4(CS + (size_t)8192 * 8 + (tc & 4)), s = ld4(SN + (size_t)8192 * 8 + (tc & 4));
                if ((tc & 8) == 0) { v0 = v0 * c - p0 * s; v1 = v1 * c - p1 * s; } else { v0 = v0 * c + p0 * s; v1 = v1 * c + p1 * s; } } }
        if (pn < 4) { const float qs = 0.125f * LOG2E; v0 = v0 * qs; v1 = v1 * qs; }
        float* d = SWQ + (size_t)rs * 1536 + (pn < 4 ? pn * 256 : (pn == 4 ? 1024 : 1280)) + tc; st4(d, v0); st4(d + 128, v1);
    }
};
struct EpiSwaVT { EPI_HDR
    const u64* ss; bf16* VT;
    __device__ __forceinline__ void operator()(EPI_ARGS) const {
        const int c0 = wc * 32 + fq * 8; const int b = u.pn >> 5, t0 = (u.pn & 31) * 256;
        f32x4 sc[2][2];
        FOR_BJ FOR_N { const u64* sp = ss + u.pn * 256 + bj * 128 + c0 + 4 * n;
#pragma unroll
            for (int e = 0; e < 4; ++e) sc[bj][n][e] = rstd_of(sp[e]); }
        FOR_AI_M { bf16* d = VT + ((size_t)(b * 256 + TROW)) * 8192 + t0 + c0;
            FOR_BJ st8b(d + bj * 128, acc[ai][bj][m][0] * sc[bj][0], acc[ai][bj][m][1] * sc[bj][1]); }
    }
};

struct DecMem { __device__ __forceinline__ void operator()(int L, Unit& u) const { u.pm = L >> 3; u.pn = L & 7; u.ao = (unsigned)u.pm * 256u * 1024u; u.bo = ((unsigned)(u.pm >> 1) * 2048u + (unsigned)u.pn * 256u) * 1024u; } };
struct DecMemT { __device__ __forceinline__ void operator()(int L, Unit& u) const { u.pm = L >> 1; u.pn = L & 1; u.ao = ((unsigned)(u.pm >> 2) * 2048u + 1024u + (unsigned)(u.pm & 3) * 256u) * 1024u; u.bo = ((unsigned)(u.pm >> 2) * 512u + (unsigned)u.pn * 256u) * 1024u; } };
struct DecAbs { __device__ __forceinline__ void operator()(int L, Unit& u) const { const unsigned kind = (unsigned)L >> 7, r = (unsigned)L & 127u, lb = r >> 4, h = (r >> 2) & 3u, t = r & 3u, lay = lb >> 1;
    if (kind == 0) { u.pm = (int)(lb * 4 + h); u.pn = (int)t; u.ao = (unsigned)(WS_MK / 2) + lb * 262144u + h * 256u; u.bo = (unsigned)(W_XQN / 2) + lay * 1048576u + t * 262144u + h * 256u; }
    else { u.pm = (int)(32 + lb * 4 + t); u.pn = (int)h; u.ao = (unsigned)(W_XO / 2) + lay * 1048576u + t * 262144u + h * 256u; u.bo = (unsigned)(WS_MV / 2) + lb * 262144u + h * 256u; } } };
struct DecGridB { DecGrid d; __device__ __forceinline__ void operator()(int L, Unit& u) const { d(L, u); u.bo += (unsigned)(u.pm >> 5) * 1048576u; } };
struct DecU { __device__ __forceinline__ void operator()(int L, Unit& u) const { const unsigned bhc = (unsigned)L >> 1, vh = L & 1; u.pm = L; u.pn = 0; u.ao = (bhc * 512u + vh * 256u) * 512u; u.bo = bhc * 131072u; } };
struct DecO { __device__ __forceinline__ void operator()(int L, Unit& u) const { const unsigned bhc = (unsigned)L >> 1, vh = L & 1; u.pm = L; u.pn = 0; u.ao = bhc * 256u * 512u; u.bo = (bhc * 512u + vh * 256u) * 512u; } };
struct DecXS { int layer; __device__ __forceinline__ void operator()(int L, Unit& u) const { u.pm = L >> 2; u.pn = L & 3; u.ao = (unsigned)u.pm * 256u * 1024u + (unsigned)u.pn * 256u; u.bo = ((unsigned)(layer * 2 + (u.pm >> 5)) * 256u) * 1024u + (unsigned)u.pn * 256u; } };
struct DecXPV { int layer; __device__ __forceinline__ void operator()(int L, Unit& u) const { u.pm = L >> 2; u.pn = L & 3; u.ao = (unsigned)u.pm * 256u * 1024u + (unsigned)u.pn * 256u; u.bo = ((unsigned)(layer * 2 + (u.pm >> 5)) * 1024u + (unsigned)u.pn * 256u) * 1024u; } };

__device__ __forceinline__ f32x4 mfma16(bf16x8 a, bf16x8 b, f32x4 c) { return __builtin_amdgcn_mfma_f32_16x16x32_bf16(a, b, c, 0, 0, 0); }
template <int RT = 8, class Epi>
__device__ __forceinline__ void sample_gemm(const Ctx& C, const bf16* A, int lda, int a_pn, const bf16* Bt, int ldb, unsigned b_pn, int K, int nunits, int skew, const Epi& E) {
    constexpr int NRB = 8 / RT;
    const int lane = olane(), r = lane & 15, g = lane >> 4, w = C.wave;
    const int first = (C.G - 1 - (int)blockIdx.x + skew) % C.G;
    int ks = K >> 3; asm volatile("" : "+s"(ks));
    LAS f32x4* P = (LAS f32x4*)(C.lds + RING_OFF);
    for (int su = first; su < nunits * NRB; su += C.G) { const int rb = su % NRB, sj = su / NRB, pn = sj >> 3, j = sj & 7;
        const bf16* ap = A + (size_t)(rb * 16 * RT + r) * lda + (size_t)pn * a_pn + w * ks + 8 * g;
        const bf16* bp0 = Bt + (size_t)pn * b_pn + (size_t)(16 * j + r) * ldb + w * ks + 8 * g; const bf16* bp1 = bp0 + (size_t)128 * ldb;
        f32x4 acc[RT][2];
#pragma unroll
        for (int rt = 0; rt < RT; ++rt) { acc[rt][0] = (f32x4){0.f, 0.f, 0.f, 0.f}; acc[rt][1] = (f32x4){0.f, 0.f, 0.f, 0.f}; }
#pragma unroll 4
        for (int k0 = 0; k0 < ks; k0 += 32) { const bf16x8 b0 = *(const bf16x8*)(bp0 + k0), b1 = *(const bf16x8*)(bp1 + k0); bf16x8 a[RT];
#pragma unroll
            for (int rt = 0; rt < RT; ++rt) a[rt] = *(const bf16x8*)(ap + (size_t)(16 * rt) * lda + k0);
#pragma unroll
            for (int rt = 0; rt < RT; ++rt) { acc[rt][0] = mfma16(b0, a[rt], acc[rt][0]); acc[rt][1] = mfma16(b1, a[rt], acc[rt][1]); } }
#pragma unroll
        for (int rt = 0; rt < RT; ++rt) { P[((w * RT + rt) * 2 + 0) * 64 + lane] = acc[rt][0]; P[((w * RT + rt) * 2 + 1) * 64 + lane] = acc[rt][1]; }
        __syncthreads();
        if (w < RT) {
            f32x4 v0 = P[((0 * RT + w) * 2 + 0) * 64 + lane], v1 = P[((0 * RT + w) * 2 + 1) * 64 + lane];
#pragma unroll
            for (int ww = 1; ww < 8; ++ww) { v0 += P[((ww * RT + w) * 2 + 0) * 64 + lane]; v1 += P[((ww * RT + w) * 2 + 1) * 64 + lane]; }
            E.quad(rb * 16 * RT + 16 * w + r, pn, 16 * j + 4 * g, v0, v1, g); }
        __syncthreads(); }
}


__device__ __forceinline__ void swa_unit(const Ctx& C, int unit, const bf16* QS, const bf16* KS, const bf16* VT, const float* sinks, bf16* AO) {
    const int kvh = unit & 3, qb = (unit >> 2) & 63, b = unit >> 8;
    const int lane_ = olane(); const int w = C.wave, l15 = lane_ & 15, g = lane_ >> 4, tid = w * 64 + lane_;
    const int head = kvh * 4 + (w >> 1);
    const float sink = sinks[head] * LOG2E;
    LAS unsigned char* KL = C.lds; LAS unsigned char* VL = C.lds + 40960;
    const int kstart = qb * 128 - 144;
    bf16x8 qf[4][2];
#pragma unroll
    for (int qt = 0; qt < 4; ++qt)
#pragma unroll
        for (int st = 0; st < 2; ++st) qf[qt][st] = *(const bf16x8*)(QS + ((size_t)b * 8192 + qb * 128 + (w & 1) * 64 + qt * 16 + l15) * 1024 + head * 64 + st * 32 + 8 * g);
    for (int c = tid; c < 2176; c += 512) { const int row = c >> 3, ch = c & 7, key = kstart + row;
        u32x4 v = (u32x4){0u, 0u, 0u, 0u}; if (key >= 0) v = *(const u32x4*)(KS + ((size_t)b * 8192 + key) * 256 + kvh * 64 + ch * 8);
        *(LAS u32x4*)(KL + row * 144 + ch * 16) = v; }
    for (int c = tid; c < 2176; c += 512) { const int d = c / 34, ch = c - d * 34, key0 = kstart + ch * 8;
        u32x4 v = (u32x4){0u, 0u, 0u, 0u}; if (key0 >= 0) v = *(const u32x4*)(VT + ((size_t)(b * 256 + kvh * 64 + d)) * 8192 + key0);
        *(LAS u32x4*)(VL + d * 560 + ch * 16) = v; }
    __syncthreads();
#pragma unroll 1
    for (int qt = 0; qt < 4; ++qt) {
        const int q0 = qb * 128 + (w & 1) * 64 + qt * 16, tb = (w & 1) * 4 + qt;
        const size_t qrow = (size_t)b * 8192 + q0 + l15;
        bf16x8 q0f = qf[0][0], q1f = qf[0][1];
        if (qt == 1) { q0f = qf[1][0]; q1f = qf[1][1]; } else if (qt == 2) { q0f = qf[2][0]; q1f = qf[2][1]; } else if (qt == 3) { q0f = qf[3][0]; q1f = qf[3][1]; }
        f32x4 s[10];
#pragma unroll
        for (int kt = 0; kt < 10; ++kt) { const LAS unsigned char* kp = KL + ((tb + kt) * 16 + l15) * 144 + g * 16;
            const bf16x8 k0 = *(const LAS bf16x8*)kp, k1 = *(const LAS bf16x8*)(kp + 64);
            f32x4 a = (f32x4){0.f, 0.f, 0.f, 0.f}; a = mfma16(k0, q0f, a); a = mfma16(k1, q1f, a); s[kt] = a; }
        float mx = sink;
#pragma unroll
        for (int kt = 0; kt < 10; ++kt)
#pragma unroll
            for (int e = 0; e < 4; ++e) { const int key = kstart + (tb + kt) * 16 + 4 * g + e, df = q0 + l15 - key; const bool ok = key >= 0 && df >= 0 && df <= 128;
                s[kt][e] = ok ? s[kt][e] : -3.0e38f; mx = fmaxf(mx, s[kt][e]); }
        mx = fmaxf(mx, __shfl_xor(mx, 16)); mx = fmaxf(mx, __shfl_xor(mx, 32));
        float sum = 0.f;
#pragma unroll
        for (int kt = 0; kt < 10; ++kt)
#pragma unroll
            for (int e = 0; e < 4; ++e) { const float p = __builtin_amdgcn_exp2f(s[kt][e] - mx); s[kt][e] = p; sum += p; }
        sum += __shfl_xor(sum, 16); sum += __shfl_xor(sum, 32);
        sum += __builtin_amdgcn_exp2f(sink - mx);
        const float inv = 1.f / sum;
        f32x4 o[4];
#pragma unroll
        for (int dt = 0; dt < 4; ++dt) o[dt] = (f32x4){0.f, 0.f, 0.f, 0.f};
#pragma unroll
        for (int ks = 0; ks < 5; ++ks) {
            const u32x4 pw = pack8(s[2 * ks], s[2 * ks + 1]); const bf16x8 pf = __builtin_bit_cast(bf16x8, pw);
            const int kb0 = (tb + 2 * ks) * 16 + 4 * g;
#pragma unroll
            for (int dt = 0; dt < 4; ++dt) { const LAS unsigned char* vp = VL + (dt * 16 + l15) * 560 + kb0 * 2;
                const u32x2 v0 = *(const LAS u32x2*)vp, v1 = *(const LAS u32x2*)(vp + 32);
                const u32x4 vw = (u32x4){v0.x, v0.y, v1.x, v1.y};
                o[dt] = mfma16(__builtin_bit_cast(bf16x8, vw), pf, o[dt]); } }
#pragma unroll
        for (int dt = 0; dt < 4; ++dt) { u32x2 wv; wv.x = cvt_pk_bf16(o[dt][0] * inv, o[dt][1] * inv); wv.y = cvt_pk_bf16(o[dt][2] * inv, o[dt][3] * inv);
            *(u32x2*)(AO + qrow * 1024 + head * 64 + dt * 16 + 4 * g) = wv; }
    }
    __syncthreads();
}

__device__ __forceinline__ void swa_sample_half(const Ctx& C, int unit, const float* SWQ, const float* ck, const float* cv, const float* sinks, float* out, bf16* AO) {
    LAS float* KV = (LAS float*)(C.lds);
    LAS float* SC = (LAS float*)(C.lds + 66560);
    const int b = unit >> 1, h2 = unit & 1, tid = otid(), lane = tid & 63, w = C.wave;
    const float* q = SWQ + (size_t)b * 1536;
    for (int pass = 0; pass < 2; ++pass) {
        const float* cache = (pass == 0 ? ck : cv) + (size_t)b * 128 * 256 + h2 * 128; float* oc = out + (pass == 0 ? O_SWKS : O_SWVS) + (size_t)b * 128 * 256 + h2 * 128;
        const float* nw = q + (pass == 0 ? 1024 : 1280) + h2 * 128;
        { f32x4 v[8];
#pragma unroll
          for (int i = 0; i < 8; ++i) { const int idx = tid + 512 * i; v[i] = ld4(cache + (size_t)(idx >> 5) * 256 + 4 * (idx & 31)); }
#pragma unroll
          for (int i = 0; i < 8; ++i) { const int idx = tid + 512 * i; *(LAS f32x4*)(KV + (idx >> 5) * 128 + 4 * (idx & 31)) = v[i]; } }
        if (tid < 32) { const f32x4 v = ld4(nw + 4 * tid); *(LAS f32x4*)(KV + 128 * 128 + 4 * tid) = v; st4(oc + (size_t)127 * 256 + 4 * tid, v); }
        __syncthreads();
        if (pass == 0) {
            const int jq = lane >> 4, dq = lane & 15, h = 8 * h2 + w; const f32x4 q4 = ld4(q + h * 64 + 4 * dq);
            for (int j0 = 0; j0 < 132; j0 += 4) { const int j = j0 + jq; const int jc = j < 129 ? j : 128;
                const f32x4 k4 = *(const LAS f32x4*)(KV + jc * 128 + (w >> 2) * 64 + 4 * dq);
                float p = (q4[0] * k4[0] + q4[1] * k4[1]) + (q4[2] * k4[2] + q4[3] * k4[3]);
                p += __shfl_xor(p, 1); p += __shfl_xor(p, 2); p += __shfl_xor(p, 4); p += __shfl_xor(p, 8);
                if (dq == 0 && j < 129) SC[w * 132 + j] = p; }
            LDS_WAIT(); asm volatile("" ::: "memory");
            { const float sink = sinks[h] * LOG2E;
                const float s0 = SC[w * 132 + lane], s1 = SC[w * 132 + 64 + lane], s2 = lane == 0 ? SC[w * 132 + 128] : -3.0e38f;
                const float mx = fmaxf(wave_max(fmaxf(fmaxf(s0, s1), s2)), sink);
                const float p0 = __builtin_amdgcn_exp2f(s0 - mx), p1 = __builtin_amdgcn_exp2f(s1 - mx), p2 = lane == 0 ? __builtin_amdgcn_exp2f(s2 - mx) : 0.f;
                const float inv = 1.f / (wave_sum(p0 + p1 + p2) + __builtin_amdgcn_exp2f(sink - mx));
                SC[w * 132 + lane] = p0 * inv; SC[w * 132 + 64 + lane] = p1 * inv; if (lane == 0) SC[w * 132 + 128] = p2 * inv; }
            __syncthreads();
        } else {
            const int d2 = lane & 31, jh = lane >> 5; float o0 = 0.f, o1 = 0.f;
#pragma unroll 4
            for (int j = jh; j < 129; j += 2) { const float p = SC[w * 132 + j]; const f32x2 v = *(const LAS f32x2*)(KV + j * 128 + (w >> 2) * 64 + 2 * d2); o0 += p * v.x; o1 += p * v.y; }
            o0 += __shfl_xor(o0, 32); o1 += __shfl_xor(o1, 32);
            if (jh == 0) *(unsigned*)(AO + (size_t)(MP + b) * 1024 + (8 * h2 + w) * 64 + 2 * d2) = cvt_pk_bf16(o0, o1);
            __syncthreads();
        }
    }
}
__device__ __forceinline__ void swa_state_copy(const Ctx& C, int b, const float* ck, const float* cv, float* out) {
    const int tid = otid();
    for (int pass = 0; pass < 2; ++pass) {
        const float* src = (pass == 0 ? ck : cv) + (size_t)b * 32768 + 256; float* dst = out + (pass == 0 ? O_SWKS : O_SWVS) + (size_t)b * 32768;
#pragma unroll 1
        for (int i0 = tid; i0 < 8128; i0 += 2048) { f32x4 v[4];
#pragma unroll
            for (int k = 0; k < 4; ++k) { const int i = i0 + 512 * k; v[k] = ld4(src + 4 * (size_t)(i < 8128 ? i : 8127)); }
#pragma unroll
            for (int k = 0; k < 4; ++k) { const int i = i0 + 512 * k; if (i < 8128) st4(dst + 4 * (size_t)i, v[k]); } }
    }
}

__device__ __forceinline__ void ret_sample_unit(const Ctx& C, int unit, const float* SQ, const float* state, const bf16* Gt, float* out, bf16* UB, LAS unsigned char* lb) {
    const int b = unit >> 2, h = unit & 3, tid = otid(), lane_ = tid & 63;
    LAS float* QK = (LAS float*)(lb);
    LAS float* RED = (LAS float*)(lb + 2048);
    LAS float* R2 = (LAS float*)(lb + 2048 + 8192);
    QK[tid] = SQ[(size_t)b * 4096 + (tid < 256 ? h * 256 + tid : 1024 + h * 256 + (tid - 256))];
    const int rg = tid >> 7, c4 = tid & 127;
    const f32x4 v4 = ld4(SQ + (size_t)b * 4096 + 2048 + h * 512 + 4 * c4);
    __syncthreads();
    const float gh = __builtin_amdgcn_exp2f(lg2g(h));
    const float* S = state + ((size_t)(b * 4 + h) * 256) * 512 + 4 * c4; float* So = out + O_RETS + ((size_t)(b * 4 + h) * 256) * 512 + 4 * c4;
    f32x4 a = (f32x4){0.f, 0.f, 0.f, 0.f};
    for (int it = 0; it < 64; it += 8) { f32x4 s[8];
#pragma unroll
        for (int k = 0; k < 8; ++k) s[k] = ld4nt(S + (size_t)((it + k) * 4 + rg) * 512);
#pragma unroll
        for (int k = 0; k < 8; ++k) { const int d = (it + k) * 4 + rg; const f32x4 sn = s[k] * gh + v4 * QK[256 + d]; st4(So + (size_t)d * 512, sn); a += sn * QK[d]; } }
    *(LAS f32x4*)(RED + rg * 512 + 4 * c4) = a;
    __syncthreads();
    f32x4 o = (f32x4){0.f, 0.f, 0.f, 0.f};
    if (tid < 128) { o = *(LAS f32x4*)(RED + 4 * tid) + *(LAS f32x4*)(RED + 512 + 4 * tid) + *(LAS f32x4*)(RED + 1024 + 4 * tid) + *(LAS f32x4*)(RED + 1536 + 4 * tid);
        const float s1 = wave_sum((o[0] + o[1]) + (o[2] + o[3])); if (lane_ == 0) R2[C.wave] = s1; }
    __syncthreads();
    const float mu = (R2[0] + R2[1]) * (1.f / 512.f);
    if (tid < 128) { const f32x4 dd = o - mu; const float s2 = wave_sum((dd[0] * dd[0] + dd[1] * dd[1]) + (dd[2] * dd[2] + dd[3] * dd[3])); if (lane_ == 0) R2[8 + C.wave] = s2; }
    __syncthreads();
    if (tid < 128) { const float rstd = __builtin_amdgcn_rsqf((R2[8] + R2[9]) * (1.f / 512.f) + EPS);
        const u32x2 gw = *(const u32x2*)(Gt + (size_t)(MP + b) * 2048 + h * 512 + 4 * tid);
        u32x2 wv; wv.x = cvt_pk_bf16(bflo(gw.x) * (o[0] - mu) * rstd, bfhi(gw.x) * (o[1] - mu) * rstd); wv.y = cvt_pk_bf16(bflo(gw.y) * (o[2] - mu) * rstd, bfhi(gw.y) * (o[3] - mu) * rstd);
        *(u32x2*)(UB + (size_t)(MP + b) * 2048 + h * 512 + 4 * tid) = wv; }
    __syncthreads();
}

__device__ __forceinline__ void xs_sample_unit(const Ctx& C, int unit, const bf16* QX, const float* cmk, const float* cmv, bf16* OX, LAS unsigned char* lb) {
    const int b = unit >> 2, h = unit & 3, tid = otid(), lane = tid & 63, w = C.wave;
    LAS float* SC = (LAS float*)(lb);
    LAS float* RED = (LAS float*)(lb + 1024);
    const u32x2 qw = *(const u32x2*)(QX + (size_t)(MP + b) * 1024 + h * 256 + 4 * lane);
    const f32x4 q4 = (f32x4){bflo(qw.x), bfhi(qw.x), bflo(qw.y), bfhi(qw.y)};
    const float* Kp = cmk + ((size_t)b * 256) * 1024 + h * 256 + 4 * lane; const float* Vp = cmv + ((size_t)b * 256) * 1024 + h * 256 + 4 * lane;
    for (int i0 = 0; i0 < 32; i0 += 8) { f32x4 k[8];
#pragma unroll
        for (int k8 = 0; k8 < 8; ++k8) k[k8] = ld4nt(Kp + (size_t)(w * 32 + i0 + k8) * 1024);
#pragma unroll
        for (int k8 = 0; k8 < 8; ++k8) { const float p = wave_sum((q4[0] * k[k8][0] + q4[1] * k[k8][1]) + (q4[2] * k[k8][2] + q4[3] * k[k8][3])); if (lane == 0) SC[w * 32 + i0 + k8] = p; } }
    f32x4 v[8];
#pragma unroll
    for (int k8 = 0; k8 < 8; ++k8) v[k8] = ld4nt(Vp + (size_t)(w * 32 + k8) * 1024);
    __syncthreads();
    const float mx = wave_max(fmaxf(fmaxf(SC[lane], SC[64 + lane]), fmaxf(SC[128 + lane], SC[192 + lane])));
    const float sum = wave_sum((__builtin_amdgcn_exp2f(SC[lane] - mx) + __builtin_amdgcn_exp2f(SC[64 + lane] - mx)) + (__builtin_amdgcn_exp2f(SC[128 + lane] - mx) + __builtin_amdgcn_exp2f(SC[192 + lane] - mx)));
    f32x4 a = (f32x4){0.f, 0.f, 0.f, 0.f};
#pragma unroll
    for (int i0 = 0; i0 < 32; i0 += 8) { f32x4 n[8];
        if (i0 + 8 < 32) {
#pragma unroll
            for (int k8 = 0; k8 < 8; ++k8) n[k8] = ld4nt(Vp + (size_t)(w * 32 + i0 + 8 + k8) * 1024); }
#pragma unroll
        for (int k8 = 0; k8 < 8; ++k8) a += v[k8] * __builtin_amdgcn_exp2f(SC[w * 32 + i0 + k8] - mx);
        if (i0 + 8 < 32) {
#pragma unroll
            for (int k8 = 0; k8 < 8; ++k8) v[k8] = n[k8]; } }
    *(LAS f32x4*)(RED + w * 256 + 4 * lane) = a;
    __syncthreads();
    if (tid < 64) { f32x4 o = (f32x4){0.f, 0.f, 0.f, 0.f};
#pragma unroll
        for (int k = 0; k < 8; ++k) o += *(LAS f32x4*)(RED + k * 256 + 4 * tid);
        const float inv = 1.f / sum; u32x2 wv; wv.x = cvt_pk_bf16(o[0] * inv, o[1] * inv); wv.y = cvt_pk_bf16(o[2] * inv, o[3] * inv);
        *(u32x2*)(OX + (size_t)(MP + b) * 1024 + h * 256 + 4 * tid) = wv; }
    __syncthreads();
}

__device__ __forceinline__ void conv_mix_rows(const Ctx& C, const Args& args, unsigned char* ws, int row0, int row1) {
    const int gw = C.vcu * 8 + C.wave, NGW = C.G * 8;
        const bf16* BG = (const bf16*)(ws + WS_Q); const bf16* CI = (const bf16*)(ws + WS_KB); bf16* UB = (bf16*)(ws + WS_UB); const float* cw = KIN(I_CW); const int lane_ = olane();
    for (int row = row0 + gw; row < row1; row += NGW) {
#pragma unroll
            for (int hf = 0; hf < 2; ++hf) { const int col = hf * 512 + 8 * lane_; float c0[8], c1[8], c2[8];
                if (row < MP) { const int t = row & 8191;
                    const u32x4 z = (u32x4){0u, 0u, 0u, 0u};
                    const u32x4 a0 = t >= 2 ? *(const u32x4*)(CI + (size_t)(row - 2) * 1024 + col) : z, a1 = t >= 1 ? *(const u32x4*)(CI + (size_t)(row - 1) * 1024 + col) : z, a2 = *(const u32x4*)(CI + (size_t)row * 1024 + col);
#pragma unroll
                    for (int k = 0; k < 4; ++k) { c0[2 * k] = bflo(a0[k]); c0[2 * k + 1] = bfhi(a0[k]); c1[2 * k] = bflo(a1[k]); c1[2 * k + 1] = bfhi(a1[k]); c2[2 * k] = bflo(a2[k]); c2[2 * k + 1] = bfhi(a2[k]); }
                } else { const int b = row - MP; const float* sc = KIN(I_SCONV) + (size_t)b * 2048 + col; const float* cn = args.out + O_CONVS + ((size_t)b * 2 + 1) * 1024 + col; float* co = args.out + O_CONVS + ((size_t)b * 2) * 1024 + col;
#pragma unroll
                    for (int k = 0; k < 8; ++k) { c0[k] = sc[k]; c1[k] = sc[1024 + k]; c2[k] = cn[k]; co[k] = c1[k]; } }
                const u32x4 bgv = *(const u32x4*)(BG + (size_t)row * 1024 + col); float o[8];
#pragma unroll
                for (int k = 0; k < 8; ++k) { const float bgk = (k & 1) ? bfhi(bgv[k >> 1]) : bflo(bgv[k >> 1]); o[k] = bgk * (cw[col + k] * c0[k] + cw[1024 + col + k] * c1[k] + cw[2048 + col + k] * c2[k]); }
                u32x4 r; r.x = cvt_pk_bf16(o[0], o[1]); r.y = cvt_pk_bf16(o[2], o[3]); r.z = cvt_pk_bf16(o[4], o[5]); r.w = cvt_pk_bf16(o[6], o[7]);
                *(u32x4*)(UB + (size_t)row * 1024 + col) = r; } }
}
__device__ __forceinline__ void conv_mix_sample(const Ctx& C, const Args& args, unsigned char* ws) {
    const int gw = C.vcu * 8 + C.wave, NGW = C.G * 8, lane_ = olane();
    const bf16* BG = (const bf16*)(ws + WS_Q); bf16* UB = (bf16*)(ws + WS_UB); const float* cw = KIN(I_CW);
    for (int item = gw; item < 256; item += NGW) { const int b = item >> 1, col = (item & 1) * 512 + 8 * lane_; const size_t row = (size_t)MP + b;
        const float* sc = KIN(I_SCONV) + (size_t)b * 2048 + col; const float* cn = args.out + O_CONVS + ((size_t)b * 2 + 1) * 1024 + col; float* co = args.out + O_CONVS + ((size_t)b * 2) * 1024 + col;
        const f32x4 a0 = ld4(sc), a1 = ld4(sc + 4), b0 = ld4(sc + 1024), b1 = ld4(sc + 1028), c0 = ld4(cn), c1 = ld4(cn + 4);
        const u32x4 bgv = *(const u32x4*)(BG + row * 1024 + col);
        const f32x4 w00 = ld4(cw + col), w01 = ld4(cw + col + 4), w10 = ld4(cw + 1024 + col), w11 = ld4(cw + 1024 + col + 4), w20 = ld4(cw + 2048 + col), w21 = ld4(cw + 2048 + col + 4);
        st4(co, b0); st4(co + 4, b1);
        const f32x4 o0 = (f32x4){bflo(bgv.x), bfhi(bgv.x), bflo(bgv.y), bfhi(bgv.y)} * (w00 * a0 + w10 * b0 + w20 * c0), o1 = (f32x4){bflo(bgv.z), bfhi(bgv.z), bflo(bgv.w), bfhi(bgv.w)} * (w01 * a1 + w11 * b1 + w21 * c1);
        *(u32x4*)(UB + row * 1024 + col) = pack8(o0, o1); }
}
__device__ __forceinline__ void pool_mix_rows(const Ctx& C, const Args& args, unsigned char* ws, int item0, int item1) {
    const int gw = C.vcu * 8 + C.wave, NGW = C.G * 8;
        const u64* ss = (const u64*)(ws + WS_SS) + (size_t)9 * MT; const bf16* XB = (const bf16*)(ws + WS_XB); const float* ng = KIN(I_NG) + 9 * 1024; bf16* UB = (bf16*)(ws + WS_UB); const int lane_ = olane();
    for (int item = item0 + gw; item < item1; item += NGW) { const int row = item >> 2, gi = item & 3, w = 2 << gi, col = gi * 256 + 4 * lane_;
            const f32x4 g4 = ld4(ng + col);
#define LDX(rr) ({ const u32x2 t_ = *(const u32x2*)(XB + (size_t)(rr) * 1024 + col); (f32x4){bflo(t_.x), bfhi(t_.x), bflo(t_.y), bfhi(t_.y)}; })
            const f32x4 hn = LDX(row) * rstd_of(ss[row]) * g4; f32x4 sum = hn; float cnt;
            if (row < MP) { const int t = row & 8191; const int n = (t + 1 < w) ? t + 1 : w; cnt = (float)n;
                for (int j = 1; j < n; ++j) sum += LDX(row - j) * rstd_of(ss[row - j]) * g4;
                if (t >= 8177) st4(args.out + O_POOLP + ((size_t)(row >> 13) * 15 + (t - 8177)) * 1024 + col, hn);
            } else { const int b = row - MP; cnt = (float)w; const float* sp = KIN(I_SPOOL) + (size_t)b * 15 * 1024 + col;
                for (int j = 1; j < w; ++j) sum += ld4(sp + (size_t)(15 - j) * 1024);
                st4(args.out + O_POOLS + ((size_t)b * 15 + 14) * 1024 + col, hn); }
#undef LDX
            const f32x4 dd = sum * (1.f / cnt) - hn; u32x2 wv; wv.x = cvt_pk_bf16(dd[0], dd[1]); wv.y = cvt_pk_bf16(dd[2], dd[3]);
            *(u32x2*)(UB + (size_t)row * 1024 + col) = wv; }
}
__device__ __forceinline__ void pool_mix_sample(const Ctx& C, const Args& args, unsigned char* ws) {
    const int gw = C.vcu * 8 + C.wave, NGW = C.G * 8, lane_ = olane();
    const u64* ss = (const u64*)(ws + WS_SS) + (size_t)9 * MT; const bf16* XB = (const bf16*)(ws + WS_XB); const float* ng = KIN(I_NG) + 9 * 1024; bf16* UB = (bf16*)(ws + WS_UB);
    for (int item = gw; item < 512; item += NGW) { const int b = item >> 2, gi = item & 3, w = 2 << gi, col = gi * 256 + 4 * lane_; const size_t row = (size_t)MP + b;
        const float* sp = KIN(I_SPOOL) + (size_t)b * 15 * 1024 + col;
        const f32x4 g4 = ld4(ng + col); const u32x2 xv = *(const u32x2*)(XB + row * 1024 + col); const u64 sv = ss[row];
        f32x4 st[15];
#pragma unroll
        for (int j = 1; j < 16; ++j) st[j - 1] = ld4(sp + (size_t)(15 - j) * 1024);
        const f32x4 hn = (f32x4){bflo(xv.x), bfhi(xv.x), bflo(xv.y), bfhi(xv.y)} * rstd_of(sv) * g4; f32x4 sum = hn;
#pragma unroll
        for (int j = 1; j < 16; ++j) if (j < w) sum += st[j - 1];
        st4(args.out + O_POOLS + ((size_t)b * 15 + 14) * 1024 + col, hn);
        const f32x4 dd = sum * (1.f / (float)w) - hn;
        *(u32x2*)(UB + row * 1024 + col) = (u32x2){cvt_pk_bf16(dd[0], dd[1]), cvt_pk_bf16(dd[2], dd[3])}; }
}
__device__ __forceinline__ void pool_state_copy(const Ctx& C, int b, const float* spool, float* out) {
    const int tid = otid(); const float* src = spool + ((size_t)b * 15 + 1) * 1024; float* dst = out + O_POOLS + (size_t)b * 15 * 1024; f32x4 v[7];
#pragma unroll
    for (int k = 0; k < 7; ++k) v[k] = ld4(src + 4 * (size_t)(tid + 512 * k));
#pragma unroll
    for (int k = 0; k < 7; ++k) st4(dst + 4 * (size_t)(tid + 512 * k), v[k]);
}
__device__ __forceinline__ void final_rows(const Ctx& C, const Args& args, unsigned char* ws, int row0, int row1) {
    const int gw = C.vcu * 8 + C.wave, NGW = C.G * 8;
        const u64* ss = (const u64*)(ws + WS_SS) + (size_t)12 * MT; const float* fg = KIN(I_FNG); const int lane_ = olane(); const bf16* XB = (const bf16*)(ws + WS_XB); float* xf = args.out;
        f32x4 gg[4];
#pragma unroll
        for (int hf = 0; hf < 2; ++hf) { gg[2 * hf] = ld4(fg + hf * 512 + 8 * lane_); gg[2 * hf + 1] = ld4(fg + hf * 512 + 8 * lane_ + 4); }
        for (int row = row0 + gw; row < row1; row += 2 * NGW) { const int row2 = (row + NGW < row1) ? row + NGW : row;
            u32x4 v[2], w[2];
#pragma unroll
            for (int hf = 0; hf < 2; ++hf) { v[hf] = *(const u32x4*)(XB + (size_t)row * 1024 + hf * 512 + 8 * lane_); w[hf] = *(const u32x4*)(XB + (size_t)row2 * 1024 + hf * 512 + 8 * lane_); }
            const float r = rstd_of(ss[row]), r2 = rstd_of(ss[row2]);
#pragma unroll
            for (int hf = 0; hf < 2; ++hf) { float* o = xf + (size_t)row * 1024 + hf * 512 + 8 * lane_;
                st4(o, (f32x4){bflo(v[hf].x), bfhi(v[hf].x), bflo(v[hf].y), bfhi(v[hf].y)} * r * gg[2 * hf]); st4(o + 4, (f32x4){bflo(v[hf].z), bfhi(v[hf].z), bflo(v[hf].w), bfhi(v[hf].w)} * r * gg[2 * hf + 1]); }
            if (row2 != row) {
#pragma unroll
                for (int hf = 0; hf < 2; ++hf) { float* o = xf + (size_t)row2 * 1024 + hf * 512 + 8 * lane_;
                    st4(o, (f32x4){bflo(w[hf].x), bfhi(w[hf].x), bflo(w[hf].y), bfhi(w[hf].y)} * r2 * gg[2 * hf]); st4(o + 4, (f32x4){bflo(w[hf].z), bfhi(w[hf].z), bflo(w[hf].w), bfhi(w[hf].w)} * r2 * gg[2 * hf + 1]); } } }
}


__device__ __forceinline__ f32x4 bf4(u32x2 t) { return (f32x4){bflo(t.x), bfhi(t.x), bflo(t.y), bfhi(t.y)}; }
__device__ __forceinline__ void pool_mix_runs(const Ctx& C, unsigned char* ws, float* out) {
    const int gw = C.vcu * 8 + C.wave, NGW = C.G * 8, lane_ = olane();
    const u64* ss = (const u64*)(ws + WS_SS) + (size_t)9 * MT; const bf16* XBp = (const bf16*)(ws + WS_XB); bf16* UB = (bf16*)(ws + WS_UB); const float* ng = KIN(I_NG) + 9 * 1024;
    for (int item = gw; item < (MP / 32) * 4; item += NGW) { const int gi = item & 3, row0 = (item >> 2) * 32, t0 = row0 & 8191, w = 2 << gi, col = gi * 256 + 4 * lane_;
        const f32x4 g4 = ld4(ng + col);
        f32x4 sum = (f32x4){0.f, 0.f, 0.f, 0.f};
        if (t0 > 0) {
            u32x2 a[16]; u64 sa[16];
#pragma unroll
            for (int j = 0; j < 16; ++j) { const int r = row0 - 1 - (j < w ? j : 0); a[j] = *(const u32x2*)(XBp + (size_t)r * 1024 + col); sa[j] = ss[r]; }
#pragma unroll
            for (int j = 0; j < 16; ++j) if (j < w) sum += bf4(a[j]) * (rstd_of(sa[j]) * g4);
        }
#pragma unroll 1
        for (int k0 = 0; k0 < 32; k0 += 8) { u32x2 a[8], o[8]; u64 sa[8], so[8];
#pragma unroll
            for (int k = 0; k < 8; ++k) { const int r = row0 + k0 + k, ro = (t0 + k0 + k - w >= 0) ? r - w : r; a[k] = *(const u32x2*)(XBp + (size_t)r * 1024 + col); sa[k] = ss[r]; o[k] = *(const u32x2*)(XBp + (size_t)ro * 1024 + col); so[k] = ss[ro]; }
#pragma unroll
            for (int k = 0; k < 8; ++k) { const int r = row0 + k0 + k, t = t0 + k0 + k; const f32x4 hn = bf4(a[k]) * (rstd_of(sa[k]) * g4);
                sum += hn; if (t - w >= 0) sum -= bf4(o[k]) * (rstd_of(so[k]) * g4);
                const float cnt = (float)((t + 1 < w) ? t + 1 : w); const f32x4 dd = sum * (1.f / cnt) - hn;
                *(u32x2*)(UB + (size_t)r * 1024 + col) = (u32x2){cvt_pk_bf16(dd[0], dd[1]), cvt_pk_bf16(dd[2], dd[3])};
                if (t >= 8177) st4(out + O_POOLP + ((size_t)(r >> 13) * 15 + (t - 8177)) * 1024 + col, hn); } }
    }
}
__device__ __forceinline__ void conv_mix_runs(const Ctx& C, unsigned char* ws) {
    const int gw = C.vcu * 8 + C.wave, NGW = C.G * 8, lane_ = olane();
    const bf16* BG = (const bf16*)(ws + WS_Q); const bf16* CI = (const bf16*)(ws + WS_KB); bf16* UB = (bf16*)(ws + WS_UB); const float* cw = KIN(I_CW);
    for (int run = gw; run < MP / 8; run += NGW) { const int row0 = run * 8, t0 = row0 & 8191;
#pragma unroll 1
        for (int hf = 0; hf < 2; ++hf) { const int col = hf * 512 + 8 * lane_;
            u32x4 ci[10], bgv[8]; const u32x4 z = (u32x4){0u, 0u, 0u, 0u};
#pragma unroll
            for (int k = 0; k < 10; ++k) ci[k] = (t0 + k - 2 >= 0) ? *(const u32x4*)(CI + (size_t)(row0 + k - 2) * 1024 + col) : z;
#pragma unroll
            for (int k = 0; k < 8; ++k) bgv[k] = *(const u32x4*)(BG + (size_t)(row0 + k) * 1024 + col);
            f32x4 w0[2], w1[2], w2[2];
#pragma unroll
            for (int q = 0; q < 2; ++q) { w0[q] = ld4(cw + col + 4 * q); w1[q] = ld4(cw + 1024 + col + 4 * q); w2[q] = ld4(cw + 2048 + col + 4 * q); }
#pragma unroll
            for (int k = 0; k < 8; ++k) { u32x4 r;
#pragma unroll
                for (int q = 0; q < 2; ++q) { const f32x4 c0 = bf4((u32x2){ci[k][2 * q], ci[k][2 * q + 1]}), c1 = bf4((u32x2){ci[k + 1][2 * q], ci[k + 1][2 * q + 1]}), c2 = bf4((u32x2){ci[k + 2][2 * q], ci[k + 2][2 * q + 1]});
                    const f32x4 o = bf4((u32x2){bgv[k][2 * q], bgv[k][2 * q + 1]}) * (w0[q] * c0 + w1[q] * c1 + w2[q] * c2);
                    r[2 * q] = cvt_pk_bf16(o[0], o[1]); r[2 * q + 1] = cvt_pk_bf16(o[2], o[3]); }
                *(u32x4*)(UB + (size_t)(row0 + k) * 1024 + col) = r; } }
    }
}


__device__ __forceinline__ void xattn_unit(const Ctx& C, int pm, int h, int lb  , const bf16* Q, const bf16* MK, const bf16* MVT, bf16* OX) {
    const int lane_ = olane(), w = C.wave, l15 = lane_ & 15, g = lane_ >> 4, tid = w * 64 + lane_;
    LAS unsigned char* KL = C.lds;
    {   u32x4 st[16];
#pragma unroll
        for (int i = 0; i < 16; ++i) { const int c = tid + 512 * i, row = c >> 5, ch = c & 31; st[i] = *(const u32x4*)(MK + ((size_t)lb * 256 + row) * 1024 + h * 256 + ch * 8); }
#pragma unroll
        for (int i = 0; i < 16; ++i) { const int c = tid + 512 * i, row = c >> 5, ch = c & 31; *(LAS u32x4*)(KL + row * 528 + ch * 16) = st[i]; } }
    __syncthreads();
    bf16x8 pf[2][8];
    float inv[2];
#pragma unroll
    for (int t = 0; t < 2; ++t) {
        bf16x8 qf[8];
#pragma unroll
        for (int ks = 0; ks < 8; ++ks) qf[ks] = *(const bf16x8*)(Q + ((size_t)pm * 256 + 32 * w + 16 * t + l15) * 1024 + h * 256 + ks * 32 + 8 * g);
        f32x4 sc[16];
#pragma unroll
        for (int kt = 0; kt < 16; ++kt) { f32x4 a0 = (f32x4){0.f, 0.f, 0.f, 0.f}; const LAS unsigned char* kp = KL + (kt * 16 + l15) * 528 + g * 16;
#pragma unroll
            for (int ks = 0; ks < 8; ++ks) a0 = mfma16(*(const LAS bf16x8*)(kp + ks * 64), qf[ks], a0);
            sc[kt] = a0; }
        float mx = -3.0e38f;
#pragma unroll
        for (int kt = 0; kt < 16; ++kt)
#pragma unroll
            for (int e = 0; e < 4; ++e) mx = fmaxf(mx, sc[kt][e]);
        mx = fmaxf(mx, __shfl_xor(mx, 16)); mx = fmaxf(mx, __shfl_xor(mx, 32));
        float z = 0.f;
#pragma unroll
        for (int kt = 0; kt < 16; ++kt)
#pragma unroll
            for (int e = 0; e < 4; ++e) { const float p = __builtin_amdgcn_exp2f(sc[kt][e] - mx); sc[kt][e] = p; z += p; }
        z += __shfl_xor(z, 16); z += __shfl_xor(z, 32);
        inv[t] = 1.f / z;
#pragma unroll
        for (int ks = 0; ks < 8; ++ks) pf[t][ks] = __builtin_bit_cast(bf16x8, pack8(sc[2 * ks], sc[2 * ks + 1]));
    }
    __syncthreads();
    {   u32x4 st[16];
#pragma unroll
        for (int i = 0; i < 16; ++i) { const int c = tid + 512 * i, row = c >> 5, ch = c & 31; st[i] = *(const u32x4*)(MVT + ((size_t)lb * 1024 + h * 256 + row) * 1024 + ch * 8); }
#pragma unroll
        for (int i = 0; i < 16; ++i) { const int c = tid + 512 * i, row = c >> 5, ch = c & 31; *(LAS u32x4*)(KL + row * 528 + ch * 16) = st[i]; } }
    __syncthreads();
    const int drow = 8 * (l15 >> 2) + (l15 & 3);
    bf16* o0p = OX + ((size_t)pm * 256 + 32 * w + l15) * 1024 + h * 256 + 8 * g; bf16* o1p = o0p + (size_t)16 * 1024;
#pragma unroll
    for (int dp = 0; dp < 8; ++dp) { f32x4 e0 = (f32x4){0.f, 0.f, 0.f, 0.f}, e1 = e0, f0 = e0, f1 = e0;
        const LAS unsigned char* vpe = KL + (32 * dp + drow) * 528 + g * 8; const LAS unsigned char* vpo = vpe + 4 * 528;
#pragma unroll
        for (int ks = 0; ks < 8; ++ks) { const u32x2 a = *(const LAS u32x2*)(vpe + ks * 64), b = *(const LAS u32x2*)(vpe + ks * 64 + 32), c2 = *(const LAS u32x2*)(vpo + ks * 64), d2 = *(const LAS u32x2*)(vpo + ks * 64 + 32);
            const bf16x8 ve = __builtin_bit_cast(bf16x8, (u32x4){a.x, a.y, b.x, b.y}), vo = __builtin_bit_cast(bf16x8, (u32x4){c2.x, c2.y, d2.x, d2.y});
            e0 = mfma16(ve, pf[0][ks], e0); e1 = mfma16(ve, pf[1][ks], e1); f0 = mfma16(vo, pf[0][ks], f0); f1 = mfma16(vo, pf[1][ks], f1); }
        st8b(o0p + 32 * dp, e0 * inv[0], f0 * inv[0]); st8b(o1p + 32 * dp, e1 * inv[1], f1 * inv[1]); }
    __syncthreads();
}

#define SSP(k) ((u64*)(ws + WS_SS) + (size_t)(k) * MT)
#define XBS ((bf16*)(ws + WS_XB) + (size_t)MP * 1024)
__device__ __forceinline__ void s_in0(const Ctx& C, unsigned char* ws) {
    EpiRetIn E{SSP(0), (const float*)(ws + T_CR), (const float*)(ws + T_SR), (bf16*)(ws + WS_Q), (bf16*)(ws + WS_KB), (bf16*)(ws + WS_APQ), (bf16*)(ws + WS_G), (float*)(ws + WS_SQ)};
    sample_gemm<8>(C, XBS, 1024, 0, (const bf16*)(ws + W_RET_IN), 1024, 262144u, 1024, 24 * 8, 0, E);
}
__device__ __forceinline__ void s_ret(const Ctx& C, unsigned char* ws, float* out, int un) {
    if (un < 512) ret_sample_unit(C, un, (const float*)(ws + WS_SQ), KIN(I_SRET), (const bf16*)(ws + WS_G), out, (bf16*)(ws + WS_UB), C.lds + EPIX_OFF); }
struct RetSide { Ctx C; unsigned char* ws; float* out; int slot, un;
    __device__ __forceinline__ void operator()(int ui) const { if (ui == slot) s_ret(C, ws, out, un); } };
__device__ __forceinline__ void s_out0(const Ctx& C, const Args& args, unsigned char* ws) {
    EpiResidual E{KIN(I_XP), KIN(I_XS), (bf16*)(ws + WS_XB), SSP(1)};
    sample_gemm<2>(C, (const bf16*)(ws + WS_UB) + (size_t)MP * 2048, 2048, 0, (const bf16*)(ws + W_RET_OUT), 2048, 256u * 2048u, 2048, 32, 0, E);
}
__device__ __forceinline__ void s_xq(const Ctx& C, unsigned char* ws, int L) {
    EpiScale E{SSP(3 * L + 1), LOG2E * 0.0625f, (bf16*)(ws + WS_Q), 1024};
    sample_gemm<2>(C, XBS, 1024, 0, (const bf16*)(ws + W_XQ + (size_t)L * 1048576 * 2), 1024, 262144u, 1024, 32, 0, E);
}
__device__ __forceinline__ void s_xo(const Ctx& C, unsigned char* ws, int L) {
    EpiResidual E{nullptr, nullptr, (bf16*)(ws + WS_XB), SSP(3 * L + 2)};
    sample_gemm<2>(C, (const bf16*)(ws + WS_OX) + (size_t)MP * 1024, 1024, 0, (const bf16*)(ws + W_XO + (size_t)L * 1048576 * 2), 1024, 262144u, 1024, 32, 0, E);
}
__device__ __forceinline__ void s_fin(const Ctx& C, unsigned char* ws, int L) {
    EpiSwiGLU E{SSP(3 * L + 2), (bf16*)(ws + WS_HF)};
    sample_gemm<8>(C, XBS, 1024, 0, (const bf16*)(ws + W_FIN + (size_t)L * 1024 * 5632 * 2), 1024, 262144u, 1024, 22 * 8, 0, E);
}
__device__ __forceinline__ void s_fout(const Ctx& C, unsigned char* ws, int L) {
    EpiResidual E{nullptr, nullptr, (bf16*)(ws + WS_XB), SSP(3 * L + 3)};
    sample_gemm<2>(C, (const bf16*)(ws + WS_HF) + (size_t)MP * DFF, DFF, 0, (const bf16*)(ws + W_FOUT + (size_t)L * 2816 * 1024 * 2), DFF, 256u * DFF, DFF, 32, 0, E);
}
__device__ __forceinline__ void s_in1(const Ctx& C, const Args& args, unsigned char* ws) {
    EpiSwaQKV E{SSP(3), (const float*)(ws + T_CS), (const float*)(ws + T_SN), (bf16*)(ws + WS_Q), (bf16*)(ws + WS_KB), (float*)(ws + WS_SQ), args.out};
    sample_gemm<2>(C, XBS, 1024, 0, (const bf16*)(ws + W_SWA_QKV), 1024, 262144u, 1024, 48, 0, E);
}
__device__ __forceinline__ void s_swa(const Ctx& C, const Args& args, unsigned char* ws) {
    for (int u = C.G - 1 - C.vcu; u < 256; u += C.G) swa_sample_half(C, u, (const float*)(ws + WS_SQ), KIN(I_CSK), KIN(I_CSV), KIN(I_SINK), args.out, (bf16*)(ws + WS_OX));
}
__device__ __forceinline__ void s_out1(const Ctx& C, unsigned char* ws) {
    EpiResidual E{nullptr, nullptr, (bf16*)(ws + WS_XB), SSP(4)};
    sample_gemm<2>(C, (const bf16*)(ws + WS_OX) + (size_t)MP * 1024, 1024, 0, (const bf16*)(ws + W_SWA_O), 1024, 262144u, 1024, 32, 0, E);
}
__device__ __forceinline__ void s_in2(const Ctx& C, const Args& args, unsigned char* ws) {
    EpiConvIn E{SSP(6), (bf16*)(ws + WS_Q), (bf16*)(ws + WS_KB), args.out};
    sample_gemm<4>(C, XBS, 1024, 0, (const bf16*)(ws + W_CONV_IN), 1024, 262144u, 1024, 96, 0, E);
}
__device__ __forceinline__ void s_out2(const Ctx& C, unsigned char* ws) {
    EpiResidual E{nullptr, nullptr, (bf16*)(ws + WS_XB), SSP(7)};
    sample_gemm<2>(C, (const bf16*)(ws + WS_UB) + (size_t)MP * 1024, 1024, 0, (const bf16*)(ws + W_CONV_OUT), 1024, 262144u, 1024, 32, 0, E);
}
__device__ __forceinline__ void s_out3(const Ctx& C, unsigned char* ws) {
    EpiResidual E{nullptr, nullptr, (bf16*)(ws + WS_XB), SSP(10)};
    sample_gemm<2>(C, (const bf16*)(ws + WS_UB) + (size_t)MP * 1024, 1024, 256, (const bf16*)(ws + W_POOL), 256, 65536u, 256, 32, 0, E);
}
template <int L> struct XsSide { Ctx C; unsigned char* ws; int u0, n, s0, s1, s2;
    __device__ __forceinline__ void run(int un) const {
        if (un < 512) xs_sample_unit(C, un, (const bf16*)(ws + WS_Q), KIN(I_CMK) + (size_t)L * 128 * 256 * 1024, KIN(I_CMV) + (size_t)L * 128 * 256 * 1024, (bf16*)(ws + WS_OX), C.lds + EPIX_OFF); }
    __device__ __forceinline__ void operator()(int ui) const {
        if (ui == s0 && n > 0) run(u0);
        if (ui == s1 && n > 1) run(u0 + 1);
        if (ui == s2 && n > 2) run(u0 + 2);
    }
};

enum { PH_PRO = 0, PH_SIN0, PH_R_IN, PH_R_PU, PH_R_SCAN, PH_R_O, PH_R_NORM, PH_R_OUT, PH_C0,
       PH_S_QKV = PH_C0 + 6, PH_S_ATT, PH_S_OUT, PH_C1, PH_V_IN = PH_C1 + 6, PH_V_MIX, PH_V_OUT, PH_C2, PH_P_MIX = PH_C2 + 6, PH_P_OUT, PH_C3, PH_E1 = PH_C3 + 6, PH_E2, PH_FINAL, NPH };

struct KS { unsigned char* ws; float* out; int lo, hi, G, bx; };
#if MK_ONE_LAUNCH
#define IN(k) ((k) <= DBG_LAST)
#else
#define IN(k) (K.lo <= (k) && (k) < K.hi)
#endif
#define AMP_HOOK(k) do { if (AMP_MASK != 0ull) { if (blockIdx.x == 0) { if (threadIdx.x == 0) { LAS unsigned long long* tp = (LAS unsigned long long*)(C.lds + MISC_OFF + 64); \
        const unsigned long long now = __builtin_amdgcn_s_memrealtime(), prev = *tp; \
        if ((AMP_MASK >> (k)) & 1ull) { const unsigned long long target = now + AMP_FACTOR * (now - prev); while (__builtin_amdgcn_s_memrealtime() < target) __builtin_amdgcn_s_sleep(8); } \
        *tp = __builtin_amdgcn_s_memrealtime(); } __syncthreads(); } } } while (0)
#define SEAM(k) do { if (MK_ONE_LAUNCH && IN(k) && IN((k) + 1)) { xcd_barrier(bar); AMP_HOOK(k); } } while (0)
#define ROT(n) ((K.bx + (n)) % K.G)

template <int L, int BASE>
__device__ __forceinline__ void common_layer(const Ctx& C, const Args& args, const KS& K, const XcdBarrier& bar) {
    unsigned char* ws = K.ws; LAS unsigned char* ring = C.lds + RING_OFF; const int G = K.G;
    u64* SS = (u64*)(ws + WS_SS); float* xf = K.out; bf16* XB = (bf16*)(ws + WS_XB);
    if (IN(BASE + 0)) {
        Gemm g{XB, (const bf16*)(ws + WS_WQK + (size_t)L * 2 * 1048576 * 2), 1024, 1024, 1024};
        pg8::Sched<DecGridB> S{256, G, K.bx, DecGridB{DecGrid{64, 4, 0u, 262144u, 0u, 0u, 0u, 262144u}}};
        EpiSoftmaxR E{SS + (size_t)(3 * L + 1) * MT, (bf16*)(ws + WS_PX), (LAS float*)(C.lds + EPIX_OFF)};
        pg8::gemm_phase<EpiSoftmaxR, pg8::Sched<DecGridB>>(ring, g, S, E, C.wave);
        if constexpr (L == 0) s_xq(C, ws, 0);
        else if constexpr (L == 1) s_swa(C, args, ws);
        else if constexpr (L == 2) conv_mix_sample(C, args, ws);
        else pool_mix_sample(C, args, ws);
    }
    SEAM(BASE + 0);
    if (IN(BASE + 1)) {
        Gemm g{(const bf16*)(ws + WS_PX), (const bf16*)(ws + WS_VWO + (size_t)L * 2 * 1048576 * 2), 1024, 1024, 1024};
        pg8::Sched<DecGridB> S{256, G, K.bx, DecGridB{DecGrid{64, 4, 0u, 262144u, 0u, 0u, 0u, 262144u}}};
        EpiResidual E{nullptr, nullptr, XB, SS + (size_t)(3 * L + 2) * MT};
        pg8::gemm_phase<EpiResidual, pg8::Sched<DecGridB>>(ring, g, S, E, C.wave);
        if constexpr (L == 1) s_out1(C, ws); else if constexpr (L == 2) s_out2(C, ws); else if constexpr (L == 3) s_out3(C, ws);
    }
    SEAM(BASE + 1);
    if constexpr (L >= 1) {
        if (IN(BASE + 3)) s_xq(C, ws, L);
        SEAM(BASE + 3);
    }
    if (IN(BASE + 4)) {
        Gemm g{XB, (const bf16*)(ws + W_FIN + (size_t)L * 1024 * 5632 * 2), 1024, 1024, 1024};
        const bool six = (G == 256) && K.bx < 128; const int sl = K.bx & 1;
        const XsSide<L> side = (G == 256) ? (six ? XsSide<L>{C, ws, K.bx, 1, 1 + 2 * sl, -1, -1} : XsSide<L>{C, ws, 128 + 3 * (K.bx - 128), 3, sl, 2 + sl, 4})
                                           : XsSide<L>{C, ws, 0, 0, -1, -1, -1};
        pg8::Sched<DecGrid, XsSide<L>> S{64 * 22, G, K.bx, DecGrid{64, 22, 0u, 262144u, 0u, 0u, 0u, 262144u}, side};
        EpiSwiGLU E{SS + (size_t)(3 * L + 2) * MT, (bf16*)(ws + WS_HF)};
        pg8::gemm_phase<EpiSwiGLU, pg8::Sched<DecGrid, XsSide<L>>>(ring, g, S, E, C.wave);
        if (G != 256) for (int un = C.vcu; un < 512; un += G) S.side.run(un);
    }
    SEAM(BASE + 4);
    if (IN(BASE + 5)) {
        Gemm g{(const bf16*)(ws + WS_HF), (const bf16*)(ws + W_FOUT + (size_t)L * 2816 * 1024 * 2), DFF, DFF, DFF};
        pg8::Sched<DecGrid> S{256, G, K.bx, DecGrid{64, 4, 0u, 256u * DFF, 0u, 0u, 0u, 256u * DFF}};
        if constexpr (L == 3) {
            if (G == 256) {
                EpiResFinal E{XB, SS + (size_t)12 * MT, KIN(I_FNG), xf, (unsigned*)(ws + WS_PC), (unsigned*)(ws + WS_CTL) + 4096};
                pg8::gemm_phase<EpiResFinal, pg8::Sched<DecGrid>>(ring, g, S, E, C.wave);
            } else {
                EpiResidual E{nullptr, nullptr, XB, SS + (size_t)12 * MT};
                pg8::gemm_phase<EpiResidual, pg8::Sched<DecGrid>>(ring, g, S, E, C.wave);
            }
        } else {
            EpiResidual E{nullptr, nullptr, XB, SS + (size_t)(3 * L + 3) * MT};
            pg8::gemm_phase<EpiResidual, pg8::Sched<DecGrid>>(ring, g, S, E, C.wave);
        }
        s_xo(C, ws, L);
    }
    SEAM(BASE + 5);
}

__global__ void __launch_bounds__(512, 2) hybrid_fwd(Args args) {
    extern __shared__ __attribute__((aligned(16))) unsigned char lds_raw[];
    Ctx C; C.lds = (LAS unsigned char*)lds_raw; C.wave = __builtin_amdgcn_readfirstlane((int)threadIdx.x >> 6);
    C.G = gridDim.x; { const int bx = blockIdx.x; C.vcu = (C.G % 8 == 0) ? (bx % 8) * (C.G / 8) + bx / 8 : bx; }
    unsigned char* ws = args.ws;
    volatile LAS unsigned* MISC = (volatile LAS unsigned*)(C.lds + MISC_OFF);
    for (int u = threadIdx.x; u < (LDS_BYTES - LDSCTL_OFF) / 4; u += 512) ((LAS unsigned*)(C.lds + LDSCTL_OFF))[u] = 0u;
    __syncthreads();
    XcdBarrier bar; bar.bar = (unsigned*)(ws + WS_CTL) + 4096; bar.x = 0; bar.st = nullptr;
    if (MK_ONE_LAUNCH) bar = xcd_barrier_post((unsigned*)(ws + WS_CTL) + 4096, MISC + 8);
    if (AMP_MASK != 0ull && threadIdx.x == 0) *(LAS unsigned long long*)(C.lds + MISC_OFF + 64) = __builtin_amdgcn_s_memrealtime();
    KS K; K.ws = ws; K.out = args.out; K.lo = args.ph_lo; K.hi = args.ph_hi; K.G = C.G; K.bx = (int)blockIdx.x;
    const int G = C.G;
#define SS ((u64*)(ws + WS_SS))
#define ST ((u64*)(ws + WS_ST))
#define XB ((bf16*)(ws + WS_XB))
#define ring (C.lds + RING_OFF)
    const int NGT = G * 512;

    if (IN(PH_PRO)) {
        if (DBG_LAST < 1000) { const int gt0 = C.vcu * 512 + otid(); GAS u32x4* o4 = (GAS u32x4*)args.out; for (size_t e = gt0; e < O_END / 4; e += (size_t)NGT) o4[e] = (u32x4){0u, 0u, 0u, 0u}; }
        p0_prologue(C, args); }
    SEAM(PH_PRO);
    if (IN(PH_SIN0)) { s_in0(C, ws); }
    SEAM(PH_SIN0);

    if (IN(PH_R_IN)) {
        {
            Gemm g{XB, (const bf16*)(ws + W_RET_IN), 1024, 1024, 1024};
            pg8::Sched<DecGrid, RetSide> S{1024, G, K.bx, DecGrid{64, 16, 0u, 262144u, 0u, 0u, 0u, 262144u}, RetSide{C, ws, args.out, K.bx & 3, C.vcu}};
            EpiRetIn E{SS, (const float*)(ws + T_CR), (const float*)(ws + T_SR), (bf16*)(ws + WS_Q), (bf16*)(ws + WS_KB), (bf16*)(ws + WS_APQ), (bf16*)(ws + WS_G), (float*)(ws + WS_SQ)};
            pg8::gemm_phase<EpiRetIn, pg8::Sched<DecGrid, RetSide>>(ring, g, S, E, C.wave);
        }
        {
            Gemm g{(const bf16*)(ws + W_RET_IN), XB, 1024, 1024, 1024};
            pg8::Sched<DecGrid> S{256, G, K.bx, DecGrid{4, 64, 1024u * 1024u, 262144u, 0u, 0u, 0u, 262144u}};
            EpiRetKT E{SS, (const float*)(ws + T_CRT), (const float*)(ws + T_SRT), (bf16*)(ws + WS_KT)};
            pg8::gemm_phase<EpiRetKT, pg8::Sched<DecGrid>>(ring, g, S, E, C.wave);
        }
        {
            Gemm g{(const bf16*)(ws + W_RET_IN), XB, 1024, 1024, 1024};
            pg8::Sched<DecGrid, RetSide> S{512, G, K.bx, DecGrid{8, 64, 4096u * 1024u, 262144u, 0u, 0u, 0u, 262144u}, RetSide{C, ws, args.out, (K.bx >> 2) & 1, C.vcu + G}};
            EpiRetVT E{SS, (bf16*)(ws + WS_VS)};
            pg8::gemm_phase<EpiRetVT, pg8::Sched<DecGrid, RetSide>>(ring, g, S, E, C.wave);
            for (int un = C.vcu + 2 * G; un < 512; un += G) s_ret(C, ws, args.out, un);
        }
    }
    SEAM(PH_R_IN);
    if (IN(PH_R_PU)) {
        {
            Gemm g{(const bf16*)(ws + WS_Q), (const bf16*)(ws + WS_KB), 1024, 1024, 256};
            pg8::Sched<DecGrid> S{256, G, K.bx, DecGrid{64, 4, 0u, 262144u, 256u, 0u, 262144u, 256u}};
            EpiP E{(bf16*)(ws + WS_APQ)};
            pg8::gemm_phase<EpiP, pg8::Sched<DecGrid>>(ring, g, S, E, C.wave);
        }
        {
            Gemm g{(const bf16*)(ws + WS_VS), (const bf16*)(ws + WS_KT), 512, 512, 256};
            pg8::Sched<DecU> S{512, G, K.bx, DecU{}};
            EpiU E{(bf16*)(ws + WS_U)};
            pg8::gemm_phase<EpiU, pg8::Sched<DecU>>(ring, g, S, E, C.wave);
        }
    }
    SEAM(PH_R_PU);
    if (IN(PH_R_SCAN)) {
        if (K.bx < 64 && G > 64) {
        {
            Gemm g{(const bf16*)(ws + WS_MEMN), (const bf16*)(ws + W_XKV), 1024, 1024, 1024};
            pg8::Sched<DecMem> S{64, G, K.bx, DecMem{}};
            EpiMemKV E{args.out, (bf16*)(ws + WS_MK), (bf16*)(ws + WS_MV)};
            pg8::gemm_phase<EpiMemKV, pg8::Sched<DecMem>>(ring, g, S, E, C.wave);
        }
        pool_state_copy(C, 2 * K.bx, KIN(I_SPOOL), args.out); pool_state_copy(C, 2 * K.bx + 1, KIN(I_SPOOL), args.out);
        } else {
        const bf16* U = (const bf16*)(ws + WS_U); bf16* VS = (bf16*)(ws + WS_VS); const int nsc = (G > 64) ? G - 64 : G, gt = ((G > 64) ? K.bx - 64 : K.bx) * 512 + otid(), NGT2 = nsc * 512;
        for (int item = gt; item < 131072; item += NGT2) { const int d8 = item & 31, v = (item >> 5) & 511, bh = item >> 14, h = bh & 3;
            const float gC = __builtin_amdgcn_exp2f(256.f * lg2g(h)); f32x4 s0 = (f32x4){0.f, 0.f, 0.f, 0.f}, s1 = s0;
            for (int c0 = 0; c0 < 32; c0 += 8) { u32x4 uu[8];
#pragma unroll
                for (int k = 0; k < 8; ++k) uu[k] = *(const u32x4*)(U + ((size_t)(bh * 32 + c0 + k) * 512 + v) * 256 + 8 * d8);
#pragma unroll
                for (int k = 0; k < 8; ++k) { *(u32x4*)(VS + ((size_t)(bh * 32 + c0 + k) * 512 + v) * 512 + 256 + 8 * d8) = pack8(s0, s1);
                    s0 = s0 * gC + (f32x4){bflo(uu[k].x), bfhi(uu[k].x), bflo(uu[k].y), bfhi(uu[k].y)}; s1 = s1 * gC + (f32x4){bflo(uu[k].z), bfhi(uu[k].z), bflo(uu[k].w), bfhi(uu[k].w)}; } }
#pragma unroll
            for (int e = 0; e < 4; ++e) { args.out[O_RETP + ((size_t)bh * 256 + 8 * d8 + e) * 512 + v] = s0[e]; args.out[O_RETP + ((size_t)bh * 256 + 8 * d8 + 4 + e) * 512 + v] = s1[e]; } }
        if (G <= 64) for (int b = K.bx; b < 128; b += G) pool_state_copy(C, b, KIN(I_SPOOL), args.out);
        }
    }
    SEAM(PH_R_SCAN);
    if (IN(PH_R_O)) {
        Gemm g{(const bf16*)(ws + WS_APQ), (const bf16*)(ws + WS_VS), 512, 512, 512};
        pg8::Sched<DecO> S{512, G, K.bx, DecO{}};
        if (G == 256) {
            EpiONorm E{(const bf16*)(ws + WS_G), (bf16*)(ws + WS_UB), ST, (unsigned*)(ws + WS_PC2), (unsigned*)(ws + WS_CTL) + 4096};
            pg8::gemm_phase<EpiONorm, pg8::Sched<DecO>>(ring, g, S, E, C.wave);
        } else {
            EpiO E{(bf16*)(ws + WS_O), ST};
            pg8::gemm_phase<EpiO, pg8::Sched<DecO>>(ring, g, S, E, C.wave);
        }
        {
            Gemm g2{(const bf16*)ws, (const bf16*)ws, 1024, 1024, 256};
            pg8::Sched<DecAbs> S2{256, G, K.bx, DecAbs{}};
            EpiAbs E2{(bf16*)(ws + WS_WQK)};
            pg8::gemm_phase<EpiAbs, pg8::Sched<DecAbs>>(ring, g2, S2, E2, C.wave);
        }
    }
    if (G != 256) SEAM(PH_R_O);
    if (IN(PH_R_NORM) && G != 256) {
        const bf16* O = (const bf16*)(ws + WS_O); const bf16* Gt = (const bf16*)(ws + WS_G); bf16* UB = (bf16*)(ws + WS_UB); const int lane_ = otid() & 63;
        const int gw = C.vcu * 8 + C.wave, NGW = G * 8;
        for (int row = gw; row < MP; row += NGW) { u32x4 ov[4], gv[4]; u64 st[8];
#pragma unroll
            for (int h = 0; h < 4; ++h) { const size_t o = (size_t)row * 2048 + h * 512 + 8 * lane_; ov[h] = *(const u32x4*)(O + o); gv[h] = *(const u32x4*)(Gt + o); st[2 * h] = ST[(size_t)row * 8 + 2 * h]; st[2 * h + 1] = ST[(size_t)row * 8 + 2 * h + 1]; }
#pragma unroll
            for (int h = 0; h < 4; ++h) { const float mu = from_fx(st[2 * h]) * (1.f / 512.f); const float var = fmaxf(from_fx(st[2 * h + 1]) * (1.f / 512.f) - mu * mu, 0.f);
                const float rstd = __builtin_amdgcn_rsqf(var + EPS); u32x4 r;
#pragma unroll
                for (int k = 0; k < 4; ++k) r[k] = cvt_pk_bf16(bflo(gv[h][k]) * (bflo(ov[h][k]) - mu) * rstd, bfhi(gv[h][k]) * (bfhi(ov[h][k]) - mu) * rstd);
                *(u32x4*)(UB + (size_t)row * 2048 + h * 512 + 8 * lane_) = r; } }
    }
    SEAM(PH_R_NORM);
    if (IN(PH_R_OUT)) {
        Gemm g{(const bf16*)(ws + WS_UB), (const bf16*)(ws + W_RET_OUT), 2048, 2048, 2048};
        pg8::Sched<DecGrid> S{256, G, K.bx, DecGrid{64, 4, 0u, 256u * 2048u, 0u, 0u, 0u, 256u * 2048u}};
        EpiResidual E{nullptr, nullptr, XB, SS + (size_t)1 * MT};
        pg8::gemm_phase<EpiResidual, pg8::Sched<DecGrid>>(ring, g, S, E, C.wave);
        s_out0(C, args, ws);
    }
    SEAM(PH_R_OUT);
    common_layer<0, PH_C0>(C, args, K, bar);

    if (IN(PH_S_QKV)) {
        {
            Gemm g{XB, (const bf16*)(ws + W_SWA_QKV), 1024, 1024, 1024};
            pg8::Sched<DecGrid> S{384, G, K.bx, DecGrid{64, 6, 0u, 262144u, 0u, 0u, 0u, 262144u}};
            EpiSwaQKV E{SS + (size_t)3 * MT, (const float*)(ws + T_CS), (const float*)(ws + T_SN), (bf16*)(ws + WS_Q), (bf16*)(ws + WS_KB), (float*)(ws + WS_SQ), args.out};
            pg8::gemm_phase<EpiSwaQKV, pg8::Sched<DecGrid>>(ring, g, S, E, C.wave);
        }
        {
            Gemm g{(const bf16*)(ws + W_SWA_QKV), XB, 1024, 1024, 1024};
            pg8::Sched<DecGrid> S{64, G, ROT(128), DecGrid{1, 64, 1280u * 1024u, 0u, 0u, 0u, 0u, 262144u}};
            EpiSwaVT E{SS + (size_t)3 * MT, (bf16*)(ws + WS_KT)};
            pg8::gemm_phase<EpiSwaVT, pg8::Sched<DecGrid>>(ring, g, S, E, C.wave);
        }
        if (G == 256) { if (K.bx >= 192) { swa_state_copy(C, (K.bx - 192) * 2, KIN(I_CSK), KIN(I_CSV), args.out); swa_state_copy(C, (K.bx - 192) * 2 + 1, KIN(I_CSK), KIN(I_CSV), args.out); } }
        else for (int b = C.vcu; b < 128; b += G) swa_state_copy(C, b, KIN(I_CSK), KIN(I_CSV), args.out);
        s_fin(C, ws, 0);
    }
    SEAM(PH_S_QKV);
    if (IN(PH_S_ATT)) {
        for (int un = C.vcu; un < 512; un += G) swa_unit(C, un, (const bf16*)(ws + WS_Q), (const bf16*)(ws + WS_KB), (const bf16*)(ws + WS_KT), KIN(I_SINK), (bf16*)(ws + WS_OX));
        s_fout(C, ws, 0);
    }
    SEAM(PH_S_ATT);
    if (IN(PH_S_OUT)) {
        Gemm g{(const bf16*)(ws + WS_OX), (const bf16*)(ws + W_SWA_O), 1024, 1024, 1024};
        pg8::Sched<DecGrid> S{256, G, K.bx, DecGrid{64, 4, 0u, 262144u, 0u, 0u, 0u, 262144u}};
        EpiResidual E{nullptr, nullptr, XB, SS + (size_t)4 * MT};
        pg8::gemm_phase<EpiResidual, pg8::Sched<DecGrid>>(ring, g, S, E, C.wave);
        s_in1(C, args, ws);
    }
    SEAM(PH_S_OUT);
    common_layer<1, PH_C1>(C, args, K, bar);

    if (IN(PH_V_IN)) {
        Gemm g{XB, (const bf16*)(ws + W_CONV_IN), 1024, 1024, 1024};
        pg8::Sched<DecGrid> S{768, G, K.bx, DecGrid{64, 12, 0u, 262144u, 0u, 0u, 0u, 262144u}};
        EpiConvIn E{SS + (size_t)6 * MT, (bf16*)(ws + WS_Q), (bf16*)(ws + WS_KB), args.out};
        pg8::gemm_phase<EpiConvIn, pg8::Sched<DecGrid>>(ring, g, S, E, C.wave);
        s_fin(C, ws, 1);
    }
    SEAM(PH_V_IN);
    if (IN(PH_V_MIX)) { conv_mix_runs(C, ws); s_fout(C, ws, 1); }
    SEAM(PH_V_MIX);
    if (IN(PH_V_OUT)) {
        Gemm g{(const bf16*)(ws + WS_UB), (const bf16*)(ws + W_CONV_OUT), 1024, 1024, 1024};
        pg8::Sched<DecGrid> S{256, G, K.bx, DecGrid{64, 4, 0u, 262144u, 0u, 0u, 0u, 262144u}};
        EpiResidual E{nullptr, nullptr, XB, SS + (size_t)7 * MT};
        pg8::gemm_phase<EpiResidual, pg8::Sched<DecGrid>>(ring, g, S, E, C.wave);
        s_in2(C, args, ws);
    }
    SEAM(PH_V_OUT);
    common_layer<2, PH_C2>(C, args, K, bar);

    if (IN(PH_P_MIX)) { pool_mix_runs(C, ws, args.out); s_fin(C, ws, 2); }
    SEAM(PH_P_MIX);
    if (IN(PH_P_OUT)) {
        Gemm g{(const bf16*)(ws + WS_UB), (const bf16*)(ws + W_POOL), 1024, 256, 256};
        pg8::Sched<DecGrid> S{256, G, K.bx, DecGrid{64, 4, 0u, 262144u, 256u, 0u, 0u, 65536u}};
        EpiResidual E{nullptr, nullptr, XB, SS + (size_t)10 * MT};
        pg8::gemm_phase<EpiResidual, pg8::Sched<DecGrid>>(ring, g, S, E, C.wave);
        s_fout(C, ws, 2);
    }
    SEAM(PH_P_OUT);
    common_layer<3, PH_C3>(C, args, K, bar);

    if (IN(PH_E1)) { if (G != 256) final_rows(C, args, ws, 0, MP); s_fin(C, ws, 3); }
    SEAM(PH_E1);
    if (IN(PH_E2)) { s_fout(C, ws, 3); }
    SEAM(PH_E2);
    if (IN(PH_FINAL)) {
        final_rows(C, args, ws, MP, MREAL);
        if (AMP_MASK != 0ull && MK_ONE_LAUNCH) { xcd_barrier(bar); AMP_HOOK(PH_FINAL); }
    }
}
#undef IN
#undef SEAM

extern "C" void kernel_launch(void* const* d_in, const int* in_sizes, int n_in, void* d_out, int out_size, void* d_ws, size_t ws_size, hipStream_t stream) {
    static int grid = 0;
    if (grid == 0) {
        if (n_in != 28 || (size_t)out_size != O_END || ws_size < WS_END) { fprintf(stderr, "kernel_launch: unexpected shapes (n_in %d out %d ws %zu need %zu)\n", n_in, out_size, ws_size, (size_t)WS_END); grid = -1; return; }
        int dev = 0, cus = 0, per_cu = 0;
        if (hipGetDevice(&dev) != hipSuccess || hipDeviceGetAttribute(&cus, hipDeviceAttributeMultiprocessorCount, dev) != hipSuccess) { grid = -1; return; }
        if (hipFuncSetAttribute((const void*)hybrid_fwd, hipFuncAttributeMaxDynamicSharedMemorySize, LDS_BYTES) != hipSuccess) { fprintf(stderr, "kernel_launch: hipFuncSetAttribute failed\n"); grid = -1; return; }
        if (hipOccupancyMaxActiveBlocksPerMultiprocessor(&per_cu, (const void*)hybrid_fwd, 512, LDS_BYTES) != hipSuccess || per_cu < 1) fprintf(stderr, "kernel_launch: occupancy query reports %d\n", per_cu);
        (void)hipGetLastError();
        grid = cus;
    }
    if (grid < 0) return;
    if (hipMemsetAsync((char*)d_ws, 0, 65536, stream) != hipSuccess) { fprintf(stderr, "kernel_launch: memset failed\n"); return; }
    Args a{};
    for (int i = 0; i < 28; ++i) a.in[i] = (const float*)d_in[i];
    a.out = (float*)d_out; a.ws = (unsigned char*)d_ws;
#if MK_ONE_LAUNCH
    a.ph_lo = 0; a.ph_hi = (DBG_LAST < 1000) ? DBG_LAST + 1 : NPH;
    hipLaunchKernelGGL(hybrid_fwd, dim3(grid), dim3(512), LDS_BYTES, stream, a);
#else
    for (int p = 0; p < NPH; ++p) { a.ph_lo = p; a.ph_hi = p + 1; hipLaunchKernelGGL(hybrid_fwd, dim3(grid), dim3(512), LDS_BYTES, stream, a); }
#endif
    const hipError_t le = hipPeekAtLastError();
    if (le != hipSuccess) fprintf(stderr, "kernel_launch: launch failed: %s\n", hipGetErrorName(le));
}
```

```cpp
#include <hip/hip_runtime.h>
#include <cstdio>
#include <cstdint>

#ifndef MK_ONE_LAUNCH
#define MK_ONE_LAUNCH 1
#endif

#ifndef DBG_LAST
#define DBG_LAST 1000
#endif
#ifndef AMP_MASK
#define AMP_MASK 0ull
#endif
#define AMP_FACTOR 9ull
#define GAS __attribute__((address_space(1)))
#define LAS __attribute__((address_space(3)))
typedef unsigned short bf16;
typedef short bf16x8 __attribute__((ext_vector_type(8)));
typedef float f32x4 __attribute__((ext_vector_type(4)));
typedef float f32x2 __attribute__((ext_vector_type(2)));
typedef unsigned u32x4 __attribute__((ext_vector_type(4)));
typedef unsigned u32x2 __attribute__((ext_vector_type(2)));

constexpr int D = 1024, TP = 8192, MP = 2 * TP, NSMP = 128, MREAL = MP + NSMP, MT = MP + 256, NPAN = MT / 256;
constexpr int DFF = 2816;
constexpr float EPS = 1e-6f;
constexpr float LOG2E = 1.4426950408889634f;
__device__ __forceinline__ float lg2g(int h) { return h == 0 ? -0.04580368961312479f : h == 1 ? -0.02272007650008353f : h == 2 ? -0.011315313227834146f : -0.005646563141142063f; }

constexpr size_t O_Y = 0, O_YS = 16777216, O_RETP = O_YS + 131072, O_RETS = O_RETP + 1048576, O_SWKP = O_RETS + 67108864, O_SWVP = O_SWKP + 65536,
                 O_SWKS = O_SWVP + 65536, O_SWVS = O_SWKS + 4194304, O_CONVP = O_SWVS + 4194304, O_CONVS = O_CONVP + 4096, O_POOLP = O_CONVS + 262144,
                 O_POOLS = O_POOLP + 30720, O_MEMK = O_POOLS + 1966080, O_MEMV = O_MEMK + 2097152, O_END = O_MEMV + 2097152;

constexpr size_t al256(size_t x) { return (x + 255) & ~(size_t)255; }
constexpr size_t WS_CTL = 0;
constexpr size_t WS_PC = 32768;
constexpr size_t WS_PC2 = 36864;
constexpr size_t WS_SS = 1u << 20;
constexpr size_t WS_ST = WS_SS + al256((size_t)13 * MT * 8);
constexpr size_t ZERO_BYTES = al256(WS_ST + (size_t)MT * 8 * 8);
static_assert(ZERO_BYTES <= (4u << 20), "control region");
constexpr size_t WS_W = 4u << 20;
constexpr size_t W_RET_IN = WS_W, W_RET_OUT = W_RET_IN + (size_t)6144 * 1024 * 2, W_SWA_QKV = W_RET_OUT + (size_t)1024 * 2048 * 2,
                 W_SWA_O = W_SWA_QKV + (size_t)1536 * 1024 * 2, W_CONV_IN = W_SWA_O + (size_t)1024 * 1024 * 2, W_CONV_OUT = W_CONV_IN + (size_t)3072 * 1024 * 2,
                 W_POOL = W_CONV_OUT + (size_t)1024 * 1024 * 2, W_XQ = W_POOL + (size_t)4 * 256 * 256 * 2, W_XKV = W_XQ + (size_t)4 * 1024 * 1024 * 2,
                 W_XO = W_XKV + (size_t)4 * 2048 * 1024 * 2, W_FIN = W_XO + (size_t)4 * 1024 * 1024 * 2, W_FOUT = W_FIN + (size_t)4 * 5632 * 1024 * 2,
                 W_END = W_FOUT + (size_t)4 * 1024 * 2816 * 2;
constexpr size_t WS_TAB = al256(W_END);
constexpr size_t T_CR = WS_TAB, T_SR = T_CR + (size_t)8193 * 128 * 4, T_CRT = al256(T_SR + (size_t)8193 * 128 * 4), T_SRT = T_CRT + (size_t)128 * 8192 * 4,
                 T_CS = T_SRT + (size_t)128 * 8192 * 4, T_SN = al256(T_CS + (size_t)8193 * 8 * 4), T_END = al256(T_SN + (size_t)8193 * 8 * 4);
constexpr size_t WS_MEMN = T_END;
constexpr size_t WS_MK = WS_MEMN + (size_t)4 * 512 * 1024 * 2;
constexpr size_t WS_MVT = WS_MK + (size_t)4 * 512 * 1024 * 2;
constexpr size_t WS_XB = WS_MVT + (size_t)4 * 2 * 1024 * 1024 * 2;
constexpr size_t WS_Q = WS_XB + (size_t)MT * 1024 * 2;
constexpr size_t WS_KB = WS_Q + (size_t)MT * 1024 * 2;
constexpr size_t WS_G = WS_KB + (size_t)MT * 1024 * 2;
constexpr size_t WS_KT = WS_G + (size_t)MT * 2048 * 2;
constexpr size_t WS_VS = WS_KT + (size_t)256 * 256 * 512 * 2;
constexpr size_t WS_APQ = WS_VS + (size_t)256 * 512 * 512 * 2;
constexpr size_t WS_U = WS_APQ + (size_t)256 * 256 * 512 * 2;
constexpr size_t WS_O = WS_U + (size_t)256 * 512 * 256 * 4;
constexpr size_t WS_UB = WS_O + (size_t)MT * 2048 * 2;
constexpr size_t WS_PX = WS_UB + (size_t)MT * 2048 * 2;
constexpr size_t WS_OX = WS_PX + (size_t)MT * 1024 * 2;
constexpr size_t WS_HF = WS_OX + (size_t)MT * 1024 * 2;
constexpr size_t WS_SQ = WS_HF + (size_t)MT * 2816 * 2;
constexpr size_t W_XQN = WS_SQ + (size_t)128 * 4096 * 4;
constexpr size_t WS_WQK = W_XQN + (size_t)4 * 1024 * 1024 * 2;
constexpr size_t WS_VWO = WS_WQK + (size_t)8 * 1024 * 1024 * 2;
constexpr size_t WS_MV = WS_MVT;
constexpr size_t WS_END = WS_VWO + (size_t)8 * 1024 * 1024 * 2;

constexpr int RING_OFF = 0, RING_BYTES = 131072;
constexpr int EPIX_OFF = RING_BYTES;
constexpr int LDSCTL_OFF = EPIX_OFF + 16384, MISC_OFF = LDSCTL_OFF + 64;
constexpr int LDS_BYTES = LDSCTL_OFF + 256;

#define LDS_WAIT() asm volatile("s_waitcnt lgkmcnt(0)" ::: "memory")
#define VM_WAIT() asm volatile("s_waitcnt vmcnt(0)" ::: "memory")
__device__ __forceinline__ unsigned cvt_pk_bf16(float lo, float hi) { unsigned r; asm volatile("v_cvt_pk_bf16_f32 %0, %1, %2" : "=v"(r) : "v"(lo), "v"(hi)); return r; }
__device__ __forceinline__ u32x4 pack8(f32x4 a, f32x4 b) { u32x4 w; w.x = cvt_pk_bf16(a[0], a[1]); w.y = cvt_pk_bf16(a[2], a[3]); w.z = cvt_pk_bf16(b[0], b[1]); w.w = cvt_pk_bf16(b[2], b[3]); return w; }
__device__ __forceinline__ f32x4 ld4(const float* p) { return *(const f32x4*)p; }
__device__ __forceinline__ void st4(float* p, f32x4 v) { *(f32x4*)p = v; }
__device__ __forceinline__ float bf2f(unsigned short b) { return __builtin_bit_cast(float, (unsigned)b << 16); }
__device__ __forceinline__ float bflo(unsigned w) { return __builtin_bit_cast(float, w << 16); }
__device__ __forceinline__ float bfhi(unsigned w) { return __builtin_bit_cast(float, w & 0xffff0000u); }
__device__ __forceinline__ float siluf(float x) { return x * __builtin_amdgcn_rcpf(1.f + __builtin_amdgcn_exp2f(-x * LOG2E)); }
typedef unsigned long long u64;
__device__ __forceinline__ u64 to_fx(float v) { return (u64)(long long)((double)v * 65536.0); }
__device__ __forceinline__ float from_fx(u64 v) { return (float)((double)(long long)v * (1.0 / 65536.0)); }
__device__ __forceinline__ void fx_add(u64* p, float v) { __hip_atomic_fetch_add(p, to_fx(v), __ATOMIC_RELAXED, __HIP_MEMORY_SCOPE_AGENT); }
__device__ __forceinline__ float rstd_of(u64 ss) { return __builtin_amdgcn_rsqf(from_fx(ss) * (1.f / 1024.f) + EPS); }
__device__ __forceinline__ float wave_sum(float v) {
#pragma unroll
    for (int o = 1; o < 64; o <<= 1) v += __shfl_xor(v, o);
    return v;
}
__device__ __forceinline__ float wave_max(float v) {
#pragma unroll
    for (int o = 1; o < 64; o <<= 1) v = fmaxf(v, __shfl_xor(v, o));
    return v;
}

namespace pg8 {
typedef unsigned short bf16_t;
constexpr int BM = 256, BK = 64, HALF = 128, HTB = HALF * BK * 2, STAGE_BYTES = 8 * HTB;
__host__ __device__ __forceinline__ int lds_byte(int r, int c) { const int st = (r >> 4) * 2 + (c >> 5), rr = r & 15, cc = c & 31, ob = rr * 64 + cc * 2; return st * 1024 + (ob ^ (((ob >> 9) & 1) << 5)); }
__host__ __device__ __forceinline__ void stage_rc(int b, int& R, int& C) { const int st = b / 1024, sb = b % 1024, swz = sb ^ (((sb >> 9) & 1) << 5); R = (st >> 1) * 16 + swz / 64; C = (st & 1) * 32 + (swz % 64) / 2; }
__host__ __device__ __forceinline__ int perm32(int rho) { const int n = rho >> 4, i = rho & 15; return 8 * (i >> 2) + 4 * n + (i & 3); }

struct Unit { int pm, pn; unsigned ao, bo; };
struct Gemm { const bf16_t* A; const bf16_t* Bt; int lda, ldb, K; };

struct NoSide { __device__ __forceinline__ void operator()(int) const {} };
template <class Dec, class Side = NoSide> struct Sched {
    int nwg, G, c; Dec d; Side side;
    __device__ __forceinline__ bool next(int i, Unit& u) const { const long L = (long)i * G + c; if (L >= nwg) return false; d((int)L, u); return true; }
    __device__ __forceinline__ void a_ready(const Unit&) const {}
    __device__ __forceinline__ void done(const Unit&, int ui) const { side(ui); }
};
struct DecGrid {
    int nM, nN; unsigned a0, am, an, b0, bm, bn;
    __device__ __forceinline__ void operator()(int L, Unit& u) const {
        const int nwg = nM * nN; int wgid = L; { const int q = nwg / 8, r = nwg % 8, xcd = wgid % 8, off = wgid / 8; wgid = (xcd < r ? xcd * (q + 1) : r * (q + 1) + (xcd - r) * q) + off; }
        const int nig = 8 * nN, gid = wgid / nig, fm = gid * 8, gsz = (nM - fm) < 8 ? (nM - fm) : 8;
        u.pm = fm + ((wgid % nig) % gsz); u.pn = (wgid % nig) / gsz;
        u.ao = a0 + (unsigned)u.pm * am + (unsigned)u.pn * an; u.bo = b0 + (unsigned)u.pm * bm + (unsigned)u.pn * bn;
    }
};

typedef f32x4 Acc[2][2][4][2];

template <class Epi, class SchedT, bool ALIGN_EPI = true, bool SP2 = true>
__device__ __forceinline__ void gemm_phase(LAS unsigned char* lds, const Gemm g, const SchedT& S, const Epi& E, const int wid) {
    static_assert(SP2, "only the SP2 loop is kept");
    int lane; asm volatile("v_mbcnt_lo_u32_b32 %0, -1, 0\n\tv_mbcnt_hi_u32_b32 %0, -1, %0" : "=v"(lane));
    const int tid = wid * 64 + lane, wr = wid >> 2, wc = wid & 3, fr = lane & 15, fq = lane >> 4;
    const int K = g.K, nt = K / BK;
    unsigned voffA[2], voffB[2];
#pragma unroll
    for (int i = 0; i < 2; ++i) { int R, C; stage_rc(tid * 16 + i * 8192, R, C); const int Rb = Epi::PERM ? ((R & ~31) + perm32(R & 31)) : R;
        voffA[i] = (unsigned)(R * g.lda + C) * 2u; voffB[i] = (unsigned)(Rb * g.ldb + C) * 2u; }
    const size_t kstep = (size_t)(BK * 2);
    const size_t hstepA = (size_t)HALF * g.lda * 2, hstepB = (size_t)HALF * g.ldb * 2;
    const unsigned ldsw = (unsigned)wid * 1024u;
    const int aoff = lds_byte(wr * 64 + fr, fq * 8), boff = lds_byte(wc * 32 + fr, fq * 8);
#define PG8_SA(b, h) (((b) * 2 + (h)) * HTB)
#define PG8_SB(b, h) ((4 + (b) * 2 + (h)) * HTB)
#define PG8_STAGE(bufoff, gbase, voff) do { _Pragma("unroll") for (int _i = 0; _i < 2; ++_i) \
        __builtin_amdgcn_global_load_lds((const unsigned*)((const char*)(gbase) + (voff)[_i]), (LAS unsigned*)(lds + (bufoff) + ldsw + _i * 8192), 16, 0, 0); } while (0)
#define PG8_LDA(dst, b, h) do { _Pragma("unroll") for (int m = 0; m < 4; ++m) _Pragma("unroll") for (int k = 0; k < 2; ++k) dst[m][k] = *(const LAS bf16x8*)(lds + PG8_SA(b, h) + aoff + m * 2048 + k * 1024); } while (0)
#define PG8_LDB(dst, b, h) do { _Pragma("unroll") for (int n = 0; n < 2; ++n) _Pragma("unroll") for (int k = 0; k < 2; ++k) dst[n][k] = *(const LAS bf16x8*)(lds + PG8_SB(b, h) + boff + n * 2048 + k * 1024); } while (0)
#define PG8_MMA(ai, bj, At, Bt) do { __builtin_amdgcn_s_setprio(1); _Pragma("unroll") for (int m = 0; m < 4; ++m) _Pragma("unroll") for (int n = 0; n < 2; ++n) _Pragma("unroll") for (int k = 0; k < 2; ++k) \
        acc[ai][bj][m][n] = __builtin_amdgcn_mfma_f32_16x16x32_bf16(Bt[n][k], At[m][k], acc[ai][bj][m][n], 0, 0, 0); __builtin_amdgcn_s_setprio(0); } while (0)
#define PG8_WAIT_V(n) asm volatile("s_waitcnt vmcnt(" #n ")" ::: "memory")
#define PG8_WAIT_L(n) asm volatile("s_waitcnt lgkmcnt(" #n ")" ::: "memory")
#define PG8_BAR __builtin_amdgcn_s_barrier()
#define PG8_SCHED __builtin_amdgcn_sched_barrier(0)
    Unit cur, nxt; int ui = 0;
    if (!S.next(0, cur)) return;
    f32x4 acc[2][2][4][2];
#pragma unroll
    for (int a = 0; a < 2; ++a)
#pragma unroll
        for (int b = 0; b < 2; ++b)
#pragma unroll
            for (int m = 0; m < 4; ++m)
#pragma unroll
                for (int n = 0; n < 2; ++n) acc[a][b][m][n] = (f32x4){0.f, 0.f, 0.f, 0.f};
    bf16x8 At[4][2], B0[2][2], B1[2][2];
    const char* cA = (const char*)g.A + (size_t)cur.ao * 2; const char* cB = (const char*)g.Bt + (size_t)cur.bo * 2;
    S.a_ready(cur);
    PG8_STAGE(PG8_SB(0, 0), cB, voffB); PG8_STAGE(PG8_SB(0, 1), cB + hstepB, voffB); PG8_STAGE(PG8_SA(0, 0), cA, voffA); PG8_STAGE(PG8_SA(0, 1), cA + hstepA, voffA);
    if (wr == 1) PG8_BAR;
    PG8_WAIT_V(2); PG8_BAR;
    PG8_STAGE(PG8_SB(1, 0), cB + kstep, voffB); PG8_STAGE(PG8_SA(1, 0), cA + kstep, voffA); PG8_STAGE(PG8_SB(1, 1), cB + hstepB + kstep, voffB);
    PG8_WAIT_V(6); PG8_BAR;
    for (;;) {
        const bool has_next = S.next(ui + 1, nxt);
        const char* nA = has_next ? (const char*)g.A + (size_t)nxt.ao * 2 : cA; const char* nB = has_next ? (const char*)g.Bt + (size_t)nxt.bo * 2 : cB;
        for (int t = 0; t < nt; t += 2) {
            const bool last = (t == nt - 2);
            const char* a1 = cA + (size_t)(t + 1) * kstep;
            const char* a2 = last ? nA : cA + (size_t)(t + 2) * kstep; const char* b2 = last ? nB : cB + (size_t)(t + 2) * kstep;
            const char* a3 = a2 + kstep; const char* b3 = b2 + kstep;
            if (last && has_next) S.a_ready(nxt);
            PG8_LDB(B0, 0, 0); PG8_LDB(B1, 0, 1); PG8_SCHED; PG8_LDA(At, 0, 0); PG8_STAGE(PG8_SA(1, 1), a1 + hstepA, voffA);
            PG8_WAIT_V(8); PG8_WAIT_L(0); PG8_BAR; PG8_MMA(0, 0, At, B0); PG8_MMA(0, 1, At, B1); PG8_BAR; PG8_SCHED;
            PG8_LDA(At, 0, 1); PG8_STAGE(PG8_SB(0, 0), b2, voffB); PG8_STAGE(PG8_SB(0, 1), b2 + hstepB, voffB); PG8_STAGE(PG8_SA(0, 0), a2, voffA);
            PG8_WAIT_V(8); PG8_WAIT_L(0); PG8_BAR; PG8_MMA(1, 0, At, B0); PG8_MMA(1, 1, At, B1); PG8_BAR; PG8_SCHED;
            PG8_LDB(B0, 1, 0); PG8_LDB(B1, 1, 1); PG8_SCHED; PG8_LDA(At, 1, 0); PG8_STAGE(PG8_SA(0, 1), a2 + hstepA, voffA);
            PG8_WAIT_V(8); PG8_WAIT_L(0); PG8_BAR; PG8_MMA(0, 0, At, B0); PG8_MMA(0, 1, At, B1); PG8_BAR; PG8_SCHED;
            PG8_LDA(At, 1, 1); PG8_STAGE(PG8_SB(1, 0), b3, voffB); PG8_STAGE(PG8_SB(1, 1), b3 + hstepB, voffB); PG8_STAGE(PG8_SA(1, 0), a3, voffA);
            PG8_WAIT_V(8); PG8_WAIT_L(0); PG8_BAR; PG8_MMA(1, 0, At, B0); PG8_MMA(1, 1, At, B1); PG8_BAR; PG8_SCHED;
        }
        if constexpr (ALIGN_EPI) { if (wr == 0) PG8_BAR; }
        { int ln; asm volatile("v_mbcnt_lo_u32_b32 %0, -1, 0\n\tv_mbcnt_hi_u32_b32 %0, -1, %0" : "=v"(ln));
          E(acc, cur, wr, wc, ln & 15, ln >> 4); }
        S.done(cur, ui);
        if (!has_next) break;
#pragma unroll
        for (int a = 0; a < 2; ++a)
#pragma unroll
            for (int b = 0; b < 2; ++b)
#pragma unroll
                for (int m = 0; m < 4; ++m)
#pragma unroll
                    for (int n = 0; n < 2; ++n) acc[a][b][m][n] = (f32x4){0.f, 0.f, 0.f, 0.f};
        cur = nxt; cA = nA; cB = nB; ++ui;
        if constexpr (ALIGN_EPI) { if (wr == 1) PG8_BAR; }
    }
    PG8_WAIT_V(0);
    if constexpr (!ALIGN_EPI) { if (wr == 0) PG8_BAR; }
    PG8_BAR;
#undef PG8_SA
#undef PG8_SB
#undef PG8_STAGE
#undef PG8_LDA
#undef PG8_LDB
#undef PG8_MMA
#undef PG8_WAIT_V
#undef PG8_WAIT_L
#undef PG8_BAR
#undef PG8_SCHED
}
}
using pg8::Unit; using pg8::Gemm; using pg8::Acc; using pg8::DecGrid;

#define XB_TMO      128
#define XB_XCNT(j)  (256  + 64 * (j))
#define XB_XSUB(j)  (1280 + 64 * (j))
#define XB_XGEN(j)  (2304 + 64 * (j))
#define XB_TOP      3328
#define XB_TOPGEN   3392
#define XCD_BAR_WORDS 3456
#define XB_SPIN_CAP (1u << 18)
__device__ __forceinline__ unsigned xb_ld(unsigned* p)              { return __hip_atomic_load(p, __ATOMIC_RELAXED, __HIP_MEMORY_SCOPE_AGENT); }
__device__ __forceinline__ unsigned xb_add(unsigned* p, unsigned v) { return __hip_atomic_fetch_add(p, v, __ATOMIC_RELAXED, __HIP_MEMORY_SCOPE_AGENT); }
__device__ __forceinline__ unsigned xb_xcc_id() { return (unsigned)__builtin_amdgcn_s_getreg((3 << 11) | 20) & 0xFu; }
#define XB_SPIN(cond, bar) do { unsigned _sp = 0; while (cond) { __builtin_amdgcn_s_sleep(1); \
    if ((++_sp & 255u) == 0u) { if (xb_ld(&(bar)[XB_TMO])) break; if (_sp > XB_SPIN_CAP) { atomicAdd(&(bar)[XB_TMO], 1u); break; } } } } while (0)
struct XcdBarrier { unsigned* bar; unsigned x; volatile LAS unsigned* st; };
__device__ __forceinline__ XcdBarrier xcd_barrier_post(unsigned* bar, volatile LAS unsigned* st) {
    XcdBarrier b; b.bar = bar; b.x = xb_xcc_id(); b.st = st;
    if (threadIdx.x == 0) (void)xb_add(&bar[XB_XCNT(b.x)], 1u);
    return b;
}
__device__ __forceinline__ void xcd_barrier_complete(unsigned* bar, unsigned x, unsigned& nloc, unsigned& nx) {
    const unsigned G = gridDim.x * gridDim.y * gridDim.z;
    unsigned sum, cnt, mine, sp = 0u;
    for (;;) {
        sum = 0u; cnt = 0u; mine = 0u;
#pragma unroll
        for (unsigned j = 0; j < 16; ++j) { const unsigned c = xb_ld(&bar[XB_XCNT(j)]); sum += c; cnt += (c > 0u) ? 1u : 0u; mine = (j == x) ? c : mine; }
        if (sum == G) break;
        __builtin_amdgcn_s_sleep(1);
        if ((++sp & 255u) == 0u) { if (xb_ld(&bar[XB_TMO])) break; if (sp > XB_SPIN_CAP) { atomicAdd(&bar[XB_TMO], 1u); break; } }
    }
    nloc = mine > 0u ? mine : 1u; nx = cnt > 0u ? cnt : 1u;
}
__device__ __forceinline__ void xcd_barrier(const XcdBarrier& b) {
    asm volatile("s_waitcnt vmcnt(0)" ::: "memory");
    __syncthreads();
    if (threadIdx.x == 0) {
        unsigned* bar = b.bar;
        __builtin_amdgcn_s_waitcnt(0);
        unsigned nloc = b.st[0], nx = b.st[1];
        if (nloc == 0u) { xcd_barrier_complete(bar, b.x, nloc, nx); b.st[0] = nloc; b.st[1] = nx; }
        const unsigned old = xb_add(&bar[XB_XSUB(b.x)], 1u);
        const unsigned gen = old / nloc;
        if (old + 1u == (gen + 1u) * nloc) {
            __builtin_amdgcn_fence(__ATOMIC_RELEASE, "agent");
            asm volatile("s_waitcnt vmcnt(0)" ::: "memory");
            const unsigned og = xb_add(&bar[XB_TOP], 1u);
            const unsigned tg = og / nx;
            if (og + 1u == (tg + 1u) * nx) xb_add(&bar[XB_TOPGEN], 1u);
            else XB_SPIN(xb_ld(&bar[XB_TOPGEN]) == tg, bar);
            __builtin_amdgcn_fence(__ATOMIC_ACQUIRE, "agent");
            xb_add(&bar[XB_XGEN(b.x)], 1u);
            asm volatile("s_waitcnt vmcnt(0)" ::: "memory");
        } else {
            XB_SPIN(xb_ld(&bar[XB_XGEN(b.x)]) == gen, bar);
            __builtin_amdgcn_fence(__ATOMIC_ACQUIRE, "agent");
            asm volatile("s_waitcnt vmcnt(0)" ::: "memory");
        }
    }
    __syncthreads();
}

struct Args { const float* in[28]; float* out; unsigned char* ws; int ph_lo, ph_hi; };
enum { I_XP = 0, I_XS, I_SRET, I_CSK, I_CSV, I_SCONV, I_SPOOL, I_CMK, I_CMV, I_MEM, I_NG, I_MNG, I_FNG, I_RWIN, I_RWOUT, I_SWQKV, I_SWO, I_SINK, I_CWIN, I_CW, I_CWOUT, I_PW, I_PSC, I_XWQ, I_XWKV, I_XWO, I_FWIN, I_FWOUT };

template <int I> __device__ __forceinline__ const float* kin() { const float* p = nullptr;
#if defined(__HIP_DEVICE_COMPILE__)
    auto ka = __builtin_amdgcn_kernarg_segment_ptr();
    asm volatile("s_load_dwordx2 %0, %1, %2\n\ts_waitcnt lgkmcnt(0)" : "=s"(p) : "s"(ka), "n"(I * 8));
#endif
    return p; }
#define KIN(i) kin<(i)>()
struct Ctx { LAS unsigned char* lds; int wave, vcu, G; };
__device__ __forceinline__ int olane() { int t; asm volatile("v_mbcnt_lo_u32_b32 %0, -1, 0\n\tv_mbcnt_hi_u32_b32 %0, -1, %0" : "=v"(t)); return t; }
#define otid() (C.wave * 64 + olane())

__device__ __forceinline__ void conv_item(const float* W, int K, int N, int k0, int ns0, bf16* WT, int nd0, const float* gain, const float* cs, LAS float* scr, int lane) {
    const int q = lane & 15, kq = lane >> 4;
    const f32x4 csv = cs ? ld4(cs + ns0 + 4 * q) : (f32x4){1.f, 1.f, 1.f, 1.f};
    f32x4 v[16];
#pragma unroll
    for (int i = 0; i < 16; ++i) v[i] = ld4(W + (size_t)(k0 + 4 * i + kq) * N + ns0 + 4 * q);
#pragma unroll
    for (int i = 0; i < 16; ++i) { const int kk = 4 * i + kq; const f32x4 w = v[i] * csv * (gain ? gain[k0 + kk] : 1.f); LAS float* d = scr + kk * 65 + 4 * q; d[0] = w[0]; d[1] = w[1]; d[2] = w[2]; d[3] = w[3]; }
    LDS_WAIT(); asm volatile("" ::: "memory");
    const int c = lane & 7;
#pragma unroll
    for (int j = 0; j < 8; ++j) { const int n = (lane >> 3) + 8 * j; const LAS float* sp = scr + (8 * c) * 65 + n;
        u32x4 o; o.x = cvt_pk_bf16(sp[0 * 65], sp[1 * 65]); o.y = cvt_pk_bf16(sp[2 * 65], sp[3 * 65]); o.z = cvt_pk_bf16(sp[4 * 65], sp[5 * 65]); o.w = cvt_pk_bf16(sp[6 * 65], sp[7 * 65]);
        *(GAS u32x4*)(WT + (size_t)(nd0 + n) * K + k0 + 8 * c) = o; }
    LDS_WAIT(); asm volatile("" ::: "memory");
}
__device__ __forceinline__ int map_col(int mode, int nd) {
    if (mode == 0) return nd;
    if (mode == 1) return nd < 2048 ? nd : (nd < 4096 ? nd + 2048 : nd - 2048);
    if (mode == 2) { if (nd < 1024) return nd; const int t = nd - 1024; return 1024 + ((t >> 7) & 1) * 1024 + (t >> 8) * 128 + (t & 127); }
    return ((nd >> 7) & 1) * DFF + (nd >> 8) * 128 + (nd & 127);
}

__device__ __forceinline__ void p0_prologue(const Ctx& C, const Args& a) {
    unsigned char* ws = a.ws;
    LAS float* scr = (LAS float*)(C.lds + RING_OFF + C.wave * 16896);
    const int tid_ = otid(), lane_ = tid_ & 63;
    const int gw = C.vcu * 8 + C.wave, NGW = C.G * 8;
    int cum = 0;
#define JOB(Wp, K_, N_, Nd_, dstp, mode, gainp, csp) do { const int K__ = (K_), nblk = (Nd_) / 64, items = (K__ / 64) * nblk; \
        for (int it = (gw + NGW - (cum % NGW)) % NGW; it < items; it += NGW) { const int kb = it / nblk, nb = it % nblk; \
            conv_item((Wp), K__, (N_), 64 * kb, map_col((mode), 64 * nb), (bf16*)(dstp), 64 * nb, (gainp), (csp), scr, lane_); } cum += items; } while (0)
    const float* ng = KIN(I_NG);
    JOB(KIN(I_RWIN), 1024, 6144, 6144, ws + W_RET_IN, 1, ng + 0 * 1024, (const float*)nullptr);
    JOB(KIN(I_RWOUT), 2048, 1024, 1024, ws + W_RET_OUT, 0, (const float*)nullptr, (const float*)nullptr);
    JOB(KIN(I_SWQKV), 1024, 1536, 1536, ws + W_SWA_QKV, 0, ng + 3 * 1024, (const float*)nullptr);
    JOB(KIN(I_SWO), 1024, 1024, 1024, ws + W_SWA_O, 0, (const float*)nullptr, (const float*)nullptr);
    JOB(KIN(I_CWIN), 1024, 3072, 3072, ws + W_CONV_IN, 2, ng + 6 * 1024, (const float*)nullptr);
    JOB(KIN(I_CWOUT), 1024, 1024, 1024, ws + W_CONV_OUT, 0, (const float*)nullptr, (const float*)nullptr);
    for (int gi = 0; gi < 4; ++gi)
        JOB(KIN(I_PW) + (size_t)gi * 65536, 256, 256, 256, ws + W_POOL + (size_t)gi * 65536 * 2, 0, (const float*)nullptr, KIN(I_PSC) + gi * 256);
    for (int l = 0; l < 4; ++l) {
        JOB(KIN(I_XWQ) + (size_t)l * 1048576, 1024, 1024, 1024, ws + W_XQ + (size_t)l * 1048576 * 2, 0, ng + (3 * l + 1) * 1024, (const float*)nullptr);
        JOB(KIN(I_XWKV) + (size_t)l * 2097152, 1024, 2048, 2048, ws + W_XKV + (size_t)l * 2097152 * 2, 0, (const float*)nullptr, (const float*)nullptr);
        JOB(KIN(I_XWO) + (size_t)l * 1048576, 1024, 1024, 1024, ws + W_XO + (size_t)l * 1048576 * 2, 0, (const float*)nullptr, (const float*)nullptr);
        JOB(KIN(I_FWIN) + (size_t)l * 1024 * 5632, 1024, 5632, 5632, ws + W_FIN + (size_t)l * 1024 * 5632 * 2, 3, ng + (3 * l + 2) * 1024, (const float*)nullptr);
        JOB(KIN(I_FWOUT) + (size_t)l * 2816 * 1024, 2816, 1024, 1024, ws + W_FOUT + (size_t)l * 2816 * 1024 * 2, 0, (const float*)nullptr, (const float*)nullptr);
    }
#undef JOB
    {   bf16* WN = (bf16*)(ws + W_XQN);
        for (int row = gw; row < 4096; row += NGW) { const float gsc = ng[(3 * (row >> 10) + 1) * 1024 + (row & 1023)];
            const GAS f32x4* xp = (const GAS f32x4*)(KIN(I_XWQ) + (size_t)row * 1024) + lane_; GAS unsigned long long* o8 = (GAS unsigned long long*)(WN + (size_t)row * 1024) + lane_;
#pragma unroll
            for (int j = 0; j < 4; ++j) { const f32x4 v = xp[64 * j] * gsc; o8[64 * j] = (unsigned long long)cvt_pk_bf16(v.x, v.y) | ((unsigned long long)cvt_pk_bf16(v.z, v.w) << 32); } } }
    bf16* XB = (bf16*)(ws + WS_XB); u64* SS = (u64*)(ws + WS_SS);
    for (int row = gw; row < MT; row += NGW) {
        GAS unsigned long long* o8 = (GAS unsigned long long*)(XB + (size_t)row * D) + lane_;
        if (row < MREAL) {
            const float* xr = row < MP ? KIN(I_XP) + (size_t)row * D : KIN(I_XS) + (size_t)(row - MP) * D;
            const GAS f32x4* xp = (const GAS f32x4*)xr + lane_; float s = 0.f;
#pragma unroll
            for (int j = 0; j < 4; ++j) { const f32x4 v = xp[64 * j]; s += (v.x * v.x + v.y * v.y) + (v.z * v.z + v.w * v.w);
                o8[64 * j] = (unsigned long long)cvt_pk_bf16(v.x, v.y) | ((unsigned long long)cvt_pk_bf16(v.z, v.w) << 32); }
            s = wave_sum(s); if (lane_ == 0) SS[row] = to_fx(s);
        } else {
#pragma unroll
            for (int j = 0; j < 4; ++j) o8[64 * j] = 0ull;
        }
    }
    bf16* MN = (bf16*)(ws + WS_MEMN);
    for (int row = gw; row < 512; row += NGW) {
        const GAS f32x4* xp = (const GAS f32x4*)(KIN(I_MEM) + (size_t)row * D) + lane_; f32x4 v[4]; float s = 0.f;
#pragma unroll
        for (int j = 0; j < 4; ++j) { v[j] = xp[64 * j]; s += (v[j].x * v[j].x + v[j].y * v[j].y) + (v[j].z * v[j].z + v[j].w * v[j].w); }
        const float r = __builtin_amdgcn_rsqf(wave_sum(s) * (1.f / 1024.f) + EPS);
        for (int l = 0; l < 4; ++l) { const GAS f32x4* gp = (const GAS f32x4*)(KIN(I_MNG) + l * D) + lane_;
            GAS unsigned long long* o8 = (GAS unsigned long long*)(MN + ((size_t)l * 512 + row) * D) + lane_;
#pragma unroll
            for (int j = 0; j < 4; ++j) { const f32x4 gg = gp[64 * j]; o8[64 * j] = (unsigned long long)cvt_pk_bf16(v[j].x * r * gg.x, v[j].y * r * gg.y) | ((unsigned long long)cvt_pk_bf16(v[j].z * r * gg.z, v[j].w * r * gg.w) << 32); } }
    }
    {
        const int gt = C.vcu * 512 + tid_, NGT = C.G * 512;
        float* CR = (float*)(ws + T_CR); float* SR = (float*)(ws + T_SR); float* CRT = (float*)(ws + T_CRT); float* SRT = (float*)(ws + T_SRT);
        for (int e = gt; e < 8193 * 128; e += NGT) { const int pos = e >> 7, i = e & 127;
            const double rev = (double)pos * (exp(-9.210340371976184 * (double)i / 128.0) * 0.15915494309189535);
            const float fr = (float)(rev - rint(rev)); const float c = __builtin_amdgcn_cosf(fr), s = __builtin_amdgcn_sinf(fr);
            CR[e] = c; SR[e] = s; if (pos < 8192) { CRT[(size_t)i * 8192 + pos] = c; SRT[(size_t)i * 8192 + pos] = s; } }
        float* CS = (float*)(ws + T_CS); float* SN = (float*)(ws + T_SN);
        for (int e = gt; e < 8193 * 8; e += NGT) { const int pos = e >> 3, i = e & 7;
            const double rev = (double)pos * (exp(-13.122363377404328 * (double)i / 8.0) * 0.15915494309189535); const float fr = (float)(rev - rint(rev)); CS[e] = __builtin_amdgcn_cosf(fr); SN[e] = __builtin_amdgcn_sinf(fr); }
    }
    {
        const int gt = C.vcu * 512 + tid_, NGT = C.G * 512;
        GAS u32x4* zz = (GAS u32x4*)(ws + WS_SS + (size_t)MT * 8); for (int e = gt; e < (int)((ZERO_BYTES - WS_SS - (size_t)MT * 8) / 16); e += NGT) zz[e] = (u32x4){0u, 0u, 0u, 0u};
        GAS u32x4* ub = (GAS u32x4*)(ws + WS_UB + (size_t)MREAL * 2048 * 2); for (int e = gt; e < 128 * 2048 * 2 / 16; e += NGT) ub[e] = (u32x4){0u, 0u, 0u, 0u};
        GAS u32x4* ox = (GAS u32x4*)(ws + WS_OX + (size_t)MREAL * 1024 * 2); for (int e = gt; e < 128 * 1024 * 2 / 16; e += NGT) ox[e] = (u32x4){0u, 0u, 0u, 0u};
    }
}

#define EPI_HDR static constexpr bool PERM = true, AFTER_DRAIN = false;
#define EPI_ARGS Acc& acc, const Unit& u, int wr, int wc, int fr, int fq
#define FOR_AI_M _Pragma("unroll") for (int ai = 0; ai < 2; ++ai) _Pragma("unroll") for (int m = 0; m < 4; ++m)
#define FOR_BJ _Pragma("unroll") for (int bj = 0; bj < 2; ++bj)
#define FOR_N _Pragma("unroll") for (int n = 0; n < 2; ++n)
#define TROW (ai * 128 + wr * 64 + m * 16 + fr)
#define LOAD_RSTD8(rr, ssp, rowbase) float rr[2][4]; { u64 t_[2][4]; FOR_AI_M t_[ai][m] = (ssp)[(rowbase) + TROW]; FOR_AI_M rr[ai][m] = rstd_of(t_[ai][m]); }
__device__ __forceinline__ f32x4 silu4(f32x4 v) { return (f32x4){siluf(v[0]), siluf(v[1]), siluf(v[2]), siluf(v[3])}; }
__device__ __forceinline__ void st8b(bf16* p, f32x4 a, f32x4 b) { *(u32x4*)p = pack8(a, b); }

struct EpiMemKV { EPI_HDR
    float* out; bf16* MK; bf16* MV;
    __device__ __forceinline__ void operator()(EPI_ARGS) const {
        const int c0 = wc * 32 + fq * 8; const bool isk = u.pn < 4; float* ob = out + (isk ? O_MEMK : O_MEMV);
        FOR_AI_M { const size_t row = (size_t)u.pm * 256 + TROW;
            FOR_BJ { const size_t o = row * 1024 + (u.pn & 3) * 256 + bj * 128 + c0;
                st4(ob + o, acc[ai][bj][m][0]); st4(ob + o + 4, acc[ai][bj][m][1]);
                st8b((isk ? MK : MV) + o, acc[ai][bj][m][0], acc[ai][bj][m][1]); } }
    }
};
struct EpiMemVT { EPI_HDR
    bf16* MVT;
    __device__ __forceinline__ void operator()(EPI_ARGS) const {
        const int c0 = wc * 32 + fq * 8; const int layer = u.pm >> 2, head = u.pm & 3;
        FOR_AI_M { const size_t row = ((size_t)(layer * 2 + u.pn) * 1024 + head * 256 + TROW);
            FOR_BJ st8b(MVT + row * 1024 + bj * 128 + c0, acc[ai][bj][m][0], acc[ai][bj][m][1]); }
    }
};
struct EpiRetIn { EPI_HDR
    const u64* ss; const float* CR; const float* SR; bf16* Q; bf16* KB; bf16* APQ; bf16* Gt; float* SQ;
    __device__ __forceinline__ void operator()(EPI_ARGS) const {
        const int c0 = wc * 32 + fq * 8, pn = u.pn;
        LOAD_RSTD8(rr, ss, u.pm * 256)
        FOR_AI_M { const int row = u.pm * 256 + TROW; const float r = rr[ai][m];
            if (pn < 8) {
                const bool samp = row >= MP; const int pos = samp ? 8192 : (row & 8191); const int h = pn & 3;
                f32x4 o1[2], o2[2];
                FOR_N { const f32x4 c = ld4(CR + (size_t)pos * 128 + c0 + 4 * n), s = ld4(SR + (size_t)pos * 128 + c0 + 4 * n);
                    const f32x4 x1 = acc[ai][0][m][n] * r, x2 = acc[ai][1][m][n] * r; o1[n] = x1 * c - x2 * s; o2[n] = x2 * c + x1 * s; }
                if (pn < 4) {
                    bf16* qd = Q + (size_t)row * 1024 + h * 256 + c0; st8b(qd, o1[0], o1[1]); st8b(qd + 128, o2[0], o2[1]);
                    if (!samp) { const int l = row & 255; const float dec = __builtin_amdgcn_exp2f((float)(l + 1) * lg2g(h));
                        const int bhc = ((row >> 13) * 4 + h) * 32 + ((row & 8191) >> 8);
                        bf16* ad = APQ + ((size_t)bhc * 256 + l) * 512 + 256 + c0; st8b(ad, o1[0] * dec, o1[1] * dec); st8b(ad + 128, o2[0] * dec, o2[1] * dec); }
                    else if (row < MREAL) { float* d = SQ + (size_t)(row - MP) * 4096 + h * 256 + c0; st4(d, o1[0]); st4(d + 4, o1[1]); st4(d + 128, o2[0]); st4(d + 132, o2[1]); }
                } else {
                    FOR_N { o1[n] = o1[n] * 0.0625f; o2[n] = o2[n] * 0.0625f; }
                    if (!samp) { bf16* kd = KB + (size_t)row * 1024 + h * 256 + c0; st8b(kd, o1[0], o1[1]); st8b(kd + 128, o2[0], o2[1]); }
                    else if (row < MREAL) { float* d = SQ + (size_t)(row - MP) * 4096 + 1024 + h * 256 + c0; st4(d, o1[0]); st4(d + 4, o1[1]); st4(d + 128, o2[0]); st4(d + 132, o2[1]); }
                }
            } else {
                FOR_BJ st8b(Gt + (size_t)row * 2048 + (pn - 8) * 256 + bj * 128 + c0, silu4(acc[ai][bj][m][0] * r), silu4(acc[ai][bj][m][1] * r));
            }
        }
    }
    __device__ __forceinline__ void quad(int rs, int pn, int tc, f32x4 v0, f32x4 v1, int g) const {
        const float r = rstd_of(ss[MP + rs]); v0 = v0 * r; v1 = v1 * r;
        if (pn < 8) { const f32x4 c = ld4(CR + (size_t)8192 * 128 + tc), s = ld4(SR + (size_t)8192 * 128 + tc); f32x4 o1 = v0 * c - v1 * s, o2 = v1 * c + v0 * s;
            if (pn >= 4) { o1 = o1 * 0.0625f; o2 = o2 * 0.0625f; }
            float* d = SQ + (size_t)rs * 4096 + (pn >= 4 ? 1024 : 0) + (pn & 3) * 256 + tc; st4(d, o1); st4(d + 128, o2); }
        else if (pn < 16) { bf16* d = Gt + (size_t)(MP + rs) * 2048 + (pn - 8) * 256 + tc; const f32x4 a = silu4(v0), b = silu4(v1);
            *(u32x2*)d = (u32x2){cvt_pk_bf16(a[0], a[1]), cvt_pk_bf16(a[2], a[3])}; *(u32x2*)(d + 128) = (u32x2){cvt_pk_bf16(b[0], b[1]), cvt_pk_bf16(b[2], b[3])}; }
        else { float* d = SQ + (size_t)rs * 4096 + 2048 + (pn - 16) * 256 + tc; st4(d, v0); st4(d + 128, v1); }
    }
};
struct EpiRetVs { EPI_HDR
    const u64* ss; float* SQ;
    __device__ __forceinline__ void operator()(EPI_ARGS) const {
        const int c0 = wc * 32 + fq * 8;
#pragma unroll
        for (int m = 0; m < 4; ++m) { const int rl = wr * 64 + m * 16 + fr; const float r = rstd_of(ss[MP + rl]);
            FOR_BJ { float* d = SQ + (size_t)rl * 4096 + 2048 + u.pn * 256 + bj * 128 + c0; st4(d, acc[0][bj][m][0] * r); st4(d + 4, acc[0][bj][m][1] * r); } }
    }
};
struct EpiRetKT { EPI_HDR
    const u64* ss; const float* CRT; const float* SRT; bf16* KT;
    __device__ __forceinline__ void operator()(EPI_ARGS) const {
        const int c0 = wc * 32 + fq * 8, h = u.pm; const float lg = lg2g(h);
        f32x4 sc[2][2];
        FOR_BJ FOR_N { const int tok0 = u.pn * 256 + bj * 128 + c0 + 4 * n;
#pragma unroll
            for (int e = 0; e < 4; ++e) sc[bj][n][e] = rstd_of(ss[tok0 + e]) * 0.0625f * __builtin_amdgcn_exp2f((float)(255 - ((tok0 + e) & 255)) * lg); }
        const int b = u.pn >> 5;
#pragma unroll
        for (int m = 0; m < 4; ++m) { const int i = wr * 64 + m * 16 + fr;
            f32x4 tc[2][2], ts[2][2];
            FOR_BJ FOR_N { const int t0 = ((u.pn & 31) * 256) + bj * 128 + c0; tc[bj][n] = ld4(CRT + (size_t)i * 8192 + t0 + 4 * n); ts[bj][n] = ld4(SRT + (size_t)i * 8192 + t0 + 4 * n); }
            FOR_BJ { f32x4 o1[2], o2[2];
                FOR_N { const f32x4 c = tc[bj][n], s = ts[bj][n];
                    const f32x4 x1 = acc[0][bj][m][n], x2 = acc[1][bj][m][n]; o1[n] = (x1 * c - x2 * s) * sc[bj][n]; o2[n] = (x2 * c + x1 * s) * sc[bj][n]; }
                bf16* d = KT + ((size_t)(((b * 4 + h) * 32 + (u.pn & 31)) * 256 + i)) * 512 + bj * 128 + c0; st8b(d, o1[0], o1[1]); st8b(d + (size_t)128 * 512, o2[0], o2[1]); } }
    }
};
struct EpiRetVT { EPI_HDR
    const u64* ss; bf16* VS;
    __device__ __forceinline__ void operator()(EPI_ARGS) const {
        const int c0 = wc * 32 + fq * 8, h = u.pm >> 1, vh = u.pm & 1; const int bhc = ((u.pn >> 5) * 4 + h) * 32 + (u.pn & 31);
        f32x4 sc[2][2];
        FOR_BJ FOR_N { const u64* sp = ss + u.pn * 256 + bj * 128 + c0 + 4 * n;
#pragma unroll
            for (int e = 0; e < 4; ++e) sc[bj][n][e] = rstd_of(sp[e]); }
        FOR_AI_M { bf16* d = VS + ((size_t)bhc * 512 + vh * 256 + TROW) * 512 + c0;
            FOR_BJ st8b(d + bj * 128, acc[ai][bj][m][0] * sc[bj][0], acc[ai][bj][m][1] * sc[bj][1]); }
    }
};
struct EpiP { EPI_HDR
    bf16* APQ;
    __device__ __forceinline__ void operator()(EPI_ARGS) const {
        const int c0 = wc * 32 + fq * 8, h = u.pn; const float lg = lg2g(h); const int bhc = ((u.pm >> 5) * 4 + h) * 32 + (u.pm & 31);
        FOR_AI_M { const int l = TROW; bf16* d = APQ + ((size_t)bhc * 256 + l) * 512 + c0;
            FOR_BJ { f32x4 o[2];
                FOR_N {
#pragma unroll
                    for (int e = 0; e < 4; ++e) { const int df = l - (bj * 128 + c0 + 4 * n + e); o[n][e] = df >= 0 ? acc[ai][bj][m][n][e] * __builtin_amdgcn_exp2f((float)df * lg) : 0.f; } }
                st8b(d + bj * 128, o[0], o[1]); } }
    }
};
struct EpiU { static constexpr bool PERM = false, AFTER_DRAIN = false;
    bf16* U;
    __device__ __forceinline__ void operator()(EPI_ARGS) const {
        FOR_AI_M { bf16* d = U + ((size_t)u.pm * 256 + TROW) * 256 + wc * 32 + fq * 4;
            FOR_BJ FOR_N { const f32x4 v = acc[ai][bj][m][n]; *(u32x2*)(d + bj * 128 + n * 16) = (u32x2){cvt_pk_bf16(v[0], v[1]), cvt_pk_bf16(v[2], v[3])}; } }
    }
};
struct EpiO { EPI_HDR
    bf16* O; u64* ST;
    __device__ __forceinline__ void operator()(EPI_ARGS) const {
        const int c0 = wc * 32 + fq * 8; const int bhc = u.pm >> 1, vh = u.pm & 1, h = (bhc >> 5) & 3;
        const int row0 = (bhc >> 7) * 8192 + (bhc & 31) * 256;
        FOR_AI_M { const int row = row0 + TROW; float s1 = 0.f, s2 = 0.f;
            FOR_BJ { const f32x4 a = acc[ai][bj][m][0], b = acc[ai][bj][m][1];
                st8b(O + (size_t)row * 2048 + h * 512 + vh * 256 + bj * 128 + c0, a, b);
                s1 += (a[0] + a[1]) + (a[2] + a[3]) + (b[0] + b[1]) + (b[2] + b[3]);
                s2 += (a[0] * a[0] + a[1] * a[1]) + (a[2] * a[2] + a[3] * a[3]) + (b[0] * b[0] + b[1] * b[1]) + (b[2] * b[2] + b[3] * b[3]); }
            s1 += __shfl_xor(s1, 16); s1 += __shfl_xor(s1, 32); s2 += __shfl_xor(s2, 16); s2 += __shfl_xor(s2, 32);
            if (fq == 0) { fx_add(ST + (size_t)row * 8 + h * 2, s1); fx_add(ST + (size_t)row * 8 + h * 2 + 1, s2); } }
    }
};
struct EpiONorm { EPI_HDR
    const bf16* Gt; bf16* UB; u64* ST; unsigned* pc; unsigned* bar;
    __device__ __forceinline__ void operator()(EPI_ARGS) const {
        const int c0 = wc * 32 + fq * 8; const int bhc = u.pm >> 1, vh = u.pm & 1, h = (bhc >> 5) & 3;
        const int row0 = (bhc >> 7) * 8192 + (bhc & 31) * 256;
        FOR_AI_M { const int row = row0 + TROW; float s1 = 0.f, s2 = 0.f;
            FOR_BJ { const f32x4 a = acc[ai][bj][m][0], b = acc[ai][bj][m][1];
                s1 += (a[0] + a[1]) + (a[2] + a[3]) + (b[0] + b[1]) + (b[2] + b[3]);
                s2 += (a[0] * a[0] + a[1] * a[1]) + (a[2] * a[2] + a[3] * a[3]) + (b[0] * b[0] + b[1] * b[1]) + (b[2] * b[2] + b[3] * b[3]); }
            s1 += __shfl_xor(s1, 16); s1 += __shfl_xor(s1, 32); s2 += __shfl_xor(s2, 16); s2 += __shfl_xor(s2, 32);
            if (fq == 0) { fx_add(ST + (size_t)row * 8 + h * 2, s1); fx_add(ST + (size_t)row * 8 + h * 2 + 1, s2); } }
        u32x4 gv[4][2];
#pragma unroll
        for (int m = 0; m < 4; ++m)
#pragma unroll
            for (int bj = 0; bj < 2; ++bj) gv[m][bj] = *(const u32x4*)(Gt + (size_t)(row0 + wr * 64 + m * 16 + fr) * 2048 + h * 512 + vh * 256 + bj * 128 + c0);
        asm volatile("s_waitcnt vmcnt(0)" ::: "memory"); __builtin_amdgcn_s_barrier(); asm volatile("" ::: "memory");
        if (wr == 0 && wc == 0 && fr == 0 && fq == 0) { (void)xb_add(pc + bhc, 1u); XB_SPIN(xb_ld(pc + bhc) < 2u, bar); }
        __builtin_amdgcn_s_barrier(); asm volatile("" ::: "memory");
        float mu[2][4], rs[2][4];
        { u64 t1[2][4], t2[2][4];
#pragma unroll
          for (int ai = 0; ai < 2; ++ai)
#pragma unroll
            for (int m = 0; m < 4; ++m) { const int row = row0 + TROW; t1[ai][m] = __hip_atomic_load(ST + (size_t)row * 8 + h * 2, __ATOMIC_RELAXED, __HIP_MEMORY_SCOPE_AGENT); t2[ai][m] = __hip_atomic_load(ST + (size_t)row * 8 + h * 2 + 1, __ATOMIC_RELAXED, __HIP_MEMORY_SCOPE_AGENT); }
#pragma unroll
          for (int ai = 0; ai < 2; ++ai)
#pragma unroll
            for (int m = 0; m < 4; ++m) { mu[ai][m] = from_fx(t1[ai][m]) * (1.f / 512.f); rs[ai][m] = __builtin_amdgcn_rsqf(fmaxf(from_fx(t2[ai][m]) * (1.f / 512.f) - mu[ai][m] * mu[ai][m], 0.f) + EPS); } }
#pragma unroll
        for (int ai = 0; ai < 2; ++ai) {
            if (ai == 1) {
#pragma unroll
                for (int m = 0; m < 4; ++m)
#pragma unroll
                    for (int bj = 0; bj < 2; ++bj) gv[m][bj] = *(const u32x4*)(Gt + (size_t)(row0 + 128 + wr * 64 + m * 16 + fr) * 2048 + h * 512 + vh * 256 + bj * 128 + c0);
            }
#pragma unroll
            for (int m = 0; m < 4; ++m) { const int row = row0 + TROW;
#pragma unroll
                for (int bj = 0; bj < 2; ++bj) { const size_t o = (size_t)row * 2048 + h * 512 + vh * 256 + bj * 128 + c0; const u32x4 g4 = gv[m][bj];
                    const f32x4 a = (acc[ai][bj][m][0] - mu[ai][m]) * rs[ai][m] * (f32x4){bflo(g4.x), bfhi(g4.x), bflo(g4.y), bfhi(g4.y)}, b = (acc[ai][bj][m][1] - mu[ai][m]) * rs[ai][m] * (f32x4){bflo(g4.z), bfhi(g4.z), bflo(g4.w), bfhi(g4.w)};
                    st8b(UB + o, a, b); } } }
    }
};
struct EpiResidual { EPI_HDR
    const float* xin_p; const float* xin_s; bf16* XB; u64* ssn;
    __device__ __forceinline__ void operator()(EPI_ARGS) const {
        const int c0 = wc * 32 + fq * 8;
        if (xin_p) {
        FOR_AI_M { const int row = u.pm * 256 + TROW; float sq = 0.f;
            FOR_BJ { const int col = u.pn * 256 + bj * 128 + c0; f32x4 a, b;
                { const float* xo = xin_p + (size_t)row * 1024 + col; a = ld4(xo); b = ld4(xo + 4); }
                a += acc[ai][bj][m][0]; b += acc[ai][bj][m][1];
                st8b(XB + (size_t)row * 1024 + col, a, b);
                sq += (a[0] * a[0] + a[1] * a[1]) + (a[2] * a[2] + a[3] * a[3]) + (b[0] * b[0] + b[1] * b[1]) + (b[2] * b[2] + b[3] * b[3]); }
            sq += __shfl_xor(sq, 16); sq += __shfl_xor(sq, 32);
            if (fq == 0) fx_add(ssn + row, sq); }
        } else {
#pragma unroll
        for (int ai = 0; ai < 2; ++ai) { u32x4 ov[4][2];
#pragma unroll
            for (int m = 0; m < 4; ++m) FOR_BJ ov[m][bj] = *(const u32x4*)(XB + (size_t)(u.pm * 256 + TROW) * 1024 + u.pn * 256 + bj * 128 + c0);
#pragma unroll
            for (int m = 0; m < 4; ++m) { const int row = u.pm * 256 + TROW; float sq = 0.f;
                FOR_BJ { const int col = u.pn * 256 + bj * 128 + c0; const u32x4 o = ov[m][bj];
                    const f32x4 a = (f32x4){bflo(o.x), bfhi(o.x), bflo(o.y), bfhi(o.y)} + acc[ai][bj][m][0], b = (f32x4){bflo(o.z), bfhi(o.z), bflo(o.w), bfhi(o.w)} + acc[ai][bj][m][1];
                    st8b(XB + (size_t)row * 1024 + col, a, b);
                    sq += (a[0] * a[0] + a[1] * a[1]) + (a[2] * a[2] + a[3] * a[3]) + (b[0] * b[0] + b[1] * b[1]) + (b[2] * b[2] + b[3] * b[3]); }
                sq += __shfl_xor(sq, 16); sq += __shfl_xor(sq, 32);
                if (fq == 0) fx_add(ssn + row, sq); } }
        }
    }
    __device__ __forceinline__ void quad(int rs, int pn, int tc, f32x4 v0, f32x4 v1, int g) const {
        const int row = MP + rs, col = pn * 256 + tc; bf16* bd = XB + (size_t)row * 1024 + col; f32x4 a, b;
        if (xin_s) { const float* xo = xin_s + (size_t)rs * 1024 + col; a = ld4(xo); b = ld4(xo + 128); }
        else { const u32x2 o0 = *(const u32x2*)bd, o1 = *(const u32x2*)(bd + 128); a = (f32x4){bflo(o0.x), bfhi(o0.x), bflo(o0.y), bfhi(o0.y)}; b = (f32x4){bflo(o1.x), bfhi(o1.x), bflo(o1.y), bfhi(o1.y)}; }
        a += v0; b += v1;
        *(u32x2*)bd = (u32x2){cvt_pk_bf16(a[0], a[1]), cvt_pk_bf16(a[2], a[3])}; *(u32x2*)(bd + 128) = (u32x2){cvt_pk_bf16(b[0], b[1]), cvt_pk_bf16(b[2], b[3])};
        float sq = (a[0] * a[0] + a[1] * a[1]) + (a[2] * a[2] + a[3] * a[3]) + (b[0] * b[0] + b[1] * b[1]) + (b[2] * b[2] + b[3] * b[3]);
        sq += __shfl_xor(sq, 16); sq += __shfl_xor(sq, 32);
        if (g == 0) fx_add(ssn + row, sq);
    }
};
struct EpiResFinal { EPI_HDR
    const bf16* XB; u64* ssn; const float* fg; float* y; unsigned* pc; unsigned* bar;
    __device__ __forceinline__ void operator()(EPI_ARGS) const {
        const int c0 = wc * 32 + fq * 8;
        FOR_AI_M { const int row = u.pm * 256 + TROW; float sq = 0.f;
            FOR_BJ { const int col = u.pn * 256 + bj * 128 + c0;
                const u32x4 o = *(const u32x4*)(XB + (size_t)row * 1024 + col);
                const f32x4 a = (f32x4){bflo(o.x), bfhi(o.x), bflo(o.y), bfhi(o.y)} + acc[ai][bj][m][0], b = (f32x4){bflo(o.z), bfhi(o.z), bflo(o.w), bfhi(o.w)} + acc[ai][bj][m][1];
                acc[ai][bj][m][0] = a; acc[ai][bj][m][1] = b;
                sq += (a[0] * a[0] + a[1] * a[1]) + (a[2] * a[2] + a[3] * a[3]) + (b[0] * b[0] + b[1] * b[1]) + (b[2] * b[2] + b[3] * b[3]); }
            sq += __shfl_xor(sq, 16); sq += __shfl_xor(sq, 32);
            if (fq == 0) fx_add(ssn + row, sq); }
        asm volatile("s_waitcnt vmcnt(0)" ::: "memory"); __builtin_amdgcn_s_barrier(); asm volatile("" ::: "memory");
        if (wr == 0 && wc == 0 && fr == 0 && fq == 0) { (void)xb_add(pc + u.pm, 1u); XB_SPIN(xb_ld(pc + u.pm) < 4u, bar); }
        __builtin_amdgcn_s_barrier(); asm volatile("" ::: "memory");
        u64 t[2][4]; f32x4 gg[2][2];
        FOR_AI_M t[ai][m] = __hip_atomic_load(ssn + u.pm * 256 + TROW, __ATOMIC_RELAXED, __HIP_MEMORY_SCOPE_AGENT);
        FOR_BJ { const int col = u.pn * 256 + bj * 128 + c0; gg[bj][0] = ld4(fg + col); gg[bj][1] = ld4(fg + col + 4); }
        FOR_AI_M { const int row = u.pm * 256 + TROW; const float r = rstd_of(t[ai][m]);
            FOR_BJ { float* yo = y + (size_t)row * 1024 + u.pn * 256 + bj * 128 + c0;
                st4(yo, acc[ai][bj][m][0] * r * gg[bj][0]); st4(yo + 4, acc[ai][bj][m][1] * r * gg[bj][1]); } }
    }
};
struct EpiScale { EPI_HDR
    const u64* ss; float scale; bf16* out; int ld;
    __device__ __forceinline__ void operator()(EPI_ARGS) const {
        const int c0 = wc * 32 + fq * 8;
        FOR_AI_M { const int row = u.pm * 256 + TROW; const float r = rstd_of(ss[row]) * scale;
            FOR_BJ st8b(out + (size_t)row * ld + u.pn * 256 + bj * 128 + c0, acc[ai][bj][m][0] * r, acc[ai][bj][m][1] * r); }
    }
    __device__ __forceinline__ void quad(int rs, int pn, int tc, f32x4 v0, f32x4 v1, int g) const {
        const float r = rstd_of(ss[MP + rs]) * scale; v0 = v0 * r; v1 = v1 * r; bf16* d = out + (size_t)(MP + rs) * ld + pn * 256 + tc;
        *(u32x2*)d = (u32x2){cvt_pk_bf16(v0[0], v0[1]), cvt_pk_bf16(v0[2], v0[3])}; *(u32x2*)(d + 128) = (u32x2){cvt_pk_bf16(v1[0], v1[1]), cvt_pk_bf16(v1[2], v1[3])};
    }
};
struct EpiSoftmax { EPI_HDR
    bf16* PX; LAS float* X;
    __device__ __forceinline__ void operator()(EPI_ARGS) const {
        const int c0 = wc * 32 + fq * 8;
        FOR_AI_M { float v = -3.0e38f;
            FOR_BJ FOR_N {
#pragma unroll
                for (int e = 0; e < 4; ++e) v = fmaxf(v, acc[ai][bj][m][n][e]); }
            v = fmaxf(v, __shfl_xor(v, 16)); v = fmaxf(v, __shfl_xor(v, 32));
            if (fq == 0) X[wc * 256 + TROW] = v; }
        asm volatile("s_waitcnt lgkmcnt(0)" ::: "memory"); __builtin_amdgcn_s_barrier(); asm volatile("" ::: "memory");
        FOR_AI_M { const int rl = TROW; const float M = fmaxf(fmaxf(X[rl], X[256 + rl]), fmaxf(X[512 + rl], X[768 + rl])); float s = 0.f;
            FOR_BJ FOR_N {
#pragma unroll
                for (int e = 0; e < 4; ++e) { const float p = __builtin_amdgcn_exp2f(acc[ai][bj][m][n][e] - M); acc[ai][bj][m][n][e] = p; s += p; } }
            s += __shfl_xor(s, 16); s += __shfl_xor(s, 32);
            if (fq == 0) X[1024 + wc * 256 + rl] = s; }
        asm volatile("s_waitcnt lgkmcnt(0)" ::: "memory"); __builtin_amdgcn_s_barrier(); asm volatile("" ::: "memory");
        FOR_AI_M { const int rl = TROW; const float inv = __builtin_amdgcn_rcpf((X[1024 + rl] + X[1280 + rl]) + (X[1536 + rl] + X[1792 + rl]));
            FOR_BJ st8b(PX + ((size_t)u.pm * 256 + rl) * 1024 + u.pn * 256 + bj * 128 + c0, acc[ai][bj][m][0] * inv, acc[ai][bj][m][1] * inv); }
        asm volatile("s_waitcnt lgkmcnt(0)" ::: "memory"); __builtin_amdgcn_s_barrier(); asm volatile("" ::: "memory");
    }
};
struct EpiSoftmaxR { EPI_HDR
    const u64* ss; bf16* PX; LAS float* X;
    __device__ __forceinline__ void operator()(EPI_ARGS) const {
        const int c0 = wc * 32 + fq * 8;
        FOR_AI_M { const float r = rstd_of(ss[u.pm * 256 + TROW]); float v = -3.0e38f;
            FOR_BJ FOR_N { const f32x4 t = acc[ai][bj][m][n] * r; acc[ai][bj][m][n] = t; v = fmaxf(fmaxf(v, fmaxf(t[0], t[1])), fmaxf(t[2], t[3])); }
            v = fmaxf(v, __shfl_xor(v, 16)); v = fmaxf(v, __shfl_xor(v, 32));
            if (fq == 0) X[wc * 256 + TROW] = v; }
        asm volatile("s_waitcnt lgkmcnt(0)" ::: "memory"); __builtin_amdgcn_s_barrier(); asm volatile("" ::: "memory");
        FOR_AI_M { const int rl = TROW; const float M = fmaxf(fmaxf(X[rl], X[256 + rl]), fmaxf(X[512 + rl], X[768 + rl])); float s = 0.f;
            FOR_BJ FOR_N {
#pragma unroll
                for (int e = 0; e < 4; ++e) { const float p = __builtin_amdgcn_exp2f(acc[ai][bj][m][n][e] - M); acc[ai][bj][m][n][e] = p; s += p; } }
            s += __shfl_xor(s, 16); s += __shfl_xor(s, 32);
            if (fq == 0) X[1024 + wc * 256 + rl] = s; }
        asm volatile("s_waitcnt lgkmcnt(0)" ::: "memory"); __builtin_amdgcn_s_barrier(); asm volatile("" ::: "memory");
        FOR_AI_M { const int rl = TROW; const float inv = __builtin_amdgcn_rcpf((X[1024 + rl] + X[1280 + rl]) + (X[1536 + rl] + X[1792 + rl]));
            FOR_BJ st8b(PX + ((size_t)u.pm * 256 + rl) * 1024 + u.pn * 256 + bj * 128 + c0, acc[ai][bj][m][0] * inv, acc[ai][bj][m][1] * inv); }
        asm volatile("s_waitcnt lgkmcnt(0)" ::: "memory"); __builtin_amdgcn_s_barrier(); asm volatile("" ::: "memory");
    }
};
struct EpiAbs { EPI_HDR
    bf16* out;
    __device__ __forceinline__ void operator()(EPI_ARGS) const {
        const int c0 = wc * 32 + fq * 8; const float sc = u.pm < 32 ? LOG2E * 0.0625f : 1.f;
        FOR_AI_M { const int row = u.pm * 256 + TROW;
            FOR_BJ st8b(out + (size_t)row * 1024 + u.pn * 256 + bj * 128 + c0, acc[ai][bj][m][0] * sc, acc[ai][bj][m][1] * sc); }
    }
};
struct EpiPlain { EPI_HDR
    bf16* out; int ld;
    __device__ __forceinline__ void operator()(EPI_ARGS) const {
        const int c0 = wc * 32 + fq * 8;
        FOR_AI_M { const int row = u.pm * 256 + TROW;
            FOR_BJ st8b(out + (size_t)row * ld + u.pn * 256 + bj * 128 + c0, acc[ai][bj][m][0], acc[ai][bj][m][1]); }
    }
};
struct EpiPlainNP { static constexpr bool PERM = false, AFTER_DRAIN = false;
    bf16* out; int ld;
    __device__ __forceinline__ void operator()(EPI_ARGS) const {
        FOR_AI_M { const int row = u.pm * 256 + TROW;
            FOR_BJ FOR_N { const f32x4 v = acc[ai][bj][m][n];
                *(u32x2*)(out + (size_t)row * ld + u.pn * 256 + bj * 128 + wc * 32 + n * 16 + fq * 4) = (u32x2){cvt_pk_bf16(v[0], v[1]), cvt_pk_bf16(v[2], v[3])}; } }
    }
};
struct EpiSwiGLU { EPI_HDR
    const u64* ss; bf16* HF;
    __device__ __forceinline__ void operator()(EPI_ARGS) const {
        const int c0 = wc * 32 + fq * 8;
        LOAD_RSTD8(rr, ss, u.pm * 256)
        FOR_AI_M { const int row = u.pm * 256 + TROW; const float r = rr[ai][m];
            const f32x4 o0 = silu4(acc[ai][0][m][0] * r) * (acc[ai][1][m][0] * r), o1 = silu4(acc[ai][0][m][1] * r) * (acc[ai][1][m][1] * r);
            st8b(HF + (size_t)row * DFF + u.pn * 128 + c0, o0, o1); }
    }
    __device__ __forceinline__ void quad(int rs, int pn, int tc, f32x4 v0, f32x4 v1, int g) const {
        const float r = rstd_of(ss[MP + rs]); const f32x4 o = silu4(v0 * r) * (v1 * r);
        *(u32x2*)(HF + (size_t)(MP + rs) * DFF + pn * 128 + tc) = (u32x2){cvt_pk_bf16(o[0], o[1]), cvt_pk_bf16(o[2], o[3])};
    }
};
struct EpiConvIn { EPI_HDR
    const u64* ss; bf16* BG; bf16* CI; float* out;
    __device__ __forceinline__ void operator()(EPI_ARGS) const {
        const int c0 = wc * 32 + fq * 8;
        LOAD_RSTD8(rr, ss, u.pm * 256)
        FOR_AI_M { const int row = u.pm * 256 + TROW; const float r = rr[ai][m];
            if (u.pn < 4) { FOR_BJ st8b(BG + (size_t)row * 1024 + u.pn * 256 + bj * 128 + c0, acc[ai][bj][m][0] * r, acc[ai][bj][m][1] * r); }
            else { const int col = (u.pn - 4) * 128 + c0; const f32x4 a = (acc[ai][0][m][0] * r) * (acc[ai][1][m][0] * r), b = (acc[ai][0][m][1] * r) * (acc[ai][1][m][1] * r);
                st8b(CI + (size_t)row * 1024 + col, a, b);
                if (row < MP) { const int t = row & 8191; if (t >= 8190) { float* d = out + O_CONVP + ((size_t)(row >> 13) * 2 + (t - 8190)) * 1024 + col; st4(d, a); st4(d + 4, b); } }
                else if (row < MREAL) { float* d = out + O_CONVS + ((size_t)(row - MP) * 2 + 1) * 1024 + col; st4(d, a); st4(d + 4, b); } } }
    }
    __device__ __forceinline__ void quad(int rs, int pn, int tc, f32x4 v0, f32x4 v1, int g) const {
        const float r = rstd_of(ss[MP + rs]); v0 = v0 * r; v1 = v1 * r;
        if (pn < 4) { bf16* d = BG + (size_t)(MP + rs) * 1024 + pn * 256 + tc; *(u32x2*)d = (u32x2){cvt_pk_bf16(v0[0], v0[1]), cvt_pk_bf16(v0[2], v0[3])}; *(u32x2*)(d + 128) = (u32x2){cvt_pk_bf16(v1[0], v1[1]), cvt_pk_bf16(v1[2], v1[3])}; }
        else { const f32x4 c = v0 * v1; const int col = (pn - 4) * 128 + tc; *(u32x2*)(CI + (size_t)(MP + rs) * 1024 + col) = (u32x2){cvt_pk_bf16(c[0], c[1]), cvt_pk_bf16(c[2], c[3])};
            st4(out + O_CONVS + ((size_t)rs * 2 + 1) * 1024 + col, c); }
    }
};
struct EpiSwaQKV { EPI_HDR
    const u64* ss; const float* CS; const float* SN; bf16* QS; bf16* KS; float* SWQ; float* out;
    __device__ __forceinline__ void operator()(EPI_ARGS) const {
        const int c0 = wc * 32 + fq * 8, pn = u.pn; const bool rot = ((wc & 1) == 0) && (fq < 2);
        LOAD_RSTD8(rr, ss, u.pm * 256)
        FOR_AI_M { const int row = u.pm * 256 + TROW; const float r = rr[ai][m]; const bool samp = row >= MP; const int pos = samp ? 8192 : (row & 8191);
            FOR_BJ { f32x4 v[2];
                FOR_N { v[n] = acc[ai][bj][m][n] * r;
                    if (pn < 5) { f32x4 pr;
#pragma unroll
                        for (int e = 0; e < 4; ++e) pr[e] = __shfl_xor(v[n][e], 16);
                        if (rot) { const f32x4 c = ld4(CS + (size_t)pos * 8 + 4 * n), s = ld4(SN + (size_t)pos * 8 + 4 * n); v[n] = (fq == 0) ? v[n] * c - pr * s : v[n] * c + pr * s; } } }
                const int tc = bj * 128 + c0;
                if (pn < 4) { const float qs = 0.125f * LOG2E; v[0] = v[0] * qs; v[1] = v[1] * qs;
                    if (!samp) st8b(QS + (size_t)row * 1024 + pn * 256 + tc, v[0], v[1]);
                    else if (row < MREAL) { float* d = SWQ + (size_t)(row - MP) * 1536 + pn * 256 + tc; st4(d, v[0]); st4(d + 4, v[1]); } }
                else if (pn == 4) {
                    if (!samp) { st8b(KS + (size_t)row * 256 + tc, v[0], v[1]); const int t = row & 8191;
                        if (t >= 8064) { float* d = out + O_SWKP + ((size_t)(row >> 13) * 128 + (t - 8064)) * 256 + tc; st4(d, v[0]); st4(d + 4, v[1]); } }
                    else if (row < MREAL) { float* d = SWQ + (size_t)(row - MP) * 1536 + 1024 + tc; st4(d, v[0]); st4(d + 4, v[1]); } }
                else {
                    if (!samp) { const int t = row & 8191; if (t >= 8064) { float* d = out + O_SWVP + ((size_t)(row >> 13) * 128 + (t - 8064)) * 256 + tc; st4(d, v[0]); st4(d + 4, v[1]); } }
                    else if (row < MREAL) { float* d = SWQ + (size_t)(row - MP) * 1536 + 1280 + tc; st4(d, v[0]); st4(d + 4, v[1]); } } } }
    }
    __device__ __forceinline__ void quad(int rs, int pn, int tc, f32x4 v0, f32x4 v1, int g) const {
        const float r = rstd_of(ss[MP + rs]); v0 = v0 * r; v1 = v1 * r;
        if (pn < 5) { f32x4 p0, p1;
#pragma unroll
            for (int e = 0; e < 4; ++e) { p0[e] = __shfl_xor(v0[e], 32); p1[e] = __shfl_xor(v1[e], 32); }
            if ((tc & 63) < 16) { const f32x4 c = ld4(CS + (size_t)8192 * 8 + (tc & 4)), s = ld4(SN + (size_t)8192 * 8 + (tc & 4));
                if ((tc & 8) == 0) { v0 = v0 * c - p0 * s; v1 = v1 * c - p1 * s; } else { v0 = v0 * c + p0 * s; v1 = v1 * c + p1 * s; } } }
        if (pn < 4) { const float qs = 0.125f * LOG2E; v0 = v0 * qs; v1 = v1 * qs; }
        float* d = SWQ + (size_t)rs * 1536 + (pn < 4 ? pn * 256 : (pn == 4 ? 1024 : 1280)) + tc; st4(d, v0); st4(d + 128, v1);
    }
};
struct EpiSwaVT { EPI_HDR
    const u64* ss; bf16* VT;
    __device__ __forceinline__ void operator()(EPI_ARGS) const {
        const int c0 = wc * 32 + fq * 8; const int b = u.pn >> 5, t0 = (u.pn & 31) * 256;
        f32x4 sc[2][2];
        FOR_BJ FOR_N { const u64* sp = ss + u.pn * 256 + bj * 128 + c0 + 4 * n;
#pragma unroll
            for (int e = 0; e < 4; ++e) sc[bj][n][e] = rstd_of(sp[e]); }
        FOR_AI_M { bf16* d = VT + ((size_t)(b * 256 + TROW)) * 8192 + t0 + c0;
            FOR_BJ st8b(d + bj * 128, acc[ai][bj][m][0] * sc[bj][0], acc[ai][bj][m][1] * sc[bj][1]); }
    }
};

struct DecMem { __device__ __forceinline__ void operator()(int L, Unit& u) const { u.pm = L >> 3; u.pn = L & 7; u.ao = (unsigned)u.pm * 256u * 1024u; u.bo = ((unsigned)(u.pm >> 1) * 2048u + (unsigned)u.pn * 256u) * 1024u; } };
struct DecMemT { __device__ __forceinline__ void operator()(int L, Unit& u) const { u.pm = L >> 1; u.pn = L & 1; u.ao = ((unsigned)(u.pm >> 2) * 2048u + 1024u + (unsigned)(u.pm & 3) * 256u) * 1024u; u.bo = ((unsigned)(u.pm >> 2) * 512u + (unsigned)u.pn * 256u) * 1024u; } };
struct DecAbs { __device__ __forceinline__ void operator()(int L, Unit& u) const { const unsigned kind = (unsigned)L >> 7, r = (unsigned)L & 127u, lb = r >> 4, h = (r >> 2) & 3u, t = r & 3u, lay = lb >> 1;
    if (kind == 0) { u.pm = (int)(lb * 4 + h); u.pn = (int)t; u.ao = (unsigned)(WS_MK / 2) + lb * 262144u + h * 256u; u.bo = (unsigned)(W_XQN / 2) + lay * 1048576u + t * 262144u + h * 256u; }
    else { u.pm = (int)(32 + lb * 4 + t); u.pn = (int)h; u.ao = (unsigned)(W_XO / 2) + lay * 1048576u + t * 262144u + h * 256u; u.bo = (unsigned)(WS_MV / 2) + lb * 262144u + h * 256u; } } };
struct DecGridB { DecGrid d; __device__ __forceinline__ void operator()(int L, Unit& u) const { d(L, u); u.bo += (unsigned)(u.pm >> 5) * 1048576u; } };
struct DecU { __device__ __forceinline__ void operator()(int L, Unit& u) const { const unsigned bhc = (unsigned)L >> 1, vh = L & 1; u.pm = L; u.pn = 0; u.ao = (bhc * 512u + vh * 256u) * 512u; u.bo = bhc * 131072u; } };
struct DecO { __device__ __forceinline__ void operator()(int L, Unit& u) const { const unsigned bhc = (unsigned)L >> 1, vh = L & 1; u.pm = L; u.pn = 0; u.ao = bhc * 256u * 512u; u.bo = (bhc * 512u + vh * 256u) * 512u; } };
struct DecXS { int layer; __device__ __forceinline__ void operator()(int L, Unit& u) const { u.pm = L >> 2; u.pn = L & 3; u.ao = (unsigned)u.pm * 256u * 1024u + (unsigned)u.pn * 256u; u.bo = ((unsigned)(layer * 2 + (u.pm >> 5)) * 256u) * 1024u + (unsigned)u.pn * 256u; } };
struct DecXPV { int layer; __device__ __forceinline__ void operator()(int L, Unit& u) const { u.pm = L >> 2; u.pn = L & 3; u.ao = (unsigned)u.pm * 256u * 1024u + (unsigned)u.pn * 256u; u.bo = ((unsigned)(layer * 2 + (u.pm >> 5)) * 1024u + (unsigned)u.pn * 256u) * 1024u; } };

__device__ __forceinline__ f32x4 mfma16(bf16x8 a, bf16x8 b, f32x4 c) { return __builtin_amdgcn_mfma_f32_16x16x32_bf16(a, b, c, 0, 0, 0); }
template <int RT = 8, class Epi>
__device__ __forceinline__ void sample_gemm(const Ctx& C, const bf16* A, int lda, int a_pn, const bf16* Bt, int ldb, unsigned b_pn, int K, int nunits, int skew, const Epi& E) {
    constexpr int NRB = 8 / RT;
    const int lane = olane(), r = lane & 15, g = lane >> 4, w = C.wave;
    const int first = (C.G - 1 - (int)blockIdx.x + skew) % C.G;
    int ks = K >> 3; asm volatile("" : "+s"(ks));
    LAS f32x4* P = (LAS f32x4*)(C.lds + RING_OFF);
    for (int su = first; su < nunits * NRB; su += C.G) { const int rb = su % NRB, sj = su / NRB, pn = sj >> 3, j = sj & 7;
        const bf16* ap = A + (size_t)(rb * 16 * RT + r) * lda + (size_t)pn * a_pn + w * ks + 8 * g;
        const bf16* bp0 = Bt + (size_t)pn * b_pn + (size_t)(16 * j + r) * ldb + w * ks + 8 * g; const bf16* bp1 = bp0 + (size_t)128 * ldb;
        f32x4 acc[RT][2];
#pragma unroll
        for (int rt = 0; rt < RT; ++rt) { acc[rt][0] = (f32x4){0.f, 0.f, 0.f, 0.f}; acc[rt][1] = (f32x4){0.f, 0.f, 0.f, 0.f}; }
#pragma unroll 4
        for (int k0 = 0; k0 < ks; k0 += 32) { const bf16x8 b0 = *(const bf16x8*)(bp0 + k0), b1 = *(const bf16x8*)(bp1 + k0); bf16x8 a[RT];
#pragma unroll
            for (int rt = 0; rt < RT; ++rt) a[rt] = *(const bf16x8*)(ap + (size_t)(16 * rt) * lda + k0);
#pragma unroll
            for (int rt = 0; rt < RT; ++rt) { acc[rt][0] = mfma16(b0, a[rt], acc[rt][0]); acc[rt][1] = mfma16(b1, a[rt], acc[rt][1]); } }
#pragma unroll
        for (int rt = 0; rt < RT; ++rt) { P[((w * RT + rt) * 2 + 0) * 64 + lane] = acc[rt][0]; P[((w * RT + rt) * 2 + 1) * 64 + lane] = acc[rt][1]; }
        __syncthreads();
        if (w < RT) {
            f32x4 v0 = P[((0 * RT + w) * 2 + 0) * 64 + lane], v1 = P[((0 * RT + w) * 2 + 1) * 64 + lane];
#pragma unroll
            for (int ww = 1; ww < 8; ++ww) { v0 += P[((ww * RT + w) * 2 + 0) * 64 + lane]; v1 += P[((ww * RT + w) * 2 + 1) * 64 + lane]; }
            E.quad(rb * 16 * RT + 16 * w + r, pn, 16 * j + 4 * g, v0, v1, g); }
        __syncthreads(); }
}


__device__ __forceinline__ void swa_unit(const Ctx& C, int unit, const bf16* QS, const bf16* KS, const bf16* VT, const float* sinks, bf16* AO) {
    const int kvh = unit & 3, qb = (unit >> 2) & 63, b = unit >> 8;
    const int lane_ = olane(); const int w = C.wave, l15 = lane_ & 15, g = lane_ >> 4, tid = w * 64 + lane_;
    const int head = kvh * 4 + (w >> 1);
    const float sink = sinks[head] * LOG2E;
    LAS unsigned char* KL = C.lds; LAS unsigned char* VL = C.lds + 40960;
    const int kstart = qb * 128 - 144;
    bf16x8 qf[4][2];
#pragma unroll
    for (int qt = 0; qt < 4; ++qt)
#pragma unroll
        for (int st = 0; st < 2; ++st) qf[qt][st] = *(const bf16x8*)(QS + ((size_t)b * 8192 + qb * 128 + (w & 1) * 64 + qt * 16 + l15) * 1024 + head * 64 + st * 32 + 8 * g);
    for (int c = tid; c < 2176; c += 512) { const int row = c >> 3, ch = c & 7, key = kstart + row;
        u32x4 v = (u32x4){0u, 0u, 0u, 0u}; if (key >= 0) v = *(const u32x4*)(KS + ((size_t)b * 8192 + key) * 256 + kvh * 64 + ch * 8);
        *(LAS u32x4*)(KL + row * 144 + ch * 16) = v; }
    for (int c = tid; c < 2176; c += 512) { const int d = c / 34, ch = c - d * 34, key0 = kstart + ch * 8;
        u32x4 v = (u32x4){0u, 0u, 0u, 0u}; if (key0 >= 0) v = *(const u32x4*)(VT + ((size_t)(b * 256 + kvh * 64 + d)) * 8192 + key0);
        *(LAS u32x4*)(VL + d * 560 + ch * 16) = v; }
    __syncthreads();
#pragma unroll 1
    for (int qt = 0; qt < 4; ++qt) {
        const int q0 = qb * 128 + (w & 1) * 64 + qt * 16, tb = (w & 1) * 4 + qt;
        const size_t qrow = (size_t)b * 8192 + q0 + l15;
        bf16x8 q0f = qf[0][0], q1f = qf[0][1];
        if (qt == 1) { q0f = qf[1][0]; q1f = qf[1][1]; } else if (qt == 2) { q0f = qf[2][0]; q1f = qf[2][1]; } else if (qt == 3) { q0f = qf[3][0]; q1f = qf[3][1]; }
        f32x4 s[10];
#pragma unroll
        for (int kt = 0; kt < 10; ++kt) { const LAS unsigned char* kp = KL + ((tb + kt) * 16 + l15) * 144 + g * 16;
            const bf16x8 k0 = *(const LAS bf16x8*)kp, k1 = *(const LAS bf16x8*)(kp + 64);
            f32x4 a = (f32x4){0.f, 0.f, 0.f, 0.f}; a = mfma16(k0, q0f, a); a = mfma16(k1, q1f, a); s[kt] = a; }
        float mx = sink;
#pragma unroll
        for (int kt = 0; kt < 10; ++kt)
#pragma unroll
            for (int e = 0; e < 4; ++e) { const int key = kstart + (tb + kt) * 16 + 4 * g + e, df = q0 + l15 - key; const bool ok = key >= 0 && df >= 0 && df <= 128;
                s[kt][e] = ok ? s[kt][e] : -3.0e38f; mx = fmaxf(mx, s[kt][e]); }
        mx = fmaxf(mx, __shfl_xor(mx, 16)); mx = fmaxf(mx, __shfl_xor(mx, 32));
        float sum = 0.f;
#pragma unroll
        for (int kt = 0; kt < 10; ++kt)
#pragma unroll
            for (int e = 0; e < 4; ++e) { const float p = __builtin_amdgcn_exp2f(s[kt][e] - mx); s[kt][e] = p; sum += p; }
        sum += __shfl_xor(sum, 16); sum += __shfl_xor(sum, 32);
        sum += __builtin_amdgcn_exp2f(sink - mx);
        const float inv = 1.f / sum;
        f32x4 o[4];
#pragma unroll
        for (int dt = 0; dt < 4; ++dt) o[dt] = (f32x4){0.f, 0.f, 0.f, 0.f};
#pragma unroll
        for (int ks = 0; ks < 5; ++ks) {
            const u32x4 pw = pack8(s[2 * ks], s[2 * ks + 1]); const bf16x8 pf = __builtin_bit_cast(bf16x8, pw);
            const int kb0 = (tb + 2 * ks) * 16 + 4 * g;
#pragma unroll
            for (int dt = 0; dt < 4; ++dt) { const LAS unsigned char* vp = VL + (dt * 16 + l15) * 560 + kb0 * 2;
                const u32x2 v0 = *(const LAS u32x2*)vp, v1 = *(const LAS u32x2*)(vp + 32);
                const u32x4 vw = (u32x4){v0.x, v0.y, v1.x, v1.y};
                o[dt] = mfma16(__builtin_bit_cast(bf16x8, vw), pf, o[dt]); } }
#pragma unroll
        for (int dt = 0; dt < 4; ++dt) { u32x2 wv; wv.x = cvt_pk_bf16(o[dt][0] * inv, o[dt][1] * inv); wv.y = cvt_pk_bf16(o[dt][2] * inv, o[dt][3] * inv);
            *(u32x2*)(AO + qrow * 1024 + head * 64 + dt * 16 + 4 * g) = wv; }
    }
    __syncthreads();
}

__device__ __forceinline__ void swa_sample_half(const Ctx& C, int unit, const float* SWQ, const float* ck, const float* cv, const float* sinks, float* out, bf16* AO) {
    LAS float* KV = (LAS float*)(C.lds);
    LAS float* SC = (LAS float*)(C.lds + 66560);
    const int b = unit >> 1, h2 = unit & 1, tid = otid(), lane = tid & 63, w = C.wave;
    const float* q = SWQ + (size_t)b * 1536;
    for (int pass = 0; pass < 2; ++pass) {
        const float* cache = (pass == 0 ? ck : cv) + (size_t)b * 128 * 256 + h2 * 128; float* oc = out + (pass == 0 ? O_SWKS : O_SWVS) + (size_t)b * 128 * 256 + h2 * 128;
        const float* nw = q + (pass == 0 ? 1024 : 1280) + h2 * 128;
        { f32x4 v[8];
#pragma unroll
          for (int i = 0; i < 8; ++i) { const int idx = tid + 512 * i; v[i] = ld4(cache + (size_t)(idx >> 5) * 256 + 4 * (idx & 31)); }
#pragma unroll
          for (int i = 0; i < 8; ++i) { const int idx = tid + 512 * i; *(LAS f32x4*)(KV + (idx >> 5) * 128 + 4 * (idx & 31)) = v[i]; } }
        if (tid < 32) { const f32x4 v = ld4(nw + 4 * tid); *(LAS f32x4*)(KV + 128 * 128 + 4 * tid) = v; st4(oc + (size_t)127 * 256 + 4 * tid, v); }
        __syncthreads();
        if (pass == 0) {
            const int jq = lane >> 4, dq = lane & 15, h = 8 * h2 + w; const f32x4 q4 = ld4(q + h * 64 + 4 * dq);
            for (int j0 = 0; j0 < 132; j0 += 4) { const int j = j0 + jq; const int jc = j < 129 ? j : 128;
                const f32x4 k4 = *(const LAS f32x4*)(KV + jc * 128 + (w >> 2) * 64 + 4 * dq);
                float p = (q4[0] * k4[0] + q4[1] * k4[1]) + (q4[2] * k4[2] + q4[3] * k4[3]);
                p += __shfl_xor(p, 1); p += __shfl_xor(p, 2); p += __shfl_xor(p, 4); p += __shfl_xor(p, 8);
                if (dq == 0 && j < 129) SC[w * 132 + j] = p; }
            LDS_WAIT(); asm volatile("" ::: "memory");
            { const float sink = sinks[h] * LOG2E;
                const float s0 = SC[w * 132 + lane], s1 = SC[w * 132 + 64 + lane], s2 = lane == 0 ? SC[w * 132 + 128] : -3.0e38f;
                const float mx = fmaxf(wave_max(fmaxf(fmaxf(s0, s1), s2)), sink);
                const float p0 = __builtin_amdgcn_exp2f(s0 - mx), p1 = __builtin_amdgcn_exp2f(s1 - mx), p2 = lane == 0 ? __builtin_amdgcn_exp2f(s2 - mx) : 0.f;
                const float inv = 1.f / (wave_sum(p0 + p1 + p2) + __builtin_amdgcn_exp2f(sink - mx));
                SC[w * 132 + lane] = p0 * inv; SC[w * 132 + 64 + lane] = p1 * inv; if (lane == 0) SC[w * 132 + 128] = p2 * inv; }
            __syncthreads();
        } else {
            const int d2 = lane & 31, jh = lane >> 5; float o0 = 0.f, o1 = 0.f;
#pragma unroll 4
            for (int j = jh; j < 129; j += 2) { const float p = SC[w * 132 + j]; const f32x2 v = *(const LAS f32x2*)(KV + j * 128 + (w >> 2) * 64 + 2 * d2); o0 += p * v.x; o1 += p * v.y; }
            o0 += __shfl_xor(o0, 32); o1 += __shfl_xor(o1, 32);
            if (jh == 0) *(unsigned*)(AO + (size_t)(MP + b) * 1024 + (8 * h2 + w) * 64 + 2 * d2) = cvt_pk_bf16(o0, o1);
            __syncthreads();
        }
    }
}
__device__ __forceinline__ void swa_state_copy(const Ctx& C, int b, const float* ck, const float* cv, float* out) {
    const int tid = otid();
    for (int pass = 0; pass < 2; ++pass) {
        const float* src = (pass == 0 ? ck : cv) + (size_t)b * 32768 + 256; float* dst = out + (pass == 0 ? O_SWKS : O_SWVS) + (size_t)b * 32768;
#pragma unroll 1
        for (int i0 = tid; i0 < 8128; i0 += 2048) { f32x4 v[4];
#pragma unroll
            for (int k = 0; k < 4; ++k) { const int i = i0 + 512 * k; v[k] = ld4(src + 4 * (size_t)(i < 8128 ? i : 8127)); }
#pragma unroll
            for (int k = 0; k < 4; ++k) { const int i = i0 + 512 * k; if (i < 8128) st4(dst + 4 * (size_t)i, v[k]); } }
    }
}

__device__ __forceinline__ void ret_sample_unit(const Ctx& C, int unit, const float* SQ, const float* state, const bf16* Gt, float* out, bf16* UB, LAS unsigned char* lb) {
    const int b = unit >> 2, h = unit & 3, tid = otid(), lane_ = tid & 63;
    LAS float* QK = (LAS float*)(lb);
    LAS float* RED = (LAS float*)(lb + 2048);
    LAS float* R2 = (LAS float*)(lb + 2048 + 8192);
    QK[tid] = SQ[(size_t)b * 4096 + (tid < 256 ? h * 256 + tid : 1024 + h * 256 + (tid - 256))];
    const int rg = tid >> 7, c4 = tid & 127;
    const f32x4 v4 = ld4(SQ + (size_t)b * 4096 + 2048 + h * 512 + 4 * c4);
    __syncthreads();
    const float gh = __builtin_amdgcn_exp2f(lg2g(h));
    const float* S = state + ((size_t)(b * 4 + h) * 256) * 512 + 4 * c4; float* So = out + O_RETS + ((size_t)(b * 4 + h) * 256) * 512 + 4 * c4;
    f32x4 a = (f32x4){0.f, 0.f, 0.f, 0.f};
    for (int it = 0; it < 64; it += 8) { f32x4 s[8];
#pragma unroll
        for (int k = 0; k < 8; ++k) s[k] = ld4(S + (size_t)((it + k) * 4 + rg) * 512);
#pragma unroll
        for (int k = 0; k < 8; ++k) { const int d = (it + k) * 4 + rg; const f32x4 sn = s[k] * gh + v4 * QK[256 + d]; st4(So + (size_t)d * 512, sn); a += sn * QK[d]; } }
    *(LAS f32x4*)(RED + rg * 512 + 4 * c4) = a;
    __syncthreads();
    f32x4 o = (f32x4){0.f, 0.f, 0.f, 0.f};
    if (tid < 128) { o = *(LAS f32x4*)(RED + 4 * tid) + *(LAS f32x4*)(RED + 512 + 4 * tid) + *(LAS f32x4*)(RED + 1024 + 4 * tid) + *(LAS f32x4*)(RED + 1536 + 4 * tid);
        const float s1 = wave_sum((o[0] + o[1]) + (o[2] + o[3])); if (lane_ == 0) R2[C.wave] = s1; }
    __syncthreads();
    const float mu = (R2[0] + R2[1]) * (1.f / 512.f);
    if (tid < 128) { const f32x4 dd = o - mu; const float s2 = wave_sum((dd[0] * dd[0] + dd[1] * dd[1]) + (dd[2] * dd[2] + dd[3] * dd[3])); if (lane_ == 0) R2[8 + C.wave] = s2; }
    __syncthreads();
    if (tid < 128) { const float rstd = __builtin_amdgcn_rsqf((R2[8] + R2[9]) * (1.f / 512.f) + EPS);
        const u32x2 gw = *(const u32x2*)(Gt + (size_t)(MP + b) * 2048 + h * 512 + 4 * tid);
        u32x2 wv; wv.x = cvt_pk_bf16(bflo(gw.x) * (o[0] - mu) * rstd, bfhi(gw.x) * (o[1] - mu) * rstd); wv.y = cvt_pk_bf16(bflo(gw.y) * (o[2] - mu) * rstd, bfhi(gw.y) * (o[3] - mu) * rstd);
        *(u32x2*)(UB + (size_t)(MP + b) * 2048 + h * 512 + 4 * tid) = wv; }
    __syncthreads();
}

__device__ __forceinline__ void xs_sample_unit(const Ctx& C, int unit, const bf16* QX, const float* cmk, const float* cmv, bf16* OX, LAS unsigned char* lb) {
    const int b = unit >> 2, h = unit & 3, tid = otid(), lane = tid & 63, w = C.wave;
    LAS float* SC = (LAS float*)(lb);
    LAS float* RED = (LAS float*)(lb + 1024);
    const u32x2 qw = *(const u32x2*)(QX + (size_t)(MP + b) * 1024 + h * 256 + 4 * lane);
    const f32x4 q4 = (f32x4){bflo(qw.x), bfhi(qw.x), bflo(qw.y), bfhi(qw.y)};
    const float* Kp = cmk + ((size_t)b * 256) * 1024 + h * 256 + 4 * lane; const float* Vp = cmv + ((size_t)b * 256) * 1024 + h * 256 + 4 * lane;
    for (int i0 = 0; i0 < 32; i0 += 8) { f32x4 k[8];
#pragma unroll
        for (int k8 = 0; k8 < 8; ++k8) k[k8] = ld4(Kp + (size_t)(w * 32 + i0 + k8) * 1024);
#pragma unroll
        for (int k8 = 0; k8 < 8; ++k8) { const float p = wave_sum((q4[0] * k[k8][0] + q4[1] * k[k8][1]) + (q4[2] * k[k8][2] + q4[3] * k[k8][3])); if (lane == 0) SC[w * 32 + i0 + k8] = p; } }
    f32x4 v[8];
#pragma unroll
    for (int k8 = 0; k8 < 8; ++k8) v[k8] = ld4(Vp + (size_t)(w * 32 + k8) * 1024);
    __syncthreads();
    const float mx = wave_max(fmaxf(fmaxf(SC[lane], SC[64 + lane]), fmaxf(SC[128 + lane], SC[192 + lane])));
    const float sum = wave_sum((__builtin_amdgcn_exp2f(SC[lane] - mx) + __builtin_amdgcn_exp2f(SC[64 + lane] - mx)) + (__builtin_amdgcn_exp2f(SC[128 + lane] - mx) + __builtin_amdgcn_exp2f(SC[192 + lane] - mx)));
    f32x4 a = (f32x4){0.f, 0.f, 0.f, 0.f};
#pragma unroll
    for (int i0 = 0; i0 < 32; i0 += 8) { f32x4 n[8];
        if (i0 + 8 < 32) {
#pragma unroll
            for (int k8 = 0; k8 < 8; ++k8) n[k8] = ld4(Vp + (size_t)(w * 32 + i0 + 8 + k8) * 1024); }
#pragma unroll
        for (int k8 = 0; k8 < 8; ++k8) a += v[k8] * __builtin_amdgcn_exp2f(SC[w * 32 + i0 + k8] - mx);
        if (i0 + 8 < 32) {
#pragma unroll
            for (int k8 = 0; k8 < 8; ++k8) v[k8] = n[k8]; } }
    *(LAS f32x4*)(RED + w * 256 + 4 * lane) = a;
    __syncthreads();
    if (tid < 64) { f32x4 o = (f32x4){0.f, 0.f, 0.f, 0.f};
#pragma unroll
        for (int k = 0; k < 8; ++k) o += *(LAS f32x4*)(RED + k * 256 + 4 * tid);
        const float inv = 1.f / sum; u32x2 wv; wv.x = cvt_pk_bf16(o[0] * inv, o[1] * inv); wv.y = cvt_pk_bf16(o[2] * inv, o[3] * inv);
        *(u32x2*)(OX + (size_t)(MP + b) * 1024 + h * 256 + 4 * tid) = wv; }
    __syncthreads();
}

__device__ __forceinline__ void conv_mix_rows(const Ctx& C, const Args& args, unsigned char* ws, int row0, int row1) {
    const int gw = C.vcu * 8 + C.wave, NGW = C.G * 8;
        const bf16* BG = (const bf16*)(ws + WS_Q); const bf16* CI = (const bf16*)(ws + WS_KB); bf16* UB = (bf16*)(ws + WS_UB); const float* cw = KIN(I_CW); const int lane_ = olane();
    for (int row = row0 + gw; row < row1; row += NGW) {
#pragma unroll
            for (int hf = 0; hf < 2; ++hf) { const int col = hf * 512 + 8 * lane_; float c0[8], c1[8], c2[8];
                if (row < MP) { const int t = row & 8191;
                    const u32x4 z = (u32x4){0u, 0u, 0u, 0u};
                    const u32x4 a0 = t >= 2 ? *(const u32x4*)(CI + (size_t)(row - 2) * 1024 + col) : z, a1 = t >= 1 ? *(const u32x4*)(CI + (size_t)(row - 1) * 1024 + col) : z, a2 = *(const u32x4*)(CI + (size_t)row * 1024 + col);
#pragma unroll
                    for (int k = 0; k < 4; ++k) { c0[2 * k] = bflo(a0[k]); c0[2 * k + 1] = bfhi(a0[k]); c1[2 * k] = bflo(a1[k]); c1[2 * k + 1] = bfhi(a1[k]); c2[2 * k] = bflo(a2[k]); c2[2 * k + 1] = bfhi(a2[k]); }
                } else { const int b = row - MP; const float* sc = KIN(I_SCONV) + (size_t)b * 2048 + col; const float* cn = args.out + O_CONVS + ((size_t)b * 2 + 1) * 1024 + col; float* co = args.out + O_CONVS + ((size_t)b * 2) * 1024 + col;
#pragma unroll
                    for (int k = 0; k < 8; ++k) { c0[k] = sc[k]; c1[k] = sc[1024 + k]; c2[k] = cn[k]; co[k] = c1[k]; } }
                const u32x4 bgv = *(const u32x4*)(BG + (size_t)row * 1024 + col); float o[8];
#pragma unroll
                for (int k = 0; k < 8; ++k) { const float bgk = (k & 1) ? bfhi(bgv[k >> 1]) : bflo(bgv[k >> 1]); o[k] = bgk * (cw[col + k] * c0[k] + cw[1024 + col + k] * c1[k] + cw[2048 + col + k] * c2[k]); }
                u32x4 r; r.x = cvt_pk_bf16(o[0], o[1]); r.y = cvt_pk_bf16(o[2], o[3]); r.z = cvt_pk_bf16(o[4], o[5]); r.w = cvt_pk_bf16(o[6], o[7]);
                *(u32x4*)(UB + (size_t)row * 1024 + col) = r; } }
}
__device__ __forceinline__ void conv_mix_sample(const Ctx& C, const Args& args, unsigned char* ws) {
    const int gw = C.vcu * 8 + C.wave, NGW = C.G * 8, lane_ = olane();
    const bf16* BG = (const bf16*)(ws + WS_Q); bf16* UB = (bf16*)(ws + WS_UB); const float* cw = KIN(I_CW);
    for (int item = gw; item < 256; item += NGW) { const int b = item >> 1, col = (item & 1) * 512 + 8 * lane_; const size_t row = (size_t)MP + b;
        const float* sc = KIN(I_SCONV) + (size_t)b * 2048 + col; const float* cn = args.out + O_CONVS + ((size_t)b * 2 + 1) * 1024 + col; float* co = args.out + O_CONVS + ((size_t)b * 2) * 1024 + col;
        const f32x4 a0 = ld4(sc), a1 = ld4(sc + 4), b0 = ld4(sc + 1024), b1 = ld4(sc + 1028), c0 = ld4(cn), c1 = ld4(cn + 4);
        const u32x4 bgv = *(const u32x4*)(BG + row * 1024 + col);
        const f32x4 w00 = ld4(cw + col), w01 = ld4(cw + col + 4), w10 = ld4(cw + 1024 + col), w11 = ld4(cw + 1024 + col + 4), w20 = ld4(cw + 2048 + col), w21 = ld4(cw + 2048 + col + 4);
        st4(co, b0); st4(co + 4, b1);
        const f32x4 o0 = (f32x4){bflo(bgv.x), bfhi(bgv.x), bflo(bgv.y), bfhi(bgv.y)} * (w00 * a0 + w10 * b0 + w20 * c0), o1 = (f32x4){bflo(bgv.z), bfhi(bgv.z), bflo(bgv.w), bfhi(bgv.w)} * (w01 * a1 + w11 * b1 + w21 * c1);
        *(u32x4*)(UB + row * 1024 + col) = pack8(o0, o1); }
}
__device__ __forceinline__ void pool_mix_rows(const Ctx& C, const Args& args, unsigned char* ws, int item0, int item1) {
    const int gw = C.vcu * 8 + C.wave, NGW = C.G * 8;
        const u64* ss = (const u64*)(ws + WS_SS) + (size_t)9 * MT; const bf16* XB = (const bf16*)(ws + WS_XB); const float* ng = KIN(I_NG) + 9 * 1024; bf16* UB = (bf16*)(ws + WS_UB); const int lane_ = olane();
    for (int item = item0 + gw; item < item1; item += NGW) { const int row = item >> 2, gi = item & 3, w = 2 << gi, col = gi * 256 + 4 * lane_;
            const f32x4 g4 = ld4(ng + col);
#define LDX(rr) ({ const u32x2 t_ = *(const u32x2*)(XB + (size_t)(rr) * 1024 + col); (f32x4){bflo(t_.x), bfhi(t_.x), bflo(t_.y), bfhi(t_.y)}; })
            const f32x4 hn = LDX(row) * rstd_of(ss[row]) * g4; f32x4 sum = hn; float cnt;
            if (row < MP) { const int t = row & 8191; const int n = (t + 1 < w) ? t + 1 : w; cnt = (float)n;
                for (int j = 1; j < n; ++j) sum += LDX(row - j) * rstd_of(ss[row - j]) * g4;
                if (t >= 8177) st4(args.out + O_POOLP + ((size_t)(row >> 13) * 15 + (t - 8177)) * 1024 + col, hn);
            } else { const int b = row - MP; cnt = (float)w; const float* sp = KIN(I_SPOOL) + (size_t)b * 15 * 1024 + col;
                for (int j = 1; j < w; ++j) sum += ld4(sp + (size_t)(15 - j) * 1024);
                st4(args.out + O_POOLS + ((size_t)b * 15 + 14) * 1024 + col, hn); }
#undef LDX
            const f32x4 dd = sum * (1.f / cnt) - hn; u32x2 wv; wv.x = cvt_pk_bf16(dd[0], dd[1]); wv.y = cvt_pk_bf16(dd[2], dd[3]);
            *(u32x2*)(UB + (size_t)row * 1024 + col) = wv; }
}
__device__ __forceinline__ void pool_mix_sample(const Ctx& C, const Args& args, unsigned char* ws) {
    const int gw = C.vcu * 8 + C.wave, NGW = C.G * 8, lane_ = olane();
    const u64* ss = (const u64*)(ws + WS_SS) + (size_t)9 * MT; const bf16* XB = (const bf16*)(ws + WS_XB); const float* ng = KIN(I_NG) + 9 * 1024; bf16* UB = (bf16*)(ws + WS_UB);
    for (int item = gw; item < 512; item += NGW) { const int b = item >> 2, gi = item & 3, w = 2 << gi, col = gi * 256 + 4 * lane_; const size_t row = (size_t)MP + b;
        const float* sp = KIN(I_SPOOL) + (size_t)b * 15 * 1024 + col;
        const f32x4 g4 = ld4(ng + col); const u32x2 xv = *(const u32x2*)(XB + row * 1024 + col); const u64 sv = ss[row];
        f32x4 st[15];
#pragma unroll
        for (int j = 1; j < 16; ++j) st[j - 1] = ld4(sp + (size_t)(15 - j) * 1024);
        const f32x4 hn = (f32x4){bflo(xv.x), bfhi(xv.x), bflo(xv.y), bfhi(xv.y)} * rstd_of(sv) * g4; f32x4 sum = hn;
#pragma unroll
        for (int j = 1; j < 16; ++j) if (j < w) sum += st[j - 1];
        st4(args.out + O_POOLS + ((size_t)b * 15 + 14) * 1024 + col, hn);
        const f32x4 dd = sum * (1.f / (float)w) - hn;
        *(u32x2*)(UB + row * 1024 + col) = (u32x2){cvt_pk_bf16(dd[0], dd[1]), cvt_pk_bf16(dd[2], dd[3])}; }
}
__device__ __forceinline__ void pool_state_copy(const Ctx& C, int b, const float* spool, float* out) {
    const int tid = otid(); const float* src = spool + ((size_t)b * 15 + 1) * 1024; float* dst = out + O_POOLS + (size_t)b * 15 * 1024; f32x4 v[7];
#pragma unroll
    for (int k = 0; k < 7; ++k) v[k] = ld4(src + 4 * (size_t)(tid + 512 * k));
#pragma unroll
    for (int k = 0; k < 7; ++k) st4(dst + 4 * (size_t)(tid + 512 * k), v[k]);
}
__device__ __forceinline__ void final_rows(const Ctx& C, const Args& args, unsigned char* ws, int row0, int row1) {
    const int gw = C.vcu * 8 + C.wave, NGW = C.G * 8;
        const u64* ss = (const u64*)(ws + WS_SS) + (size_t)12 * MT; const float* fg = KIN(I_FNG); const int lane_ = olane(); const bf16* XB = (const bf16*)(ws + WS_XB); float* xf = args.out;
        f32x4 gg[4];
#pragma unroll
        for (int hf = 0; hf < 2; ++hf) { gg[2 * hf] = ld4(fg + hf * 512 + 8 * lane_); gg[2 * hf + 1] = ld4(fg + hf * 512 + 8 * lane_ + 4); }
        for (int row = row0 + gw; row < row1; row += 2 * NGW) { const int row2 = (row + NGW < row1) ? row + NGW : row;
            u32x4 v[2], w[2];
#pragma unroll
            for (int hf = 0; hf < 2; ++hf) { v[hf] = *(const u32x4*)(XB + (size_t)row * 1024 + hf * 512 + 8 * lane_); w[hf] = *(const u32x4*)(XB + (size_t)row2 * 1024 + hf * 512 + 8 * lane_); }
            const float r = rstd_of(ss[row]), r2 = rstd_of(ss[row2]);
#pragma unroll
            for (int hf = 0; hf < 2; ++hf) { float* o = xf + (size_t)row * 1024 + hf * 512 + 8 * lane_;
                st4(o, (f32x4){bflo(v[hf].x), bfhi(v[hf].x), bflo(v[hf].y), bfhi(v[hf].y)} * r * gg[2 * hf]); st4(o + 4, (f32x4){bflo(v[hf].z), bfhi(v[hf].z), bflo(v[hf].w), bfhi(v[hf].w)} * r * gg[2 * hf + 1]); }
            if (row2 != row) {
#pragma unroll
                for (int hf = 0; hf < 2; ++hf) { float* o = xf + (size_t)row2 * 1024 + hf * 512 + 8 * lane_;
                    st4(o, (f32x4){bflo(w[hf].x), bfhi(w[hf].x), bflo(w[hf].y), bfhi(w[hf].y)} * r2 * gg[2 * hf]); st4(o + 4, (f32x4){bflo(w[hf].z), bfhi(w[hf].z), bflo(w[hf].w), bfhi(w[hf].w)} * r2 * gg[2 * hf + 1]); } } }
}


__device__ __forceinline__ f32x4 bf4(u32x2 t) { return (f32x4){bflo(t.x), bfhi(t.x), bflo(t.y), bfhi(t.y)}; }
__device__ __forceinline__ void pool_mix_runs(const Ctx& C, unsigned char* ws, float* out) {
    const int gw = C.vcu * 8 + C.wave, NGW = C.G * 8, lane_ = olane();
    const u64* ss = (const u64*)(ws + WS_SS) + (size_t)9 * MT; const bf16* XBp = (const bf16*)(ws + WS_XB); bf16* UB = (bf16*)(ws + WS_UB); const float* ng = KIN(I_NG) + 9 * 1024;
    for (int item = gw; item < (MP / 32) * 4; item += NGW) { const int gi = item & 3, row0 = (item >> 2) * 32, t0 = row0 & 8191, w = 2 << gi, col = gi * 256 + 4 * lane_;
        const f32x4 g4 = ld4(ng + col);
        f32x4 sum = (f32x4){0.f, 0.f, 0.f, 0.f};
        if (t0 > 0) {
            u32x2 a[16]; u64 sa[16];
#pragma unroll
            for (int j = 0; j < 16; ++j) { const int r = row0 - 1 - (j < w ? j : 0); a[j] = *(const u32x2*)(XBp + (size_t)r * 1024 + col); sa[j] = ss[r]; }
#pragma unroll
            for (int j = 0; j < 16; ++j) if (j < w) sum += bf4(a[j]) * (rstd_of(sa[j]) * g4);
        }
#pragma unroll 1
        for (int k0 = 0; k0 < 32; k0 += 8) { u32x2 a[8], o[8]; u64 sa[8], so[8];
#pragma unroll
            for (int k = 0; k < 8; ++k) { const int r = row0 + k0 + k, ro = (t0 + k0 + k - w >= 0) ? r - w : r; a[k] = *(const u32x2*)(XBp + (size_t)r * 1024 + col); sa[k] = ss[r]; o[k] = *(const u32x2*)(XBp + (size_t)ro * 1024 + col); so[k] = ss[ro]; }
#pragma unroll
            for (int k = 0; k < 8; ++k) { const int r = row0 + k0 + k, t = t0 + k0 + k; const f32x4 hn = bf4(a[k]) * (rstd_of(sa[k]) * g4);
                sum += hn; if (t - w >= 0) sum -= bf4(o[k]) * (rstd_of(so[k]) * g4);
                const float cnt = (float)((t + 1 < w) ? t + 1 : w); const f32x4 dd = sum * (1.f / cnt) - hn;
                *(u32x2*)(UB + (size_t)r * 1024 + col) = (u32x2){cvt_pk_bf16(dd[0], dd[1]), cvt_pk_bf16(dd[2], dd[3])};
                if (t >= 8177) st4(out + O_POOLP + ((size_t)(r >> 13) * 15 + (t - 8177)) * 1024 + col, hn); } }
    }
}
__device__ __forceinline__ void conv_mix_runs(const Ctx& C, unsigned char* ws) {
    const int gw = C.vcu * 8 + C.wave, NGW = C.G * 8, lane_ = olane();
    const bf16* BG = (const bf16*)(ws + WS_Q); const bf16* CI = (const bf16*)(ws + WS_KB); bf16* UB = (bf16*)(ws + WS_UB); const float* cw = KIN(I_CW);
    for (int run = gw; run < MP / 8; run += NGW) { const int row0 = run * 8, t0 = row0 & 8191;
#pragma unroll 1
        for (int hf = 0; hf < 2; ++hf) { const int col = hf * 512 + 8 * lane_;
            u32x4 ci[10], bgv[8]; const u32x4 z = (u32x4){0u, 0u, 0u, 0u};
#pragma unroll
            for (int k = 0; k < 10; ++k) ci[k] = (t0 + k - 2 >= 0) ? *(const u32x4*)(CI + (size_t)(row0 + k - 2) * 1024 + col) : z;
#pragma unroll
            for (int k = 0; k < 8; ++k) bgv[k] = *(const u32x4*)(BG + (size_t)(row0 + k) * 1024 + col);
            f32x4 w0[2], w1[2], w2[2];
#pragma unroll
            for (int q = 0; q < 2; ++q) { w0[q] = ld4(cw + col + 4 * q); w1[q] = ld4(cw + 1024 + col + 4 * q); w2[q] = ld4(cw + 2048 + col + 4 * q); }
#pragma unroll
            for (int k = 0; k < 8; ++k) { u32x4 r;
#pragma unroll
                for (int q = 0; q < 2; ++q) { const f32x4 c0 = bf4((u32x2){ci[k][2 * q], ci[k][2 * q + 1]}), c1 = bf4((u32x2){ci[k + 1][2 * q], ci[k + 1][2 * q + 1]}), c2 = bf4((u32x2){ci[k + 2][2 * q], ci[k + 2][2 * q + 1]});
                    const f32x4 o = bf4((u32x2){bgv[k][2 * q], bgv[k][2 * q + 1]}) * (w0[q] * c0 + w1[q] * c1 + w2[q] * c2);
                    r[2 * q] = cvt_pk_bf16(o[0], o[1]); r[2 * q + 1] = cvt_pk_bf16(o[2], o[3]); }
                *(u32x4*)(UB + (size_t)(row0 + k) * 1024 + col) = r; } }
    }
}


__device__ __forceinline__ void xattn_unit(const Ctx& C, int pm, int h, int lb  , const bf16* Q, const bf16* MK, const bf16* MVT, bf16* OX) {
    const int lane_ = olane(), w = C.wave, l15 = lane_ & 15, g = lane_ >> 4, tid = w * 64 + lane_;
    LAS unsigned char* KL = C.lds;
    {   u32x4 st[16];
#pragma unroll
        for (int i = 0; i < 16; ++i) { const int c = tid + 512 * i, row = c >> 5, ch = c & 31; st[i] = *(const u32x4*)(MK + ((size_t)lb * 256 + row) * 1024 + h * 256 + ch * 8); }
#pragma unroll
        for (int i = 0; i < 16; ++i) { const int c = tid + 512 * i, row = c >> 5, ch = c & 31; *(LAS u32x4*)(KL + row * 528 + ch * 16) = st[i]; } }
    __syncthreads();
    bf16x8 pf[2][8];
    float inv[2];
#pragma unroll
    for (int t = 0; t < 2; ++t) {
        bf16x8 qf[8];
#pragma unroll
        for (int ks = 0; ks < 8; ++ks) qf[ks] = *(const bf16x8*)(Q + ((size_t)pm * 256 + 32 * w + 16 * t + l15) * 1024 + h * 256 + ks * 32 + 8 * g);
        f32x4 sc[16];
#pragma unroll
        for (int kt = 0; kt < 16; ++kt) { f32x4 a0 = (f32x4){0.f, 0.f, 0.f, 0.f}; const LAS unsigned char* kp = KL + (kt * 16 + l15) * 528 + g * 16;
#pragma unroll
            for (int ks = 0; ks < 8; ++ks) a0 = mfma16(*(const LAS bf16x8*)(kp + ks * 64), qf[ks], a0);
            sc[kt] = a0; }
        float mx = -3.0e38f;
#pragma unroll
        for (int kt = 0; kt < 16; ++kt)
#pragma unroll
            for (int e = 0; e < 4; ++e) mx = fmaxf(mx, sc[kt][e]);
        mx = fmaxf(mx, __shfl_xor(mx, 16)); mx = fmaxf(mx, __shfl_xor(mx, 32));
        float z = 0.f;
#pragma unroll
        for (int kt = 0; kt < 16; ++kt)
#pragma unroll
            for (int e = 0; e < 4; ++e) { const float p = __builtin_amdgcn_exp2f(sc[kt][e] - mx); sc[kt][e] = p; z += p; }
        z += __shfl_xor(z, 16); z += __shfl_xor(z, 32);
        inv[t] = 1.f / z;
#pragma unroll
        for (int ks = 0; ks < 8; ++ks) pf[t][ks] = __builtin_bit_cast(bf16x8, pack8(sc[2 * ks], sc[2 * ks + 1]));
    }
    __syncthreads();
    {   u32x4 st[16];
#pragma unroll
        for (int i = 0; i < 16; ++i) { const int c = tid + 512 * i, row = c >> 5, ch = c & 31; st[i] = *(const u32x4*)(MVT + ((size_t)lb * 1024 + h * 256 + row) * 1024 + ch * 8); }
#pragma unroll
        for (int i = 0; i < 16; ++i) { const int c = tid + 512 * i, row = c >> 5, ch = c & 31; *(LAS u32x4*)(KL + row * 528 + ch * 16) = st[i]; } }
    __syncthreads();
    const int drow = 8 * (l15 >> 2) + (l15 & 3);
    bf16* o0p = OX + ((size_t)pm * 256 + 32 * w + l15) * 1024 + h * 256 + 8 * g; bf16* o1p = o0p + (size_t)16 * 1024;
#pragma unroll
    for (int dp = 0; dp < 8; ++dp) { f32x4 e0 = (f32x4){0.f, 0.f, 0.f, 0.f}, e1 = e0, f0 = e0, f1 = e0;
        const LAS unsigned char* vpe = KL + (32 * dp + drow) * 528 + g * 8; const LAS unsigned char* vpo = vpe + 4 * 528;
#pragma unroll
        for (int ks = 0; ks < 8; ++ks) { const u32x2 a = *(const LAS u32x2*)(vpe + ks * 64), b = *(const LAS u32x2*)(vpe + ks * 64 + 32), c2 = *(const LAS u32x2*)(vpo + ks * 64), d2 = *(const LAS u32x2*)(vpo + ks * 64 + 32);
            const bf16x8 ve = __builtin_bit_cast(bf16x8, (u32x4){a.x, a.y, b.x, b.y}), vo = __builtin_bit_cast(bf16x8, (u32x4){c2.x, c2.y, d2.x, d2.y});
            e0 = mfma16(ve, pf[0][ks], e0); e1 = mfma16(ve, pf[1][ks], e1); f0 = mfma16(vo, pf[0][ks], f0); f1 = mfma16(vo, pf[1][ks], f1); }
        st8b(o0p + 32 * dp, e0 * inv[0], f0 * inv[0]); st8b(o1p + 32 * dp, e1 * inv[1], f1 * inv[1]); }
    __syncthreads();
}

#define SSP(k) ((u64*)(ws + WS_SS) + (size_t)(k) * MT)
#define XBS ((bf16*)(ws + WS_XB) + (size_t)MP * 1024)
__device__ __forceinline__ void s_in0(const Ctx& C, unsigned char* ws) {
    EpiRetIn E{SSP(0), (const float*)(ws + T_CR), (const float*)(ws + T_SR), (bf16*)(ws + WS_Q), (bf16*)(ws + WS_KB), (bf16*)(ws + WS_APQ), (bf16*)(ws + WS_G), (float*)(ws + WS_SQ)};
    sample_gemm<8>(C, XBS, 1024, 0, (const bf16*)(ws + W_RET_IN), 1024, 262144u, 1024, 24 * 8, 0, E);
}
__device__ __forceinline__ void s_ret(const Ctx& C, unsigned char* ws, float* out, int un) {
    if (un < 512) ret_sample_unit(C, un, (const float*)(ws + WS_SQ), KIN(I_SRET), (const bf16*)(ws + WS_G), out, (bf16*)(ws + WS_UB), C.lds + EPIX_OFF); }
struct RetSide { Ctx C; unsigned char* ws; float* out; int slot, un;
    __device__ __forceinline__ void operator()(int ui) const { if (ui == slot) s_ret(C, ws, out, un); } };
__device__ __forceinline__ void s_out0(const Ctx& C, const Args& args, unsigned char* ws) {
    EpiResidual E{KIN(I_XP), KIN(I_XS), (bf16*)(ws + WS_XB), SSP(1)};
    sample_gemm<2>(C, (const bf16*)(ws + WS_UB) + (size_t)MP * 2048, 2048, 0, (const bf16*)(ws + W_RET_OUT), 2048, 256u * 2048u, 2048, 32, 0, E);
}
__device__ __forceinline__ void s_xq(const Ctx& C, unsigned char* ws, int L) {
    EpiScale E{SSP(3 * L + 1), LOG2E * 0.0625f, (bf16*)(ws + WS_Q), 1024};
    sample_gemm<2>(C, XBS, 1024, 0, (const bf16*)(ws + W_XQ + (size_t)L * 1048576 * 2), 1024, 262144u, 1024, 32, 0, E);
}
__device__ __forceinline__ void s_xo(const Ctx& C, unsigned char* ws, int L) {
    EpiResidual E{nullptr, nullptr, (bf16*)(ws + WS_XB), SSP(3 * L + 2)};
    sample_gemm<2>(C, (const bf16*)(ws + WS_OX) + (size_t)MP * 1024, 1024, 0, (const bf16*)(ws + W_XO + (size_t)L * 1048576 * 2), 1024, 262144u, 1024, 32, 0, E);
}
__device__ __forceinline__ void s_fin(const Ctx& C, unsigned char* ws, int L) {
    EpiSwiGLU E{SSP(3 * L + 2), (bf16*)(ws + WS_HF)};
    sample_gemm<8>(C, XBS, 1024, 0, (const bf16*)(ws + W_FIN + (size_t)L * 1024 * 5632 * 2), 1024, 262144u, 1024, 22 * 8, 0, E);
}
__device__ __forceinline__ void s_fout(const Ctx& C, unsigned char* ws, int L) {
    EpiResidual E{nullptr, nullptr, (bf16*)(ws + WS_XB), SSP(3 * L + 3)};
    sample_gemm<1>(C, (const bf16*)(ws + WS_HF) + (size_t)MP * DFF, DFF, 0, (const bf16*)(ws + W_FOUT + (size_t)L * 2816 * 1024 * 2), DFF, 256u * DFF, DFF, 32, 0, E);
}
__device__ __forceinline__ void s_in1(const Ctx& C, const Args& args, unsigned char* ws) {
    EpiSwaQKV E{SSP(3), (const float*)(ws + T_CS), (const float*)(ws + T_SN), (bf16*)(ws + WS_Q), (bf16*)(ws + WS_KB), (float*)(ws + WS_SQ), args.out};
    sample_gemm<2>(C, XBS, 1024, 0, (const bf16*)(ws + W_SWA_QKV), 1024, 262144u, 1024, 48, 0, E);
}
__device__ __forceinline__ void s_swa(const Ctx& C, const Args& args, unsigned char* ws) {
    for (int u = C.G - 1 - C.vcu; u < 256; u += C.G) swa_sample_half(C, u, (const float*)(ws + WS_SQ), KIN(I_CSK), KIN(I_CSV), KIN(I_SINK), args.out, (bf16*)(ws + WS_OX));
}
__device__ __forceinline__ void s_out1(const Ctx& C, unsigned char* ws) {
    EpiResidual E{nullptr, nullptr, (bf16*)(ws + WS_XB), SSP(4)};
    sample_gemm<2>(C, (const bf16*)(ws + WS_OX) + (size_t)MP * 1024, 1024, 0, (const bf16*)(ws + W_SWA_O), 1024, 262144u, 1024, 32, 0, E);
}
__device__ __forceinline__ void s_in2(const Ctx& C, const Args& args, unsigned char* ws) {
    EpiConvIn E{SSP(6), (bf16*)(ws + WS_Q), (bf16*)(ws + WS_KB), args.out};
    sample_gemm<4>(C, XBS, 1024, 0, (const bf16*)(ws + W_CONV_IN), 1024, 262144u, 1024, 96, 0, E);
}
__device__ __forceinline__ void s_out2(const Ctx& C, unsigned char* ws) {
    EpiResidual E{nullptr, nullptr, (bf16*)(ws + WS_XB), SSP(7)};
    sample_gemm<2>(C, (const bf16*)(ws + WS_UB) + (size_t)MP * 1024, 1024, 0, (const bf16*)(ws + W_CONV_OUT), 1024, 262144u, 1024, 32, 0, E);
}
__device__ __forceinline__ void s_out3(const Ctx& C, unsigned char* ws) {
    EpiResidual E{nullptr, nullptr, (bf16*)(ws + WS_XB), SSP(10)};
    sample_gemm<2>(C, (const bf16*)(ws + WS_UB) + (size_t)MP * 1024, 1024, 256, (const bf16*)(ws + W_POOL), 256, 65536u, 256, 32, 0, E);
}
template <int L> struct XsSide { Ctx C; unsigned char* ws; int u0, n, s0, s1, s2;
    __device__ __forceinline__ void run(int un) const {
        if (un < 512) xs_sample_unit(C, un, (const bf16*)(ws + WS_Q), KIN(I_CMK) + (size_t)L * 128 * 256 * 1024, KIN(I_CMV) + (size_t)L * 128 * 256 * 1024, (bf16*)(ws + WS_OX), C.lds + EPIX_OFF); }
    __device__ __forceinline__ void operator()(int ui) const {
        if (ui == s0 && n > 0) run(u0);
        if (ui == s1 && n > 1) run(u0 + 1);
        if (ui == s2 && n > 2) run(u0 + 2);
    }
};

enum { PH_PRO = 0, PH_SIN0, PH_R_IN, PH_R_PU, PH_R_SCAN, PH_R_O, PH_R_NORM, PH_R_OUT, PH_C0,
       PH_S_QKV = PH_C0 + 6, PH_S_ATT, PH_S_OUT, PH_C1, PH_V_IN = PH_C1 + 6, PH_V_MIX, PH_V_OUT, PH_C2, PH_P_MIX = PH_C2 + 6, PH_P_OUT, PH_C3, PH_E1 = PH_C3 + 6, PH_E2, PH_FINAL, NPH };

struct KS { unsigned char* ws; float* out; int lo, hi, G, bx; };
#if MK_ONE_LAUNCH
#define IN(k) ((k) <= DBG_LAST)
#else
#define IN(k) (K.lo <= (k) && (k) < K.hi)
#endif
#define AMP_HOOK(k) do { if (AMP_MASK != 0ull) { if (blockIdx.x == 0) { if (threadIdx.x == 0) { LAS unsigned long long* tp = (LAS unsigned long long*)(C.lds + MISC_OFF + 64); \
        const unsigned long long now = __builtin_amdgcn_s_memrealtime(), prev = *tp; \
        if ((AMP_MASK >> (k)) & 1ull) { const unsigned long long target = now + AMP_FACTOR * (now - prev); while (__builtin_amdgcn_s_memrealtime() < target) __builtin_amdgcn_s_sleep(8); } \
        *tp = __builtin_amdgcn_s_memrealtime(); } __syncthreads(); } } } while (0)
#define SEAM(k) do { if (MK_ONE_LAUNCH && IN(k) && IN((k) + 1)) { xcd_barrier(bar); AMP_HOOK(k); } } while (0)
#define ROT(n) ((K.bx + (n)) % K.G)

template <int L, int BASE>
__device__ __forceinline__ void common_layer(const Ctx& C, const Args& args, const KS& K, const XcdBarrier& bar) {
    unsigned char* ws = K.ws; LAS unsigned char* ring = C.lds + RING_OFF; const int G = K.G;
    u64* SS = (u64*)(ws + WS_SS); float* xf = K.out; bf16* XB = (bf16*)(ws + WS_XB);
    if (IN(BASE + 0)) {
        Gemm g{XB, (const bf16*)(ws + WS_WQK + (size_t)L * 2 * 1048576 * 2), 1024, 1024, 1024};
        pg8::Sched<DecGridB> S{256, G, K.bx, DecGridB{DecGrid{64, 4, 0u, 262144u, 0u, 0u, 0u, 262144u}}};
        EpiSoftmaxR E{SS + (size_t)(3 * L + 1) * MT, (bf16*)(ws + WS_PX), (LAS float*)(C.lds + EPIX_OFF)};
        pg8::gemm_phase<EpiSoftmaxR, pg8::Sched<DecGridB>>(ring, g, S, E, C.wave);
        if constexpr (L == 0) s_xq(C, ws, 0);
        else if constexpr (L == 1) s_swa(C, args, ws);
        else if constexpr (L == 2) conv_mix_sample(C, args, ws);
        else pool_mix_sample(C, args, ws);
    }
    SEAM(BASE + 0);
    if (IN(BASE + 1)) {
        Gemm g{(const bf16*)(ws + WS_PX), (const bf16*)(ws + WS_VWO + (size_t)L * 2 * 1048576 * 2), 1024, 1024, 1024};
        pg8::Sched<DecGridB> S{256, G, K.bx, DecGridB{DecGrid{64, 4, 0u, 262144u, 0u, 0u, 0u, 262144u}}};
        EpiResidual E{nullptr, nullptr, XB, SS + (size_t)(3 * L + 2) * MT};
        pg8::gemm_phase<EpiResidual, pg8::Sched<DecGridB>>(ring, g, S, E, C.wave);
        if constexpr (L == 1) s_out1(C, ws); else if constexpr (L == 2) s_out2(C, ws); else if constexpr (L == 3) s_out3(C, ws);
    }
    SEAM(BASE + 1);
    if constexpr (L >= 1) {
        if (IN(BASE + 3)) s_xq(C, ws, L);
        SEAM(BASE + 3);
    }
    if (IN(BASE + 4)) {
        Gemm g{XB, (const bf16*)(ws + W_FIN + (size_t)L * 1024 * 5632 * 2), 1024, 1024, 1024};
        const bool six = (G == 256) && K.bx < 128; const int sl = K.bx & 1;
        const XsSide<L> side = (G == 256) ? (six ? XsSide<L>{C, ws, K.bx, 1, 1 + 2 * sl, -1, -1} : XsSide<L>{C, ws, 128 + 3 * (K.bx - 128), 3, sl, 2 + sl, 4})
                                           : XsSide<L>{C, ws, 0, 0, -1, -1, -1};
        pg8::Sched<DecGrid, XsSide<L>> S{64 * 22, G, K.bx, DecGrid{64, 22, 0u, 262144u, 0u, 0u, 0u, 262144u}, side};
        EpiSwiGLU E{SS + (size_t)(3 * L + 2) * MT, (bf16*)(ws + WS_HF)};
        pg8::gemm_phase<EpiSwiGLU, pg8::Sched<DecGrid, XsSide<L>>>(ring, g, S, E, C.wave);
        if (G != 256) for (int un = C.vcu; un < 512; un += G) S.side.run(un);
    }
    SEAM(BASE + 4);
    if (IN(BASE + 5)) {
        Gemm g{(const bf16*)(ws + WS_HF), (const bf16*)(ws + W_FOUT + (size_t)L * 2816 * 1024 * 2), DFF, DFF, DFF};
        pg8::Sched<DecGrid> S{256, G, K.bx, DecGrid{64, 4, 0u, 256u * DFF, 0u, 0u, 0u, 256u * DFF}};
        if constexpr (L == 3) {
            if (G == 256) {
                EpiResFinal E{XB, SS + (size_t)12 * MT, KIN(I_FNG), xf, (unsigned*)(ws + WS_PC), (unsigned*)(ws + WS_CTL) + 4096};
                pg8::gemm_phase<EpiResFinal, pg8::Sched<DecGrid>>(ring, g, S, E, C.wave);
            } else {
                EpiResidual E{nullptr, nullptr, XB, SS + (size_t)12 * MT};
                pg8::gemm_phase<EpiResidual, pg8::Sched<DecGrid>>(ring, g, S, E, C.wave);
            }
        } else {
            EpiResidual E{nullptr, nullptr, XB, SS + (size_t)(3 * L + 3) * MT};
            pg8::gemm_phase<EpiResidual, pg8::Sched<DecGrid>>(ring, g, S, E, C.wave);
        }
        s_xo(C, ws, L);
    }
    SEAM(BASE + 5);
}

__global__ void __launch_bounds__(512, 2) hybrid_fwd(Args args) {
    extern __shared__ __attribute__((aligned(16))) unsigned char lds_raw[];
    Ctx C; C.lds = (LAS unsigned char*)lds_raw; C.wave = __builtin_amdgcn_readfirstlane((int)threadIdx.x >> 6);
    C.G = gridDim.x; { const int bx = blockIdx.x; C.vcu = (C.G % 8 == 0) ? (bx % 8) * (C.G / 8) + bx / 8 : bx; }
    unsigned char* ws = args.ws;
    volatile LAS unsigned* MISC = (volatile LAS unsigned*)(C.lds + MISC_OFF);
    for (int u = threadIdx.x; u < (LDS_BYTES - LDSCTL_OFF) / 4; u += 512) ((LAS unsigned*)(C.lds + LDSCTL_OFF))[u] = 0u;
    __syncthreads();
    XcdBarrier bar; bar.bar = (unsigned*)(ws + WS_CTL) + 4096; bar.x = 0; bar.st = nullptr;
    if (MK_ONE_LAUNCH) bar = xcd_barrier_post((unsigned*)(ws + WS_CTL) + 4096, MISC + 8);
    if (AMP_MASK != 0ull && threadIdx.x == 0) *(LAS unsigned long long*)(C.lds + MISC_OFF + 64) = __builtin_amdgcn_s_memrealtime();
    KS K; K.ws = ws; K.out = args.out; K.lo = args.ph_lo; K.hi = args.ph_hi; K.G = C.G; K.bx = (int)blockIdx.x;
    const int G = C.G;
#define SS ((u64*)(ws + WS_SS))
#define ST ((u64*)(ws + WS_ST))
#define XB ((bf16*)(ws + WS_XB))
#define ring (C.lds + RING_OFF)
    const int NGT = G * 512;

    if (IN(PH_PRO)) {
        if (DBG_LAST < 1000) { const int gt0 = C.vcu * 512 + otid(); GAS u32x4* o4 = (GAS u32x4*)args.out; for (size_t e = gt0; e < O_END / 4; e += (size_t)NGT) o4[e] = (u32x4){0u, 0u, 0u, 0u}; }
        p0_prologue(C, args); }
    SEAM(PH_PRO);
    if (IN(PH_SIN0)) { s_in0(C, ws); }
    SEAM(PH_SIN0);

    if (IN(PH_R_IN)) {
        {
            Gemm g{XB, (const bf16*)(ws + W_RET_IN), 1024, 1024, 1024};
            pg8::Sched<DecGrid, RetSide> S{1024, G, K.bx, DecGrid{64, 16, 0u, 262144u, 0u, 0u, 0u, 262144u}, RetSide{C, ws, args.out, K.bx & 3, C.vcu}};
            EpiRetIn E{SS, (const float*)(ws + T_CR), (const float*)(ws + T_SR), (bf16*)(ws + WS_Q), (bf16*)(ws + WS_KB), (bf16*)(ws + WS_APQ), (bf16*)(ws + WS_G), (float*)(ws + WS_SQ)};
            pg8::gemm_phase<EpiRetIn, pg8::Sched<DecGrid, RetSide>>(ring, g, S, E, C.wave);
        }
        {
            Gemm g{(const bf16*)(ws + W_RET_IN), XB, 1024, 1024, 1024};
            pg8::Sched<DecGrid> S{256, G, K.bx, DecGrid{4, 64, 1024u * 1024u, 262144u, 0u, 0u, 0u, 262144u}};
            EpiRetKT E{SS, (const float*)(ws + T_CRT), (const float*)(ws + T_SRT), (bf16*)(ws + WS_KT)};
            pg8::gemm_phase<EpiRetKT, pg8::Sched<DecGrid>>(ring, g, S, E, C.wave);
        }
        {
            Gemm g{(const bf16*)(ws + W_RET_IN), XB, 1024, 1024, 1024};
            pg8::Sched<DecGrid, RetSide> S{512, G, K.bx, DecGrid{8, 64, 4096u * 1024u, 262144u, 0u, 0u, 0u, 262144u}, RetSide{C, ws, args.out, (K.bx >> 2) & 1, C.vcu + G}};
            EpiRetVT E{SS, (bf16*)(ws + WS_VS)};
            pg8::gemm_phase<EpiRetVT, pg8::Sched<DecGrid, RetSide>>(ring, g, S, E, C.wave);
            for (int un = C.vcu + 2 * G; un < 512; un += G) s_ret(C, ws, args.out, un);
        }
    }
    SEAM(PH_R_IN);
    if (IN(PH_R_PU)) {
        {
            Gemm g{(const bf16*)(ws + WS_Q), (const bf16*)(ws + WS_KB), 1024, 1024, 256};
            pg8::Sched<DecGrid> S{256, G, K.bx, DecGrid{64, 4, 0u, 262144u, 256u, 0u, 262144u, 256u}};
            EpiP E{(bf16*)(ws + WS_APQ)};
            pg8::gemm_phase<EpiP, pg8::Sched<DecGrid>>(ring, g, S, E, C.wave);
        }
        {
            Gemm g{(const bf16*)(ws + WS_VS), (const bf16*)(ws + WS_KT), 512, 512, 256};
            pg8::Sched<DecU> S{512, G, K.bx, DecU{}};
            EpiU E{(bf16*)(ws + WS_U)};
            pg8::gemm_phase<EpiU, pg8::Sched<DecU>>(ring, g, S, E, C.wave);
        }
    }
    SEAM(PH_R_PU);
    if (IN(PH_R_SCAN)) {
        if (K.bx < 64 && G > 64) {
        {
            Gemm g{(const bf16*)(ws + WS_MEMN), (const bf16*)(ws + W_XKV), 1024, 1024, 1024};
            pg8::Sched<DecMem> S{64, G, K.bx, DecMem{}};
            EpiMemKV E{args.out, (bf16*)(ws + WS_MK), (bf16*)(ws + WS_MV)};
            pg8::gemm_phase<EpiMemKV, pg8::Sched<DecMem>>(ring, g, S, E, C.wave);
        }
        pool_state_copy(C, 2 * K.bx, KIN(I_SPOOL), args.out); pool_state_copy(C, 2 * K.bx + 1, KIN(I_SPOOL), args.out);
        } else {
        const bf16* U = (const bf16*)(ws + WS_U); bf16* VS = (bf16*)(ws + WS_VS); const int nsc = (G > 64) ? G - 64 : G, gt = ((G > 64) ? K.bx - 64 : K.bx) * 512 + otid(), NGT2 = nsc * 512;
        for (int item = gt; item < 131072; item += NGT2) { const int d8 = item & 31, v = (item >> 5) & 511, bh = item >> 14, h = bh & 3;
            const float gC = __builtin_amdgcn_exp2f(256.f * lg2g(h)); f32x4 s0 = (f32x4){0.f, 0.f, 0.f, 0.f}, s1 = s0;
            for (int c0 = 0; c0 < 32; c0 += 8) { u32x4 uu[8];
#pragma unroll
                for (int k = 0; k < 8; ++k) uu[k] = *(const u32x4*)(U + ((size_t)(bh * 32 + c0 + k) * 512 + v) * 256 + 8 * d8);
#pragma unroll
                for (int k = 0; k < 8; ++k) { *(u32x4*)(VS + ((size_t)(bh * 32 + c0 + k) * 512 + v) * 512 + 256 + 8 * d8) = pack8(s0, s1);
                    s0 = s0 * gC + (f32x4){bflo(uu[k].x), bfhi(uu[k].x), bflo(uu[k].y), bfhi(uu[k].y)}; s1 = s1 * gC + (f32x4){bflo(uu[k].z), bfhi(uu[k].z), bflo(uu[k].w), bfhi(uu[k].w)}; } }
#pragma unroll
            for (int e = 0; e < 4; ++e) { args.out[O_RETP + ((size_t)bh * 256 + 8 * d8 + e) * 512 + v] = s0[e]; args.out[O_RETP + ((size_t)bh * 256 + 8 * d8 + 4 + e) * 512 + v] = s1[e]; } }
        if (G <= 64) for (int b = K.bx; b < 128; b += G) pool_state_copy(C, b, KIN(I_SPOOL), args.out);
        }
    }
    SEAM(PH_R_SCAN);
    if (IN(PH_R_O)) {
        Gemm g{(const bf16*)(ws + WS_APQ), (const bf16*)(ws + WS_VS), 512, 512, 512};
        pg8::Sched<DecO> S{512, G, K.bx, DecO{}};
        if (G == 256) {
            EpiONorm E{(const bf16*)(ws + WS_G), (bf16*)(ws + WS_UB), ST, (unsigned*)(ws + WS_PC2), (unsigned*)(ws + WS_CTL) + 4096};
            pg8::gemm_phase<EpiONorm, pg8::Sched<DecO>>(ring, g, S, E, C.wave);
        } else {
            EpiO E{(bf16*)(ws + WS_O), ST};
            pg8::gemm_phase<EpiO, pg8::Sched<DecO>>(ring, g, S, E, C.wave);
        }
        {
            Gemm g2{(const bf16*)ws, (const bf16*)ws, 1024, 1024, 256};
            pg8::Sched<DecAbs> S2{256, G, K.bx, DecAbs{}};
            EpiAbs E2{(bf16*)(ws + WS_WQK)};
            pg8::gemm_phase<EpiAbs, pg8::Sched<DecAbs>>(ring, g2, S2, E2, C.wave);
        }
    }
    if (G != 256) SEAM(PH_R_O);
    if (IN(PH_R_NORM) && G != 256) {
        const bf16* O = (const bf16*)(ws + WS_O); const bf16* Gt = (const bf16*)(ws + WS_G); bf16* UB = (bf16*)(ws + WS_UB); const int lane_ = otid() & 63;
        const int gw = C.vcu * 8 + C.wave, NGW = G * 8;
        for (int row = gw; row < MP; row += NGW) { u32x4 ov[4], gv[4]; u64 st[8];
#pragma unroll
            for (int h = 0; h < 4; ++h) { const size_t o = (size_t)row * 2048 + h * 512 + 8 * lane_; ov[h] = *(const u32x4*)(O + o); gv[h] = *(const u32x4*)(Gt + o); st[2 * h] = ST[(size_t)row * 8 + 2 * h]; st[2 * h + 1] = ST[(size_t)row * 8 + 2 * h + 1]; }
#pragma unroll
            for (int h = 0; h < 4; ++h) { const float mu = from_fx(st[2 * h]) * (1.f / 512.f); const float var = fmaxf(from_fx(st[2 * h + 1]) * (1.f / 512.f) - mu * mu, 0.f);
                const float rstd = __builtin_amdgcn_rsqf(var + EPS); u32x4 r;
#pragma unroll
                for (int k = 0; k < 4; ++k) r[k] = cvt_pk_bf16(bflo(gv[h][k]) * (bflo(ov[h][k]) - mu) * rstd, bfhi(gv[h][k]) * (bfhi(ov[h][k]) - mu) * rstd);
                *(u32x4*)(UB + (size_t)row * 2048 + h * 512 + 8 * lane_) = r; } }
    }
    SEAM(PH_R_NORM);
    if (IN(PH_R_OUT)) {
        Gemm g{(const bf16*)(ws + WS_UB), (const bf16*)(ws + W_RET_OUT), 2048, 2048, 2048};
        pg8::Sched<DecGrid> S{256, G, K.bx, DecGrid{64, 4, 0u, 256u * 2048u, 0u, 0u, 0u, 256u * 2048u}};
        EpiResidual E{nullptr, nullptr, XB, SS + (size_t)1 * MT};
        pg8::gemm_phase<EpiResidual, pg8::Sched<DecGrid>>(ring, g, S, E, C.wave);
        s_out0(C, args, ws);
    }
    SEAM(PH_R_OUT);
    common_layer<0, PH_C0>(C, args, K, bar);

    if (IN(PH_S_QKV)) {
        {
            Gemm g{XB, (const bf16*)(ws + W_SWA_QKV), 1024, 1024, 1024};
            pg8::Sched<DecGrid> S{384, G, K.bx, DecGrid{64, 6, 0u, 262144u, 0u, 0u, 0u, 262144u}};
            EpiSwaQKV E{SS + (size_t)3 * MT, (const float*)(ws + T_CS), (const float*)(ws + T_SN), (bf16*)(ws + WS_Q), (bf16*)(ws + WS_KB), (float*)(ws + WS_SQ), args.out};
            pg8::gemm_phase<EpiSwaQKV, pg8::Sched<DecGrid>>(ring, g, S, E, C.wave);
        }
        {
            Gemm g{(const bf16*)(ws + W_SWA_QKV), XB, 1024, 1024, 1024};
            pg8::Sched<DecGrid> S{64, G, ROT(128), DecGrid{1, 64, 1280u * 1024u, 0u, 0u, 0u, 0u, 262144u}};
            EpiSwaVT E{SS + (size_t)3 * MT, (bf16*)(ws + WS_KT)};
            pg8::gemm_phase<EpiSwaVT, pg8::Sched<DecGrid>>(ring, g, S, E, C.wave);
        }
        if (G == 256) { if (K.bx >= 192) { swa_state_copy(C, (K.bx - 192) * 2, KIN(I_CSK), KIN(I_CSV), args.out); swa_state_copy(C, (K.bx - 192) * 2 + 1, KIN(I_CSK), KIN(I_CSV), args.out); } }
        else for (int b = C.vcu; b < 128; b += G) swa_state_copy(C, b, KIN(I_CSK), KIN(I_CSV), args.out);
        s_fin(C, ws, 0);
    }
    SEAM(PH_S_QKV);
    if (IN(PH_S_ATT)) {
        for (int un = C.vcu; un < 512; un += G) swa_unit(C, un, (const bf16*)(ws + WS_Q), (const bf16*)(ws + WS_KB), (const bf16*)(ws + WS_KT), KIN(I_SINK), (bf16*)(ws + WS_OX));
        s_fout(C, ws, 0);
    }
    SEAM(PH_S_ATT);
    if (IN(PH_S_OUT)) {
        Gemm g{(const bf16*)(ws + WS_OX), (const bf16*)(ws + W_SWA_O), 1024, 1024, 1024};
        pg8::Sched<DecGrid> S{256, G, K.bx, DecGrid{64, 4, 0u, 262144u, 0u, 0u, 0u, 262144u}};
        EpiResidual E{nullptr, nullptr, XB, SS + (size_t)4 * MT};
        pg8::gemm_phase<EpiResidual, pg8::Sched<DecGrid>>(ring, g, S, E, C.wave);
        s_in1(C, args, ws);
    }
    SEAM(PH_S_OUT);
    common_layer<1, PH_C1>(C, args, K, bar);

    if (IN(PH_V_IN)) {
        Gemm g{XB, (const bf16*)(ws + W_CONV_IN), 1024, 1024, 1024};
        pg8::Sched<DecGrid> S{768, G, K.bx, DecGrid{64, 12, 0u, 262144u, 0u, 0u, 0u, 262144u}};
        EpiConvIn E{SS + (size_t)6 * MT, (bf16*)(ws + WS_Q), (bf16*)(ws + WS_KB), args.out};
        pg8::gemm_phase<EpiConvIn, pg8::Sched<DecGrid>>(ring, g, S, E, C.wave);
        s_fin(C, ws, 1);
    }
    SEAM(PH_V_IN);
    if (IN(PH_V_MIX)) { conv_mix_runs(C, ws); s_fout(C, ws, 1); }
    SEAM(PH_V_MIX);
    if (IN(PH_V_OUT)) {
        Gemm g{(const bf16*)(ws + WS_UB), (const bf16*)(ws + W_CONV_OUT), 1024, 1024, 1024};
        pg8::Sched<DecGrid> S{256, G, K.bx, DecGrid{64, 4, 0u, 262144u, 0u, 0u, 0u, 262144u}};
        EpiResidual E{nullptr, nullptr, XB, SS + (size_t)7 * MT};
        pg8::gemm_phase<EpiResidual, pg8::Sched<DecGrid>>(ring, g, S, E, C.wave);
        s_in2(C, args, ws);
    }
    SEAM(PH_V_OUT);
    common_layer<2, PH_C2>(C, args, K, bar);

    if (IN(PH_P_MIX)) { pool_mix_runs(C, ws, args.out); s_fin(C, ws, 2); }
    SEAM(PH_P_MIX);
    if (IN(PH_P_OUT)) {
        Gemm g{(const bf16*)(ws + WS_UB), (const bf16*)(ws + W_POOL), 1024, 256, 256};
        pg8::Sched<DecGrid> S{256, G, K.bx, DecGrid{64, 4, 0u, 262144u, 256u, 0u, 0u, 65536u}};
        EpiResidual E{nullptr, nullptr, XB, SS + (size_t)10 * MT};
        pg8::gemm_phase<EpiResidual, pg8::Sched<DecGrid>>(ring, g, S, E, C.wave);
        s_fout(C, ws, 2);
    }
    SEAM(PH_P_OUT);
    common_layer<3, PH_C3>(C, args, K, bar);

    if (IN(PH_E1)) { if (G != 256) final_rows(C, args, ws, 0, MP); s_fin(C, ws, 3); }
    SEAM(PH_E1);
    if (IN(PH_E2)) { s_fout(C, ws, 3); }
    SEAM(PH_E2);
    if (IN(PH_FINAL)) {
        final_rows(C, args, ws, MP, MREAL);
        if (AMP_MASK != 0ull && MK_ONE_LAUNCH) { xcd_barrier(bar); AMP_HOOK(PH_FINAL); }
    }
}
#undef IN
#undef SEAM

extern "C" void kernel_launch(void* const* d_in, const int* in_sizes, int n_in, void* d_out, int out_size, void* d_ws, size_t ws_size, hipStream_t stream) {
    static int grid = 0;
    if (grid == 0) {
        if (n_in != 28 || (size_t)out_size != O_END || ws_size < WS_END) { fprintf(stderr, "kernel_launch: unexpected shapes (n_in %d out %d ws %zu need %zu)\n", n_in, out_size, ws_size, (size_t)WS_END); grid = -1; return; }
        int dev = 0, cus = 0, per_cu = 0;
        if (hipGetDevice(&dev) != hipSuccess || hipDeviceGetAttribute(&cus, hipDeviceAttributeMultiprocessorCount, dev) != hipSuccess) { grid = -1; return; }
        if (hipFuncSetAttribute((const void*)hybrid_fwd, hipFuncAttributeMaxDynamicSharedMemorySize, LDS_BYTES) != hipSuccess) { fprintf(stderr, "kernel_launch: hipFuncSetAttribute failed\n"); grid = -1; return; }
        if (hipOccupancyMaxActiveBlocksPerMultiprocessor(&per_cu, (const void*)hybrid_fwd, 512, LDS_BYTES) != hipSuccess || per_cu < 1) fprintf(stderr, "kernel_launch: occupancy query reports %d\n", per_cu);
        (void)hipGetLastError();
        grid = cus;
    }
    if (grid < 0) return;
    if (hipMemsetAsync((char*)d_ws, 0, 65536, stream) != hipSuccess) { fprintf(stderr, "kernel_launch: memset failed\n"); return; }
    Args a{};
    for (int i = 0; i < 28; ++i) a.in[i] = (const float*)d_in[i];
    a.out = (float*)d_out; a.ws = (unsigned char*)d_ws;
#if MK_ONE_LAUNCH
    a.ph_lo = 0; a.ph_hi = (DBG_LAST < 1000) ? DBG_LAST + 1 : NPH;
    hipLaunchKernelGGL(hybrid_fwd, dim3(grid), dim3(512), LDS_BYTES, stream, a);
#else
    for (int p = 0; p < NPH; ++p) { a.ph_lo = p; a.ph_hi = p + 1; hipLaunchKernelGGL(hybrid_fwd, dim3(grid), dim3(512), LDS_BYTES, stream, a); }
#endif
    const hipError_t le = hipPeekAtLastError();
    if (le != hipSuccess) fprintf(stderr, "kernel_launch: launch failed: %s\n", hipGetErrorName(le));
}
```

```cpp
#include <hip/hip_runtime.h>
#include <cstdio>
#include <cstdint>

#ifndef MK_ONE_LAUNCH
#define MK_ONE_LAUNCH 1
#endif

#ifndef DBG_LAST
#define DBG_LAST 1000
#endif
#ifndef AMP_MASK
#define AMP_MASK 0ull
#endif
#define AMP_FACTOR 9ull
#define GAS __attribute__((address_space(1)))
#define LAS __attribute__((address_space(3)))
typedef unsigned short bf16;
typedef short bf16x8 __attribute__((ext_vector_type(8)));
typedef float f32x4 __attribute__((ext_vector_type(4)));
typedef float f32x2 __attribute__((ext_vector_type(2)));
typedef unsigned u32x4 __attribute__((ext_vector_type(4)));
typedef unsigned u32x2 __attribute__((ext_vector_type(2)));

constexpr int D = 1024, TP = 8192, MP = 2 * TP, NSMP = 128, MREAL = MP + NSMP, MT = MP + 256, NPAN = MT / 256;
constexpr int DFF = 2816;
constexpr float EPS = 1e-6f;
constexpr float LOG2E = 1.4426950408889634f;
__device__ __forceinline__ float lg2g(int h) { return h == 0 ? -0.04580368961312479f : h == 1 ? -0.02272007650008353f : h == 2 ? -0.011315313227834146f : -0.005646563141142063f; }

constexpr size_t O_Y = 0, O_YS = 16777216, O_RETP = O_YS + 131072, O_RETS = O_RETP + 1048576, O_SWKP = O_RETS + 67108864, O_SWVP = O_SWKP + 65536,
                 O_SWKS = O_SWVP + 65536, O_SWVS = O_SWKS + 4194304, O_CONVP = O_SWVS + 4194304, O_CONVS = O_CONVP + 4096, O_POOLP = O_CONVS + 262144,
                 O_POOLS = O_POOLP + 30720, O_MEMK = O_POOLS + 1966080, O_MEMV = O_MEMK + 2097152, O_END = O_MEMV + 2097152;

constexpr size_t al256(size_t x) { return (x + 255) & ~(size_t)255; }
constexpr size_t WS_CTL = 0;
constexpr size_t WS_PC = 32768;
constexpr size_t WS_PC2 = 36864;
constexpr size_t WS_SS = 1u << 20;
constexpr size_t WS_ST = WS_SS + al256((size_t)13 * MT * 8);
constexpr size_t ZERO_BYTES = al256(WS_ST + (size_t)MT * 8 * 8);
static_assert(ZERO_BYTES <= (4u << 20), "control region");
constexpr size_t WS_W = 4u << 20;
constexpr size_t W_RET_IN = WS_W, W_RET_OUT = W_RET_IN + (size_t)6144 * 1024 * 2, W_SWA_QKV = W_RET_OUT + (size_t)1024 * 2048 * 2,
                 W_SWA_O = W_SWA_QKV + (size_t)1536 * 1024 * 2, W_CONV_IN = W_SWA_O + (size_t)1024 * 1024 * 2, W_CONV_OUT = W_CONV_IN + (size_t)3072 * 1024 * 2,
                 W_POOL = W_CONV_OUT + (size_t)1024 * 1024 * 2, W_XQ = W_POOL + (size_t)4 * 256 * 256 * 2, W_XKV = W_XQ + (size_t)4 * 1024 * 1024 * 2,
                 W_XO = W_XKV + (size_t)4 * 2048 * 1024 * 2, W_FIN = W_XO + (size_t)4 * 1024 * 1024 * 2, W_FOUT = W_FIN + (size_t)4 * 5632 * 1024 * 2,
                 W_END = W_FOUT + (size_t)4 * 1024 * 2816 * 2;
constexpr size_t WS_TAB = al256(W_END);
constexpr size_t T_CR = WS_TAB, T_SR = T_CR + (size_t)8193 * 128 * 4, T_CRT = al256(T_SR + (size_t)8193 * 128 * 4), T_SRT = T_CRT + (size_t)128 * 8192 * 4,
                 T_CS = T_SRT + (size_t)128 * 8192 * 4, T_SN = al256(T_CS + (size_t)8193 * 8 * 4), T_END = al256(T_SN + (size_t)8193 * 8 * 4);
constexpr size_t WS_MEMN = T_END;
constexpr size_t WS_MK = WS_MEMN + (size_t)4 * 512 * 1024 * 2;
constexpr size_t WS_MVT = WS_MK + (size_t)4 * 512 * 1024 * 2;
constexpr size_t WS_XB = WS_MVT + (size_t)4 * 2 * 1024 * 1024 * 2;
constexpr size_t WS_Q = WS_XB + (size_t)MT * 1024 * 2;
constexpr size_t WS_KB = WS_Q + (size_t)MT * 1024 * 2;
constexpr size_t WS_G = WS_KB + (size_t)MT * 1024 * 2;
constexpr size_t WS_KT = WS_G + (size_t)MT * 2048 * 2;
constexpr size_t WS_VS = WS_KT + (size_t)256 * 256 * 512 * 2;
constexpr size_t WS_APQ = WS_VS + (size_t)256 * 512 * 512 * 2;
constexpr size_t WS_U = WS_APQ + (size_t)256 * 256 * 512 * 2;
constexpr size_t WS_O = WS_U + (size_t)256 * 512 * 256 * 4;
constexpr size_t WS_UB = WS_O + (size_t)MT * 2048 * 2;
constexpr size_t WS_PX = WS_UB + (size_t)MT * 2048 * 2;
constexpr size_t WS_OX = WS_PX + (size_t)MT * 1024 * 2;
constexpr size_t WS_HF = WS_OX + (size_t)MT * 1024 * 2;
constexpr size_t WS_SQ = WS_HF + (size_t)MT * 2816 * 2;
constexpr size_t W_XQN = WS_SQ + (size_t)128 * 4096 * 4;
constexpr size_t WS_WQK = W_XQN + (size_t)4 * 1024 * 1024 * 2;
constexpr size_t WS_VWO = WS_WQK + (size_t)8 * 1024 * 1024 * 2;
constexpr size_t WS_MV = WS_MVT;
constexpr size_t WS_END = WS_VWO + (size_t)8 * 1024 * 1024 * 2;

constexpr int RING_OFF = 0, RING_BYTES = 131072;
constexpr int EPIX_OFF = RING_BYTES;
constexpr int LDSCTL_OFF = EPIX_OFF + 16384, MISC_OFF = LDSCTL_OFF + 64;
constexpr int LDS_BYTES = LDSCTL_OFF + 256;

#define LDS_WAIT() asm volatile("s_waitcnt lgkmcnt(0)" ::: "memory")
#define VM_WAIT() asm volatile("s_waitcnt vmcnt(0)" ::: "memory")
__device__ __forceinline__ unsigned cvt_pk_bf16(float lo, float hi) { unsigned r; asm volatile("v_cvt_pk_bf16_f32 %0, %1, %2" : "=v"(r) : "v"(lo), "v"(hi)); return r; }
__device__ __forceinline__ u32x4 pack8(f32x4 a, f32x4 b) { u32x4 w; w.x = cvt_pk_bf16(a[0], a[1]); w.y = cvt_pk_bf16(a[2], a[3]); w.z = cvt_pk_bf16(b[0], b[1]); w.w = cvt_pk_bf16(b[2], b[3]); return w; }
__device__ __forceinline__ f32x4 ld4(const float* p) { return *(const f32x4*)p; }
__device__ __forceinline__ void st4(float* p, f32x4 v) { *(f32x4*)p = v; }
__device__ __forceinline__ float bf2f(unsigned short b) { return __builtin_bit_cast(float, (unsigned)b << 16); }
__device__ __forceinline__ float bflo(unsigned w) { return __builtin_bit_cast(float, w << 16); }
__device__ __forceinline__ float bfhi(unsigned w) { return __builtin_bit_cast(float, w & 0xffff0000u); }
__device__ __forceinline__ float siluf(float x) { return x * __builtin_amdgcn_rcpf(1.f + __builtin_amdgcn_exp2f(-x * LOG2E)); }
typedef unsigned long long u64;
__device__ __forceinline__ u64 to_fx(float v) { return (u64)(long long)((double)v * 65536.0); }
__device__ __forceinline__ float from_fx(u64 v) { return (float)((double)(long long)v * (1.0 / 65536.0)); }
__device__ __forceinline__ void fx_add(u64* p, float v) { __hip_atomic_fetch_add(p, to_fx(v), __ATOMIC_RELAXED, __HIP_MEMORY_SCOPE_AGENT); }
__device__ __forceinline__ float rstd_of(u64 ss) { return __builtin_amdgcn_rsqf(from_fx(ss) * (1.f / 1024.f) + EPS); }
__device__ __forceinline__ float wave_sum(float v) {
#pragma unroll
    for (int o = 1; o < 64; o <<= 1) v += __shfl_xor(v, o);
    return v;
}
__device__ __forceinline__ float wave_max(float v) {
#pragma unroll
    for (int o = 1; o < 64; o <<= 1) v = fmaxf(v, __shfl_xor(v, o));
    return v;
}

namespace pg8 {
typedef unsigned short bf16_t;
constexpr int BM = 256, BK = 64, HALF = 128, HTB = HALF * BK * 2, STAGE_BYTES = 8 * HTB;
__host__ __device__ __forceinline__ int lds_byte(int r, int c) { const int st = (r >> 4) * 2 + (c >> 5), rr = r & 15, cc = c & 31, ob = rr * 64 + cc * 2; return st * 1024 + (ob ^ (((ob >> 9) & 1) << 5)); }
__host__ __device__ __forceinline__ void stage_rc(int b, int& R, int& C) { const int st = b / 1024, sb = b % 1024, swz = sb ^ (((sb >> 9) & 1) << 5); R = (st >> 1) * 16 + swz / 64; C = (st & 1) * 32 + (swz % 64) / 2; }
__host__ __device__ __forceinline__ int perm32(int rho) { const int n = rho >> 4, i = rho & 15; return 8 * (i >> 2) + 4 * n + (i & 3); }

struct Unit { int pm, pn; unsigned ao, bo; };
struct Gemm { const bf16_t* A; const bf16_t* Bt; int lda, ldb, K; };

struct NoSide { __device__ __forceinline__ void operator()(int) const {} };
template <class Dec, class Side = NoSide> struct Sched {
    int nwg, G, c; Dec d; Side side;
    __device__ __forceinline__ bool next(int i, Unit& u) const { const long L = (long)i * G + c; if (L >= nwg) return false; d((int)L, u); return true; }
    __device__ __forceinline__ void a_ready(const Unit&) const {}
    __device__ __forceinline__ void done(const Unit&, int ui) const { side(ui); }
};
struct DecGrid {
    int nM, nN; unsigned a0, am, an, b0, bm, bn;
    __device__ __forceinline__ void operator()(int L, Unit& u) const {
        const int nwg = nM * nN; int wgid = L; { const int q = nwg / 8, r = nwg % 8, xcd = wgid % 8, off = wgid / 8; wgid = (xcd < r ? xcd * (q + 1) : r * (q + 1) + (xcd - r) * q) + off; }
        const int nig = 8 * nN, gid = wgid / nig, fm = gid * 8, gsz = (nM - fm) < 8 ? (nM - fm) : 8;
        u.pm = fm + ((wgid % nig) % gsz); u.pn = (wgid % nig) / gsz;
        u.ao = a0 + (unsigned)u.pm * am + (unsigned)u.pn * an; u.bo = b0 + (unsigned)u.pm * bm + (unsigned)u.pn * bn;
    }
};

typedef f32x4 Acc[2][2][4][2];

template <class Epi, class SchedT, bool ALIGN_EPI = true, bool SP2 = true>
__device__ __forceinline__ void gemm_phase(LAS unsigned char* lds, const Gemm g, const SchedT& S, const Epi& E, const int wid) {
    static_assert(SP2, "only the SP2 loop is kept");
    int lane; asm volatile("v_mbcnt_lo_u32_b32 %0, -1, 0\n\tv_mbcnt_hi_u32_b32 %0, -1, %0" : "=v"(lane));
    const int tid = wid * 64 + lane, wr = wid >> 2, wc = wid & 3, fr = lane & 15, fq = lane >> 4;
    const int K = g.K, nt = K / BK;
    unsigned voffA[2], voffB[2];
#pragma unroll
    for (int i = 0; i < 2; ++i) { int R, C; stage_rc(tid * 16 + i * 8192, R, C); const int Rb = Epi::PERM ? ((R & ~31) + perm32(R & 31)) : R;
        voffA[i] = (unsigned)(R * g.lda + C) * 2u; voffB[i] = (unsigned)(Rb * g.ldb + C) * 2u; }
    const size_t kstep = (size_t)(BK * 2);
    const size_t hstepA = (size_t)HALF * g.lda * 2, hstepB = (size_t)HALF * g.ldb * 2;
    const unsigned ldsw = (unsigned)wid * 1024u;
    const int aoff = lds_byte(wr * 64 + fr, fq * 8), boff = lds_byte(wc * 32 + fr, fq * 8);
#define PG8_SA(b, h) (((b) * 2 + (h)) * HTB)
#define PG8_SB(b, h) ((4 + (b) * 2 + (h)) * HTB)
#define PG8_STAGE(bufoff, gbase, voff) do { _Pragma("unroll") for (int _i = 0; _i < 2; ++_i) \
        __builtin_amdgcn_global_load_lds((const unsigned*)((const char*)(gbase) + (voff)[_i]), (LAS unsigned*)(lds + (bufoff) + ldsw + _i * 8192), 16, 0, 0); } while (0)
#define PG8_LDA(dst, b, h) do { _Pragma("unroll") for (int m = 0; m < 4; ++m) _Pragma("unroll") for (int k = 0; k < 2; ++k) dst[m][k] = *(const LAS bf16x8*)(lds + PG8_SA(b, h) + aoff + m * 2048 + k * 1024); } while (0)
#define PG8_LDB(dst, b, h) do { _Pragma("unroll") for (int n = 0; n < 2; ++n) _Pragma("unroll") for (int k = 0; k < 2; ++k) dst[n][k] = *(const LAS bf16x8*)(lds + PG8_SB(b, h) + boff + n * 2048 + k * 1024); } while (0)
#define PG8_MMA(ai, bj, At, Bt) do { __builtin_amdgcn_s_setprio(1); _Pragma("unroll") for (int m = 0; m < 4; ++m) _Pragma("unroll") for (int n = 0; n < 2; ++n) _Pragma("unroll") for (int k = 0; k < 2; ++k) \
        acc[ai][bj][m][n] = __builtin_amdgcn_mfma_f32_16x16x32_bf16(Bt[n][k], At[m][k], acc[ai][bj][m][n], 0, 0, 0); __builtin_amdgcn_s_setprio(0); } while (0)
#define PG8_WAIT_V(n) asm volatile("s_waitcnt vmcnt(" #n ")" ::: "memory")
#define PG8_WAIT_L(n) asm volatile("s_waitcnt lgkmcnt(" #n ")" ::: "memory")
#define PG8_BAR __builtin_amdgcn_s_barrier()
#define PG8_SCHED __builtin_amdgcn_sched_barrier(0)
    Unit cur, nxt; int ui = 0;
    if (!S.next(0, cur)) return;
    f32x4 acc[2][2][4][2];
#pragma unroll
    for (int a = 0; a < 2; ++a)
#pragma unroll
        for (int b = 0; b < 2; ++b)
#pragma unroll
            for (int m = 0; m < 4; ++m)
#pragma unroll
                for (int n = 0; n < 2; ++n) acc[a][b][m][n] = (f32x4){0.f, 0.f, 0.f, 0.f};
    bf16x8 At[4][2], B0[2][2], B1[2][2];
    const char* cA = (const char*)g.A + (size_t)cur.ao * 2; const char* cB = (const char*)g.Bt + (size_t)cur.bo * 2;
    S.a_ready(cur);
    PG8_STAGE(PG8_SB(0, 0), cB, voffB); PG8_STAGE(PG8_SB(0, 1), cB + hstepB, voffB); PG8_STAGE(PG8_SA(0, 0), cA, voffA); PG8_STAGE(PG8_SA(0, 1), cA + hstepA, voffA);
    if (wr == 1) PG8_BAR;
    PG8_WAIT_V(2); PG8_BAR;
    PG8_STAGE(PG8_SB(1, 0), cB + kstep, voffB); PG8_STAGE(PG8_SA(1, 0), cA + kstep, voffA); PG8_STAGE(PG8_SB(1, 1), cB + hstepB + kstep, voffB);
    PG8_WAIT_V(6); PG8_BAR;
    for (;;) {
        const bool has_next = S.next(ui + 1, nxt);
        const char* nA = has_next ? (const char*)g.A + (size_t)nxt.ao * 2 : cA; const char* nB = has_next ? (const char*)g.Bt + (size_t)nxt.bo * 2 : cB;
        for (int t = 0; t < nt; t += 2) {
            const bool last = (t == nt - 2);
            const char* a1 = cA + (size_t)(t + 1) * kstep;
            const char* a2 = last ? nA : cA + (size_t)(t + 2) * kstep; const char* b2 = last ? nB : cB + (size_t)(t + 2) * kstep;
            const char* a3 = a2 + kstep; const char* b3 = b2 + kstep;
            if (last && has_next) S.a_ready(nxt);
            PG8_LDB(B0, 0, 0); PG8_LDB(B1, 0, 1); PG8_SCHED; PG8_LDA(At, 0, 0); PG8_STAGE(PG8_SA(1, 1), a1 + hstepA, voffA);
            PG8_WAIT_V(8); PG8_WAIT_L(0); PG8_BAR; PG8_MMA(0, 0, At, B0); PG8_MMA(0, 1, At, B1); PG8_BAR; PG8_SCHED;
            PG8_LDA(At, 0, 1); PG8_STAGE(PG8_SB(0, 0), b2, voffB); PG8_STAGE(PG8_SB(0, 1), b2 + hstepB, voffB); PG8_STAGE(PG8_SA(0, 0), a2, voffA);
            PG8_WAIT_V(8); PG8_WAIT_L(0); PG8_BAR; PG8_MMA(1, 0, At, B0); PG8_MMA(1, 1, At, B1); PG8_BAR; PG8_SCHED;
            PG8_LDB(B0, 1, 0); PG8_LDB(B1, 1, 1); PG8_SCHED; PG8_LDA(At, 1, 0); PG8_STAGE(PG8_SA(0, 1), a2 + hstepA, voffA);
            PG8_WAIT_V(8); PG8_WAIT_L(0); PG8_BAR; PG8_MMA(0, 0, At, B0); PG8_MMA(0, 1, At, B1); PG8_BAR; PG8_SCHED;
            PG8_LDA(At, 1, 1); PG8_STAGE(PG8_SB(1, 0), b3, voffB); PG8_STAGE(PG8_SB(1, 1), b3 + hstepB, voffB); PG8_STAGE(PG8_SA(1, 0), a3, voffA);
            PG8_WAIT_V(8); PG8_WAIT_L(0); PG8_BAR; PG8_MMA(1, 0, At, B0); PG8_MMA(1, 1, At, B1); PG8_BAR; PG8_SCHED;
        }
        if constexpr (ALIGN_EPI) { if (wr == 0) PG8_BAR; }
        { int ln; asm volatile("v_mbcnt_lo_u32_b32 %0, -1, 0\n\tv_mbcnt_hi_u32_b32 %0, -1, %0" : "=v"(ln));
          E(acc, cur, wr, wc, ln & 15, ln >> 4); }
        S.done(cur, ui);
        if (!has_next) break;
#pragma unroll
        for (int a = 0; a < 2; ++a)
#pragma unroll
            for (int b = 0; b < 2; ++b)
#pragma unroll
                for (int m = 0; m < 4; ++m)
#pragma unroll
                    for (int n = 0; n < 2; ++n) acc[a][b][m][n] = (f32x4){0.f, 0.f, 0.f, 0.f};
        cur = nxt; cA = nA; cB = nB; ++ui;
        if constexpr (ALIGN_EPI) { if (wr == 1) PG8_BAR; }
    }
    PG8_WAIT_V(0);
    if constexpr (!ALIGN_EPI) { if (wr == 0) PG8_BAR; }
    PG8_BAR;
#undef PG8_SA
#undef PG8_SB
#undef PG8_STAGE
#undef PG8_LDA
#undef PG8_LDB
#undef PG8_MMA
#undef PG8_WAIT_V
#undef PG8_WAIT_L
#undef PG8_BAR
#undef PG8_SCHED
}
}
using pg8::Unit; using pg8::Gemm; using pg8::Acc; using pg8::DecGrid;

#define XB_TMO      128
#define XB_XCNT(j)  (256  + 64 * (j))
#define XB_XSUB(j)  (1280 + 64 * (j))
#define XB_XGEN(j)  (2304 + 64 * (j))
#define XB_TOP      3328
#define XB_TOPGEN   3392
#define XCD_BAR_WORDS 3456
#define XB_SPIN_CAP (1u << 18)
__device__ __forceinline__ unsigned xb_ld(unsigned* p)              { return __hip_atomic_load(p, __ATOMIC_RELAXED, __HIP_MEMORY_SCOPE_AGENT); }
__device__ __forceinline__ unsigned xb_add(unsigned* p, unsigned v) { return __hip_atomic_fetch_add(p, v, __ATOMIC_RELAXED, __HIP_MEMORY_SCOPE_AGENT); }
__device__ __forceinline__ unsigned xb_xcc_id() { return (unsigned)__builtin_amdgcn_s_getreg((3 << 11) | 20) & 0xFu; }
#define XB_SPIN(cond, bar) do { unsigned _sp = 0; while (cond) { __builtin_amdgcn_s_sleep(1); \
    if ((++_sp & 255u) == 0u) { if (xb_ld(&(bar)[XB_TMO])) break; if (_sp > XB_SPIN_CAP) { atomicAdd(&(bar)[XB_TMO], 1u); break; } } } } while (0)
struct XcdBarrier { unsigned* bar; unsigned x; volatile LAS unsigned* st; };
__device__ __forceinline__ XcdBarrier xcd_barrier_post(unsigned* bar, volatile LAS unsigned* st) {
    XcdBarrier b; b.bar = bar; b.x = xb_xcc_id(); b.st = st;
    if (threadIdx.x == 0) (void)xb_add(&bar[XB_XCNT(b.x)], 1u);
    return b;
}
__device__ __forceinline__ void xcd_barrier_complete(unsigned* bar, unsigned x, unsigned& nloc, unsigned& nx) {
    const unsigned G = gridDim.x * gridDim.y * gridDim.z;
    unsigned sum, cnt, mine, sp = 0u;
    for (;;) {
        sum = 0u; cnt = 0u; mine = 0u;
#pragma unroll
        for (unsigned j = 0; j < 16; ++j) { const unsigned c = xb_ld(&bar[XB_XCNT(j)]); sum += c; cnt += (c > 0u) ? 1u : 0u; mine = (j == x) ? c : mine; }
        if (sum == G) break;
        __builtin_amdgcn_s_sleep(1);
        if ((++sp & 255u) == 0u) { if (xb_ld(&bar[XB_TMO])) break; if (sp > XB_SPIN_CAP) { atomicAdd(&bar[XB_TMO], 1u); break; } }
    }
    nloc = mine > 0u ? mine : 1u; nx = cnt > 0u ? cnt : 1u;
}
__device__ __forceinline__ void xcd_barrier(const XcdBarrier& b) {
    asm volatile("s_waitcnt vmcnt(0)" ::: "memory");
    __syncthreads();
    if (threadIdx.x == 0) {
        unsigned* bar = b.bar;
        __builtin_amdgcn_s_waitcnt(0);
        unsigned nloc = b.st[0], nx = b.st[1];
        if (nloc == 0u) { xcd_barrier_complete(bar, b.x, nloc, nx); b.st[0] = nloc; b.st[1] = nx; }
        const unsigned old = xb_add(&bar[XB_XSUB(b.x)], 1u);
        const unsigned gen = old / nloc;
        if (old + 1u == (gen + 1u) * nloc) {
            __builtin_amdgcn_fence(__ATOMIC_RELEASE, "agent");
            asm volatile("s_waitcnt vmcnt(0)" ::: "memory");
            const unsigned og = xb_add(&bar[XB_TOP], 1u);
            const unsigned tg = og / nx;
            if (og + 1u == (tg + 1u) * nx) xb_add(&bar[XB_TOPGEN], 1u);
            else XB_SPIN(xb_ld(&bar[XB_TOPGEN]) == tg, bar);
            __builtin_amdgcn_fence(__ATOMIC_ACQUIRE, "agent");
            xb_add(&bar[XB_XGEN(b.x)], 1u);
            asm volatile("s_waitcnt vmcnt(0)" ::: "memory");
        } else {
            XB_SPIN(xb_ld(&bar[XB_XGEN(b.x)]) == gen, bar);
            __builtin_amdgcn_fence(__ATOMIC_ACQUIRE, "agent");
            asm volatile("s_waitcnt vmcnt(0)" ::: "memory");
        }
    }
    __syncthreads();
}

struct Args { const float* in[28]; float* out; unsigned char* ws; int ph_lo, ph_hi; };
enum { I_XP = 0, I_XS, I_SRET, I_CSK, I_CSV, I_SCONV, I_SPOOL, I_CMK, I_CMV, I_MEM, I_NG, I_MNG, I_FNG, I_RWIN, I_RWOUT, I_SWQKV, I_SWO, I_SINK, I_CWIN, I_CW, I_CWOUT, I_PW, I_PSC, I_XWQ, I_XWKV, I_XWO, I_FWIN, I_FWOUT };

template <int I> __device__ __forceinline__ const float* kin() { const float* p = nullptr;
#if defined(__HIP_DEVICE_COMPILE__)
    auto ka = __builtin_amdgcn_kernarg_segment_ptr();
    asm volatile("s_load_dwordx2 %0, %1, %2\n\ts_waitcnt lgkmcnt(0)" : "=s"(p) : "s"(ka), "n"(I * 8));
#endif
    return p; }
#define KIN(i) kin<(i)>()
struct Ctx { LAS unsigned char* lds; int wave, vcu, G; };
__device__ __forceinline__ int olane() { int t; asm volatile("v_mbcnt_lo_u32_b32 %0, -1, 0\n\tv_mbcnt_hi_u32_b32 %0, -1, %0" : "=v"(t)); return t; }
#define otid() (C.wave * 64 + olane())

__device__ __forceinline__ void conv_item(const float* W, int K, int N, int k0, int ns0, bf16* WT, int nd0, const float* gain, const float* cs, LAS float* scr, int lane) {
    const int q = lane & 15, kq = lane >> 4;
    const f32x4 csv = cs ? ld4(cs + ns0 + 4 * q) : (f32x4){1.f, 1.f, 1.f, 1.f};
    f32x4 v[16];
#pragma unroll
    for (int i = 0; i < 16; ++i) v[i] = ld4(W + (size_t)(k0 + 4 * i + kq) * N + ns0 + 4 * q);
#pragma unroll
    for (int i = 0; i < 16; ++i) { const int kk = 4 * i + kq; const f32x4 w = v[i] * csv * (gain ? gain[k0 + kk] : 1.f); LAS float* d = scr + kk * 65 + 4 * q; d[0] = w[0]; d[1] = w[1]; d[2] = w[2]; d[3] = w[3]; }
    LDS_WAIT(); asm volatile("" ::: "memory");
    const int c = lane & 7;
#pragma unroll
    for (int j = 0; j < 8; ++j) { const int n = (lane >> 3) + 8 * j; const LAS float* sp = scr + (8 * c) * 65 + n;
        u32x4 o; o.x = cvt_pk_bf16(sp[0 * 65], sp[1 * 65]); o.y = cvt_pk_bf16(sp[2 * 65], sp[3 * 65]); o.z = cvt_pk_bf16(sp[4 * 65], sp[5 * 65]); o.w = cvt_pk_bf16(sp[6 * 65], sp[7 * 65]);
        *(GAS u32x4*)(WT + (size_t)(nd0 + n) * K + k0 + 8 * c) = o; }
    LDS_WAIT(); asm volatile("" ::: "memory");
}
__device__ __forceinline__ int map_col(int mode, int nd) {
    if (mode == 0) return nd;
    if (mode == 1) return nd < 2048 ? nd : (nd < 4096 ? nd + 2048 : nd - 2048);
    if (mode == 2) { if (nd < 1024) return nd; const int t = nd - 1024; return 1024 + ((t >> 7) & 1) * 1024 + (t >> 8) * 128 + (t & 127); }
    return ((nd >> 7) & 1) * DFF + (nd >> 8) * 128 + (nd & 127);
}

__device__ __forceinline__ void p0_prologue(const Ctx& C, const Args& a) {
    unsigned char* ws = a.ws;
    LAS float* scr = (LAS float*)(C.lds + RING_OFF + C.wave * 16896);
    const int tid_ = otid(), lane_ = tid_ & 63;
    const int gw = C.vcu * 8 + C.wave, NGW = C.G * 8;
    int cum = 0;
#define JOB(Wp, K_, N_, Nd_, dstp, mode, gainp, csp) do { const int K__ = (K_), nblk = (Nd_) / 64, items = (K__ / 64) * nblk; \
        for (int it = (gw + NGW - (cum % NGW)) % NGW; it < items; it += NGW) { const int kb = it / nblk, nb = it % nblk; \
            conv_item((Wp), K__, (N_), 64 * kb, map_col((mode), 64 * nb), (bf16*)(dstp), 64 * nb, (gainp), (csp), scr, lane_); } cum += items; } while (0)
    const float* ng = KIN(I_NG);
    JOB(KIN(I_RWIN), 1024, 6144, 6144, ws + W_RET_IN, 1, ng + 0 * 1024, (const float*)nullptr);
    JOB(KIN(I_RWOUT), 2048, 1024, 1024, ws + W_RET_OUT, 0, (const float*)nullptr, (const float*)nullptr);
    JOB(KIN(I_SWQKV), 1024, 1536, 1536, ws + W_SWA_QKV, 0, ng + 3 * 1024, (const float*)nullptr);
    JOB(KIN(I_SWO), 1024, 1024, 1024, ws + W_SWA_O, 0, (const float*)nullptr, (const float*)nullptr);
    JOB(KIN(I_CWIN), 1024, 3072, 3072, ws + W_CONV_IN, 2, ng + 6 * 1024, (const float*)nullptr);
    JOB(KIN(I_CWOUT), 1024, 1024, 1024, ws + W_CONV_OUT, 0, (const float*)nullptr, (const float*)nullptr);
    for (int gi = 0; gi < 4; ++gi)
        JOB(KIN(I_PW) + (size_t)gi * 65536, 256, 256, 256, ws + W_POOL + (size_t)gi * 65536 * 2, 0, (const float*)nullptr, KIN(I_PSC) + gi * 256);
    for (int l = 0; l < 4; ++l) {
        JOB(KIN(I_XWQ) + (size_t)l * 1048576, 1024, 1024, 1024, ws + W_XQ + (size_t)l * 1048576 * 2, 0, ng + (3 * l + 1) * 1024, (const float*)nullptr);
        JOB(KIN(I_XWKV) + (size_t)l * 2097152, 1024, 2048, 2048, ws + W_XKV + (size_t)l * 2097152 * 2, 0, (const float*)nullptr, (const float*)nullptr);
        JOB(KIN(I_XWO) + (size_t)l * 1048576, 1024, 1024, 1024, ws + W_XO + (size_t)l * 1048576 * 2, 0, (const float*)nullptr, (const float*)nullptr);
        JOB(KIN(I_FWIN) + (size_t)l * 1024 * 5632, 1024, 5632, 5632, ws + W_FIN + (size_t)l * 1024 * 5632 * 2, 3, ng + (3 * l + 2) * 1024, (const float*)nullptr);
        JOB(KIN(I_FWOUT) + (size_t)l * 2816 * 1024, 2816, 1024, 1024, ws + W_FOUT + (size_t)l * 2816 * 1024 * 2, 0, (const float*)nullptr, (const float*)nullptr);
    }
#undef JOB
    {   bf16* WN = (bf16*)(ws + W_XQN);
        for (int row = gw; row < 4096; row += NGW) { const float gsc = ng[(3 * (row >> 10) + 1) * 1024 + (row & 1023)];
            const GAS f32x4* xp = (const GAS f32x4*)(KIN(I_XWQ) + (size_t)row * 1024) + lane_; GAS unsigned long long* o8 = (GAS unsigned long long*)(WN + (size_t)row * 1024) + lane_;
#pragma unroll
            for (int j = 0; j < 4; ++j) { const f32x4 v = xp[64 * j] * gsc; o8[64 * j] = (unsigned long long)cvt_pk_bf16(v.x, v.y) | ((unsigned long long)cvt_pk_bf16(v.z, v.w) << 32); } } }
    bf16* XB = (bf16*)(ws + WS_XB); u64* SS = (u64*)(ws + WS_SS);
    for (int row = gw; row < MT; row += NGW) {
        GAS unsigned long long* o8 = (GAS unsigned long long*)(XB + (size_t)row * D) + lane_;
        if (row < MREAL) {
            const float* xr = row < MP ? KIN(I_XP) + (size_t)row * D : KIN(I_XS) + (size_t)(row - MP) * D;
            const GAS f32x4* xp = (const GAS f32x4*)xr + lane_; float s = 0.f;
#pragma unroll
            for (int j = 0; j < 4; ++j) { const f32x4 v = xp[64 * j]; s += (v.x * v.x + v.y * v.y) + (v.z * v.z + v.w * v.w);
                o8[64 * j] = (unsigned long long)cvt_pk_bf16(v.x, v.y) | ((unsigned long long)cvt_pk_bf16(v.z, v.w) << 32); }
            s = wave_sum(s); if (lane_ == 0) SS[row] = to_fx(s);
        } else {
#pragma unroll
            for (int j = 0; j < 4; ++j) o8[64 * j] = 0ull;
        }
    }
    bf16* MN = (bf16*)(ws + WS_MEMN);
    for (int row = gw; row < 512; row += NGW) {
        const GAS f32x4* xp = (const GAS f32x4*)(KIN(I_MEM) + (size_t)row * D) + lane_; f32x4 v[4]; float s = 0.f;
#pragma unroll
        for (int j = 0; j < 4; ++j) { v[j] = xp[64 * j]; s += (v[j].x * v[j].x + v[j].y * v[j].y) + (v[j].z * v[j].z + v[j].w * v[j].w); }
        const float r = __builtin_amdgcn_rsqf(wave_sum(s) * (1.f / 1024.f) + EPS);
        for (int l = 0; l < 4; ++l) { const GAS f32x4* gp = (const GAS f32x4*)(KIN(I_MNG) + l * D) + lane_;
            GAS unsigned long long* o8 = (GAS unsigned long long*)(MN + ((size_t)l * 512 + row) * D) + lane_;
#pragma unroll
            for (int j = 0; j < 4; ++j) { const f32x4 gg = gp[64 * j]; o8[64 * j] = (unsigned long long)cvt_pk_bf16(v[j].x * r * gg.x, v[j].y * r * gg.y) | ((unsigned long long)cvt_pk_bf16(v[j].z * r * gg.z, v[j].w * r * gg.w) << 32); } }
    }
    {
        const int gt = C.vcu * 512 + tid_, NGT = C.G * 512;
        float* CR = (float*)(ws + T_CR); float* SR = (float*)(ws + T_SR); float* CRT = (float*)(ws + T_CRT); float* SRT = (float*)(ws + T_SRT);
        for (int e = gt; e < 8193 * 128; e += NGT) { const int pos = e >> 7, i = e & 127;
            const double rev = (double)pos * (exp(-9.210340371976184 * (double)i / 128.0) * 0.15915494309189535);
            const float fr = (float)(rev - rint(rev)); const float c = __builtin_amdgcn_cosf(fr), s = __builtin_amdgcn_sinf(fr);
            CR[e] = c; SR[e] = s; if (pos < 8192) { CRT[(size_t)i * 8192 + pos] = c; SRT[(size_t)i * 8192 + pos] = s; } }
        float* CS = (float*)(ws + T_CS); float* SN = (float*)(ws + T_SN);
        for (int e = gt; e < 8193 * 8; e += NGT) { const int pos = e >> 3, i = e & 7;
            const double rev = (double)pos * (exp(-13.122363377404328 * (double)i / 8.0) * 0.15915494309189535); const float fr = (float)(rev - rint(rev)); CS[e] = __builtin_amdgcn_cosf(fr); SN[e] = __builtin_amdgcn_sinf(fr); }
    }
    {
        const int gt = C.vcu * 512 + tid_, NGT = C.G * 512;
        GAS u32x4* zz = (GAS u32x4*)(ws + WS_SS + (size_t)MT * 8); for (int e = gt; e < (int)((ZERO_BYTES - WS_SS - (size_t)MT * 8) / 16); e += NGT) zz[e] = (u32x4){0u, 0u, 0u, 0u};
        GAS u32x4* ub = (GAS u32x4*)(ws + WS_UB + (size_t)MREAL * 2048 * 2); for (int e = gt; e < 128 * 2048 * 2 / 16; e += NGT) ub[e] = (u32x4){0u, 0u, 0u, 0u};
        GAS u32x4* ox = (GAS u32x4*)(ws + WS_OX + (size_t)MREAL * 1024 * 2); for (int e = gt; e < 128 * 1024 * 2 / 16; e += NGT) ox[e] = (u32x4){0u, 0u, 0u, 0u};
    }
}

#define EPI_HDR static constexpr bool PERM = true, AFTER_DRAIN = false;
#define EPI_ARGS Acc& acc, const Unit& u, int wr, int wc, int fr, int fq
#define FOR_AI_M _Pragma("unroll") for (int ai = 0; ai < 2; ++ai) _Pragma("unroll") for (int m = 0; m < 4; ++m)
#define FOR_BJ _Pragma("unroll") for (int bj = 0; bj < 2; ++bj)
#define FOR_N _Pragma("unroll") for (int n = 0; n < 2; ++n)
#define TROW (ai * 128 + wr * 64 + m * 16 + fr)
#define LOAD_RSTD8(rr, ssp, rowbase) float rr[2][4]; { u64 t_[2][4]; FOR_AI_M t_[ai][m] = (ssp)[(rowbase) + TROW]; FOR_AI_M rr[ai][m] = rstd_of(t_[ai][m]); }
__device__ __forceinline__ f32x4 silu4(f32x4 v) { return (f32x4){siluf(v[0]), siluf(v[1]), siluf(v[2]), siluf(v[3])}; }
__device__ __forceinline__ void st8b(bf16* p, f32x4 a, f32x4 b) { *(u32x4*)p = pack8(a, b); }

struct EpiMemKV { EPI_HDR
    float* out; bf16* MK; bf16* MV;
    __device__ __forceinline__ void operator()(EPI_ARGS) const {
        const int c0 = wc * 32 + fq * 8; const bool isk = u.pn < 4; float* ob = out + (isk ? O_MEMK : O_MEMV);
        FOR_AI_M { const size_t row = (size_t)u.pm * 256 + TROW;
            FOR_BJ { const size_t o = row * 1024 + (u.pn & 3) * 256 + bj * 128 + c0;
                st4(ob + o, acc[ai][bj][m][0]); st4(ob + o + 4, acc[ai][bj][m][1]);
                st8b((isk ? MK : MV) + o, acc[ai][bj][m][0], acc[ai][bj][m][1]); } }
    }
};
struct EpiMemVT { EPI_HDR
    bf16* MVT;
    __device__ __forceinline__ void operator()(EPI_ARGS) const {
        const int c0 = wc * 32 + fq * 8; const int layer = u.pm >> 2, head = u.pm & 3;
        FOR_AI_M { const size_t row = ((size_t)(layer * 2 + u.pn) * 1024 + head * 256 + TROW);
            FOR_BJ st8b(MVT + row * 1024 + bj * 128 + c0, acc[ai][bj][m][0], acc[ai][bj][m][1]); }
    }
};
struct EpiRetIn { EPI_HDR
    const u64* ss; const float* CR; const float* SR; bf16* Q; bf16* KB; bf16* APQ; bf16* Gt; float* SQ;
    __device__ __forceinline__ void operator()(EPI_ARGS) const {
        const int c0 = wc * 32 + fq * 8, pn = u.pn;
        LOAD_RSTD8(rr, ss, u.pm * 256)
        FOR_AI_M { const int row = u.pm * 256 + TROW; const float r = rr[ai][m];
            if (pn < 8) {
                const bool samp = row >= MP; const int pos = samp ? 8192 : (row & 8191); const int h = pn & 3;
                f32x4 o1[2], o2[2];
                FOR_N { const f32x4 c = ld4(CR + (size_t)pos * 128 + c0 + 4 * n), s = ld4(SR + (size_t)pos * 128 + c0 + 4 * n);
                    const f32x4 x1 = acc[ai][0][m][n] * r, x2 = acc[ai][1][m][n] * r; o1[n] = x1 * c - x2 * s; o2[n] = x2 * c + x1 * s; }
                if (pn < 4) {
                    bf16* qd = Q + (size_t)row * 1024 + h * 256 + c0; st8b(qd, o1[0], o1[1]); st8b(qd + 128, o2[0], o2[1]);
                    if (!samp) { const int l = row & 255; const float dec = __builtin_amdgcn_exp2f((float)(l + 1) * lg2g(h));
                        const int bhc = ((row >> 13) * 4 + h) * 32 + ((row & 8191) >> 8);
                        bf16* ad = APQ + ((size_t)bhc * 256 + l) * 512 + 256 + c0; st8b(ad, o1[0] * dec, o1[1] * dec); st8b(ad + 128, o2[0] * dec, o2[1] * dec); }
                    else if (row < MREAL) { float* d = SQ + (size_t)(row - MP) * 4096 + h * 256 + c0; st4(d, o1[0]); st4(d + 4, o1[1]); st4(d + 128, o2[0]); st4(d + 132, o2[1]); }
                } else {
                    FOR_N { o1[n] = o1[n] * 0.0625f; o2[n] = o2[n] * 0.0625f; }
                    if (!samp) { bf16* kd = KB + (size_t)row * 1024 + h * 256 + c0; st8b(kd, o1[0], o1[1]); st8b(kd + 128, o2[0], o2[1]); }
                    else if (row < MREAL) { float* d = SQ + (size_t)(row - MP) * 4096 + 1024 + h * 256 + c0; st4(d, o1[0]); st4(d + 4, o1[1]); st4(d + 128, o2[0]); st4(d + 132, o2[1]); }
                }
            } else {
                FOR_BJ st8b(Gt + (size_t)row * 2048 + (pn - 8) * 256 + bj * 128 + c0, silu4(acc[ai][bj][m][0] * r), silu4(acc[ai][bj][m][1] * r));
            }
        }
    }
    __device__ __forceinline__ void quad(int rs, int pn, int tc, f32x4 v0, f32x4 v1, int g) const {
        const float r = rstd_of(ss[MP + rs]); v0 = v0 * r; v1 = v1 * r;
        if (pn < 8) { const f32x4 c = ld4(CR + (size_t)8192 * 128 + tc), s = ld4(SR + (size_t)8192 * 128 + tc); f32x4 o1 = v0 * c - v1 * s, o2 = v1 * c + v0 * s;
            if (pn >= 4) { o1 = o1 * 0.0625f; o2 = o2 * 0.0625f; }
            float* d = SQ + (size_t)rs * 4096 + (pn >= 4 ? 1024 : 0) + (pn & 3) * 256 + tc; st4(d, o1); st4(d + 128, o2); }
        else if (pn < 16) { bf16* d = Gt + (size_t)(MP + rs) * 2048 + (pn - 8) * 256 + tc; const f32x4 a = silu4(v0), b = silu4(v1);
            *(u32x2*)d = (u32x2){cvt_pk_bf16(a[0], a[1]), cvt_pk_bf16(a[2], a[3])}; *(u32x2*)(d + 128) = (u32x2){cvt_pk_bf16(b[0], b[1]), cvt_pk_bf16(b[2], b[3])}; }
        else { float* d = SQ + (size_t)rs * 4096 + 2048 + (pn - 16) * 256 + tc; st4(d, v0); st4(d + 128, v1); }
    }
};
struct EpiRetVs { EPI_HDR
    const u64* ss; float* SQ;
    __device__ __forceinline__ void operator()(EPI_ARGS) const {
        const int c0 = wc * 32 + fq * 8;
#pragma unroll
        for (int m = 0; m < 4; ++m) { const int rl = wr * 64 + m * 16 + fr; const float r = rstd_of(ss[MP + rl]);
            FOR_BJ { float* d = SQ + (size_t)rl * 4096 + 2048 + u.pn * 256 + bj * 128 + c0; st4(d, acc[0][bj][m][0] * r); st4(d + 4, acc[0][bj][m][1] * r); } }
    }
};
struct EpiRetKT { EPI_HDR
    const u64* ss; const float* CRT; const float* SRT; bf16* KT;
    __device__ __forceinline__ void operator()(EPI_ARGS) const {
        const int c0 = wc * 32 + fq * 8, h = u.pm; const float lg = lg2g(h);
        f32x4 sc[2][2];
        FOR_BJ FOR_N { const int tok0 = u.pn * 256 + bj * 128 + c0 + 4 * n;
#pragma unroll
            for (int e = 0; e < 4; ++e) sc[bj][n][e] = rstd_of(ss[tok0 + e]) * 0.0625f * __builtin_amdgcn_exp2f((float)(255 - ((tok0 + e) & 255)) * lg); }
        const int b = u.pn >> 5;
#pragma unroll
        for (int m = 0; m < 4; ++m) { const int i = wr * 64 + m * 16 + fr;
            f32x4 tc[2][2], ts[2][2];
            FOR_BJ FOR_N { const int t0 = ((u.pn & 31) * 256) + bj * 128 + c0; tc[bj][n] = ld4(CRT + (size_t)i * 8192 + t0 + 4 * n); ts[bj][n] = ld4(SRT + (size_t)i * 8192 + t0 + 4 * n); }
            FOR_BJ { f32x4 o1[2], o2[2];
                FOR_N { const f32x4 c = tc[bj][n], s = ts[bj][n];
                    const f32x4 x1 = acc[0][bj][m][n], x2 = acc[1][bj][m][n]; o1[n] = (x1 * c - x2 * s) * sc[bj][n]; o2[n] = (x2 * c + x1 * s) * sc[bj][n]; }
                bf16* d = KT + ((size_t)(((b * 4 + h) * 32 + (u.pn & 31)) * 256 + i)) * 512 + bj * 128 + c0; st8b(d, o1[0], o1[1]); st8b(d + (size_t)128 * 512, o2[0], o2[1]); } }
    }
};
struct EpiRetVT { EPI_HDR
    const u64* ss; bf16* VS;
    __device__ __forceinline__ void operator()(EPI_ARGS) const {
        const int c0 = wc * 32 + fq * 8, h = u.pm >> 1, vh = u.pm & 1; const int bhc = ((u.pn >> 5) * 4 + h) * 32 + (u.pn & 31);
        f32x4 sc[2][2];
        FOR_BJ FOR_N { const u64* sp = ss + u.pn * 256 + bj * 128 + c0 + 4 * n;
#pragma unroll
            for (int e = 0; e < 4; ++e) sc[bj][n][e] = rstd_of(sp[e]); }
        FOR_AI_M { bf16* d = VS + ((size_t)bhc * 512 + vh * 256 + TROW) * 512 + c0;
            FOR_BJ st8b(d + bj * 128, acc[ai][bj][m][0] * sc[bj][0], acc[ai][bj][m][1] * sc[bj][1]); }
    }
};
struct EpiP { EPI_HDR
    bf16* APQ;
    __device__ __forceinline__ void operator()(EPI_ARGS) const {
        const int c0 = wc * 32 + fq * 8, h = u.pn; const float lg = lg2g(h); const int bhc = ((u.pm >> 5) * 4 + h) * 32 + (u.pm & 31);
        FOR_AI_M { const int l = TROW; bf16* d = APQ + ((size_t)bhc * 256 + l) * 512 + c0;
            FOR_BJ { f32x4 o[2];
                FOR_N {
#pragma unroll
                    for (int e = 0; e < 4; ++e) { const int df = l - (bj * 128 + c0 + 4 * n + e); o[n][e] = df >= 0 ? acc[ai][bj][m][n][e] * __builtin_amdgcn_exp2f((float)df * lg) : 0.f; } }
                st8b(d + bj * 128, o[0], o[1]); } }
    }
};
struct EpiU { static constexpr bool PERM = false, AFTER_DRAIN = false;
    bf16* U;
    __device__ __forceinline__ void operator()(EPI_ARGS) const {
        FOR_AI_M { bf16* d = U + ((size_t)u.pm * 256 + TROW) * 256 + wc * 32 + fq * 4;
            FOR_BJ FOR_N { const f32x4 v = acc[ai][bj][m][n]; *(u32x2*)(d + bj * 128 + n * 16) = (u32x2){cvt_pk_bf16(v[0], v[1]), cvt_pk_bf16(v[2], v[3])}; } }
    }
};
struct EpiO { EPI_HDR
    bf16* O; u64* ST;
    __device__ __forceinline__ void operator()(EPI_ARGS) const {
        const int c0 = wc * 32 + fq * 8; const int bhc = u.pm >> 1, vh = u.pm & 1, h = (bhc >> 5) & 3;
        const int row0 = (bhc >> 7) * 8192 + (bhc & 31) * 256;
        FOR_AI_M { const int row = row0 + TROW; float s1 = 0.f, s2 = 0.f;
            FOR_BJ { const f32x4 a = acc[ai][bj][m][0], b = acc[ai][bj][m][1];
                st8b(O + (size_t)row * 2048 + h * 512 + vh * 256 + bj * 128 + c0, a, b);
                s1 += (a[0] + a[1]) + (a[2] + a[3]) + (b[0] + b[1]) + (b[2] + b[3]);
                s2 += (a[0] * a[0] + a[1] * a[1]) + (a[2] * a[2] + a[3] * a[3]) + (b[0] * b[0] + b[1] * b[1]) + (b[2] * b[2] + b[3] * b[3]); }
            s1 += __shfl_xor(s1, 16); s1 += __shfl_xor(s1, 32); s2 += __shfl_xor(s2, 16); s2 += __shfl_xor(s2, 32);
            if (fq == 0) { fx_add(ST + (size_t)row * 8 + h * 2, s1); fx_add(ST + (size_t)row * 8 + h * 2 + 1, s2); } }
    }
};
struct EpiONorm { EPI_HDR
    const bf16* Gt; bf16* UB; u64* ST; unsigned* pc; unsigned* bar;
    __device__ __forceinline__ void operator()(EPI_ARGS) const {
        const int c0 = wc * 32 + fq * 8; const int bhc = u.pm >> 1, vh = u.pm & 1, h = (bhc >> 5) & 3;
        const int row0 = (bhc >> 7) * 8192 + (bhc & 31) * 256;
        FOR_AI_M { const int row = row0 + TROW; float s1 = 0.f, s2 = 0.f;
            FOR_BJ { const f32x4 a = acc[ai][bj][m][0], b = acc[ai][bj][m][1];
                s1 += (a[0] + a[1]) + (a[2] + a[3]) + (b[0] + b[1]) + (b[2] + b[3]);
                s2 += (a[0] * a[0] + a[1] * a[1]) + (a[2] * a[2] + a[3] * a[3]) + (b[0] * b[0] + b[1] * b[1]) + (b[2] * b[2] + b[3] * b[3]); }
            s1 += __shfl_xor(s1, 16); s1 += __shfl_xor(s1, 32); s2 += __shfl_xor(s2, 16); s2 += __shfl_xor(s2, 32);
            if (fq == 0) { fx_add(ST + (size_t)row * 8 + h * 2, s1); fx_add(ST + (size_t)row * 8 + h * 2 + 1, s2); } }
        u32x4 gv[4][2];
#pragma unroll
        for (int m = 0; m < 4; ++m)
#pragma unroll
            for (int bj = 0; bj < 2; ++bj) gv[m][bj] = *(const u32x4*)(Gt + (size_t)(row0 + wr * 64 + m * 16 + fr) * 2048 + h * 512 + vh * 256 + bj * 128 + c0);
        asm volatile("s_waitcnt vmcnt(0)" ::: "memory"); __builtin_amdgcn_s_barrier(); asm volatile("" ::: "memory");
        if (wr == 0 && wc == 0 && fr == 0 && fq == 0) { (void)xb_add(pc + bhc, 1u); XB_SPIN(xb_ld(pc + bhc) < 2u, bar); }
        __builtin_amdgcn_s_barrier(); asm volatile("" ::: "memory");
        float mu[2][4], rs[2][4];
        { u64 t1[2][4], t2[2][4];
#pragma unroll
          for (int ai = 0; ai < 2; ++ai)
#pragma unroll
            for (int m = 0; m < 4; ++m) { const int row = row0 + TROW; t1[ai][m] = __hip_atomic_load(ST + (size_t)row * 8 + h * 2, __ATOMIC_RELAXED, __HIP_MEMORY_SCOPE_AGENT); t2[ai][m] = __hip_atomic_load(ST + (size_t)row * 8 + h * 2 + 1, __ATOMIC_RELAXED, __HIP_MEMORY_SCOPE_AGENT); }
#pragma unroll
          for (int ai = 0; ai < 2; ++ai)
#pragma unroll
            for (int m = 0; m < 4; ++m) { mu[ai][m] = from_fx(t1[ai][m]) * (1.f / 512.f); rs[ai][m] = __builtin_amdgcn_rsqf(fmaxf(from_fx(t2[ai][m]) * (1.f / 512.f) - mu[ai][m] * mu[ai][m], 0.f) + EPS); } }
#pragma unroll
        for (int ai = 0; ai < 2; ++ai) {
            if (ai == 1) {
#pragma unroll
                for (int m = 0; m < 4; ++m)
#pragma unroll
                    for (int bj = 0; bj < 2; ++bj) gv[m][bj] = *(const u32x4*)(Gt + (size_t)(row0 + 128 + wr * 64 + m * 16 + fr) * 2048 + h * 512 + vh * 256 + bj * 128 + c0);
            }
#pragma unroll
            for (int m = 0; m < 4; ++m) { const int row = row0 + TROW;
#pragma unroll
                for (int bj = 0; bj < 2; ++bj) { const size_t o = (size_t)row * 2048 + h * 512 + vh * 256 + bj * 128 + c0; const u32x4 g4 = gv[m][bj];
                    const f32x4 a = (acc[ai][bj][m][0] - mu[ai][m]) * rs[ai][m] * (f32x4){bflo(g4.x), bfhi(g4.x), bflo(g4.y), bfhi(g4.y)}, b = (acc[ai][bj][m][1] - mu[ai][m]) * rs[ai][m] * (f32x4){bflo(g4.z), bfhi(g4.z), bflo(g4.w), bfhi(g4.w)};
                    st8b(UB + o, a, b); } } }
    }
};
struct EpiResidual { EPI_HDR
    const float* xin_p; const float* xin_s; bf16* XB; u64* ssn;
    __device__ __forceinline__ void operator()(EPI_ARGS) const {
        const int c0 = wc * 32 + fq * 8;
        if (xin_p) {
        FOR_AI_M { const int row = u.pm * 256 + TROW; float sq = 0.f;
            FOR_BJ { const int col = u.pn * 256 + bj * 128 + c0; f32x4 a, b;
                { const float* xo = xin_p + (size_t)row * 1024 + col; a = ld4(xo); b = ld4(xo + 4); }
                a += acc[ai][bj][m][0]; b += acc[ai][bj][m][1];
                st8b(XB + (size_t)row * 1024 + col, a, b);
                sq += (a[0] * a[0] + a[1] * a[1]) + (a[2] * a[2] + a[3] * a[3]) + (b[0] * b[0] + b[1] * b[1]) + (b[2] * b[2] + b[3] * b[3]); }
            sq += __shfl_xor(sq, 16); sq += __shfl_xor(sq, 32);
            if (fq == 0) fx_add(ssn + row, sq); }
        } else {
#pragma unroll
        for (int ai = 0; ai < 2; ++ai) { u32x4 ov[4][2];
#pragma unroll
            for (int m = 0; m < 4; ++m) FOR_BJ ov[m][bj] = *(const u32x4*)(XB + (size_t)(u.pm * 256 + TROW) * 1024 + u.pn * 256 + bj * 128 + c0);
#pragma unroll
            for (int m = 0; m < 4; ++m) { const int row = u.pm * 256 + TROW; float sq = 0.f;
                FOR_BJ { const int col = u.pn * 256 + bj * 128 + c0; const u32x4 o = ov[m][bj];
                    const f32x4 a = (f32x4){bflo(o.x), bfhi(o.x), bflo(o.y), bfhi(o.y)} + acc[ai][bj][m][0], b = (f32x4){bflo(o.z), bfhi(o.z), bflo(o.w), bfhi(o.w)} + acc[ai][bj][m][1];
                    st8b(XB + (size_t)row * 1024 + col, a, b);
                    sq += (a[0] * a[0] + a[1] * a[1]) + (a[2] * a[2] + a[3] * a[3]) + (b[0] * b[0] + b[1] * b[1]) + (b[2] * b[2] + b[3] * b[3]); }
                sq += __shfl_xor(sq, 16); sq += __shfl_xor(sq, 32);
                if (fq == 0) fx_add(ssn + row, sq); } }
        }
    }
    __device__ __forceinline__ void quad(int rs, int pn, int tc, f32x4 v0, f32x4 v1, int g) const {
        const int row = MP + rs, col = pn * 256 + tc; bf16* bd = XB + (size_t)row * 1024 + col; f32x4 a, b;
        if (xin_s) { const float* xo = xin_s + (size_t)rs * 1024 + col; a = ld4(xo); b = ld4(xo + 128); }
        else { const u32x2 o0 = *(const u32x2*)bd, o1 = *(const u32x2*)(bd + 128); a = (f32x4){bflo(o0.x), bfhi(o0.x), bflo(o0.y), bfhi(o0.y)}; b = (f32x4){bflo(o1.x), bfhi(o1.x), bflo(o1.y), bfhi(o1.y)}; }
        a += v0; b += v1;
        *(u32x2*)bd = (u32x2){cvt_pk_bf16(a[0], a[1]), cvt_pk_bf16(a[2], a[3])}; *(u32x2*)(bd + 128) = (u32x2){cvt_pk_bf16(b[0], b[1]), cvt_pk_bf16(b[2], b[3])};
        float sq = (a[0] * a[0] + a[1] * a[1]) + (a[2] * a[2] + a[3] * a[3]) + (b[0] * b[0] + b[1] * b[1]) + (b[2] * b[2] + b[3] * b[3]);
        sq += __shfl_xor(sq, 16); sq += __shfl_xor(sq, 32);
        if (g == 0) fx_add(ssn + row, sq);
    }
};
struct EpiResFinal { EPI_HDR
    const bf16* XB; u64* ssn; const float* fg; float* y; unsigned* pc; unsigned* bar;
    __device__ __forceinline__ void operator()(EPI_ARGS) const {
        const int c0 = wc * 32 + fq * 8;
        FOR_AI_M { const int row = u.pm * 256 + TROW; float sq = 0.f;
            FOR_BJ { const int col = u.pn * 256 + bj * 128 + c0;
                const u32x4 o = *(const u32x4*)(XB + (size_t)row * 1024 + col);
                const f32x4 a = (f32x4){bflo(o.x), bfhi(o.x), bflo(o.y), bfhi(o.y)} + acc[ai][bj][m][0], b = (f32x4){bflo(o.z), bfhi(o.z), bflo(o.w), bfhi(o.w)} + acc[ai][bj][m][1];
                acc[ai][bj][m][0] = a; acc[ai][bj][m][1] = b;
                sq += (a[0] * a[0] + a[1] * a[1]) + (a[2] * a[2] + a[3] * a[3]) + (b[0] * b[0] + b[1] * b[1]) + (b[2] * b[2] + b[3] * b[3]); }
            sq += __shfl_xor(sq, 16); sq += __shfl_xor(sq, 32);
            if (fq == 0) fx_add(ssn + row, sq); }
        asm volatile("s_waitcnt vmcnt(0)" ::: "memory"); __builtin_amdgcn_s_barrier(); asm volatile("" ::: "memory");
        if (wr == 0 && wc == 0 && fr == 0 && fq == 0) { (void)xb_add(pc + u.pm, 1u); XB_SPIN(xb_ld(pc + u.pm) < 4u, bar); }
        __builtin_amdgcn_s_barrier(); asm volatile("" ::: "memory");
        u64 t[2][4]; f32x4 gg[2][2];
        FOR_AI_M t[ai][m] = __hip_atomic_load(ssn + u.pm * 256 + TROW, __ATOMIC_RELAXED, __HIP_MEMORY_SCOPE_AGENT);
        FOR_BJ { const int col = u.pn * 256 + bj * 128 + c0; gg[bj][0] = ld4(fg + col); gg[bj][1] = ld4(fg + col + 4); }
        FOR_AI_M { const int row = u.pm * 256 + TROW; const float r = rstd_of(t[ai][m]);
            FOR_BJ { float* yo = y + (size_t)row * 1024 + u.pn * 256 + bj * 128 + c0;
                st4(yo, acc[ai][bj][m][0] * r * gg[bj][0]); st4(yo + 4, acc[ai][bj][m][1] * r * gg[bj][1]); } }
    }
};
struct EpiScale { EPI_HDR
    const u64* ss; float scale; bf16* out; int ld;
    __device__ __forceinline__ void operator()(EPI_ARGS) const {
        const int c0 = wc * 32 + fq * 8;
        FOR_AI_M { const int row = u.pm * 256 + TROW; const float r = rstd_of(ss[row]) * scale;
            FOR_BJ st8b(out + (size_t)row * ld + u.pn * 256 + bj * 128 + c0, acc[ai][bj][m][0] * r, acc[ai][bj][m][1] * r); }
    }
    __device__ __forceinline__ void quad(int rs, int pn, int tc, f32x4 v0, f32x4 v1, int g) const {
        const float r = rstd_of(ss[MP + rs]) * scale; v0 = v0 * r; v1 = v1 * r; bf16* d = out + (size_t)(MP + rs) * ld + pn * 256 + tc;
        *(u32x2*)d = (u32x2){cvt_pk_bf16(v0[0], v0[1]), cvt_pk_bf16(v0[2], v0[3])}; *(u32x2*)(d + 128) = (u32x2){cvt_pk_bf16(v1[0], v1[1]), cvt_pk_bf16(v1[2], v1[3])};
    }
};
struct EpiSoftmax { EPI_HDR
    bf16* PX; LAS float* X;
    __device__ __forceinline__ void operator()(EPI_ARGS) const {
        const int c0 = wc * 32 + fq * 8;
        FOR_AI_M { float v = -3.0e38f;
            FOR_BJ FOR_N {
#pragma unroll
                for (int e = 0; e < 4; ++e) v = fmaxf(v, acc[ai][bj][m][n][e]); }
            v = fmaxf(v, __shfl_xor(v, 16)); v = fmaxf(v, __shfl_xor(v, 32));
            if (fq == 0) X[wc * 256 + TROW] = v; }
        asm volatile("s_waitcnt lgkmcnt(0)" ::: "memory"); __builtin_amdgcn_s_barrier(); asm volatile("" ::: "memory");
        FOR_AI_M { const int rl = TROW; const float M = fmaxf(fmaxf(X[rl], X[256 + rl]), fmaxf(X[512 + rl], X[768 + rl])); float s = 0.f;
            FOR_BJ FOR_N {
#pragma unroll
                for (int e = 0; e < 4; ++e) { const float p = __builtin_amdgcn_exp2f(acc[ai][bj][m][n][e] - M); acc[ai][bj][m][n][e] = p; s += p; } }
            s += __shfl_xor(s, 16); s += __shfl_xor(s, 32);
            if (fq == 0) X[1024 + wc * 256 + rl] = s; }
        asm volatile("s_waitcnt lgkmcnt(0)" ::: "memory"); __builtin_amdgcn_s_barrier(); asm volatile("" ::: "memory");
        FOR_AI_M { const int rl = TROW; const float inv = __builtin_amdgcn_rcpf((X[1024 + rl] + X[1280 + rl]) + (X[1536 + rl] + X[1792 + rl]));
            FOR_BJ st8b(PX + ((size_t)u.pm * 256 + rl) * 1024 + u.pn * 256 + bj * 128 + c0, acc[ai][bj][m][0] * inv, acc[ai][bj][m][1] * inv); }
        asm volatile("s_waitcnt lgkmcnt(0)" ::: "memory"); __builtin_amdgcn_s_barrier(); asm volatile("" ::: "memory");
    }
};
struct EpiSoftmaxR { EPI_HDR
    const u64* ss; bf16* PX; LAS float* X;
    __device__ __forceinline__ void operator()(EPI_ARGS) const {
        const int c0 = wc * 32 + fq * 8;
        FOR_AI_M { const float r = rstd_of(ss[u.pm * 256 + TROW]); float v = -3.0e38f;
            FOR_BJ FOR_N { const f32x4 t = acc[ai][bj][m][n] * r; acc[ai][bj][m][n] = t; v = fmaxf(fmaxf(v, fmaxf(t[0], t[1])), fmaxf(t[2], t[3])); }
            v = fmaxf(v, __shfl_xor(v, 16)); v = fmaxf(v, __shfl_xor(v, 32));
            if (fq == 0) X[wc * 256 + TROW] = v; }
        asm volatile("s_waitcnt lgkmcnt(0)" ::: "memory"); __builtin_amdgcn_s_barrier(); asm volatile("" ::: "memory");
        FOR_AI_M { const int rl = TROW; const float M = fmaxf(fmaxf(X[rl], X[256 + rl]), fmaxf(X[512 + rl], X[768 + rl])); float s = 0.f;
            FOR_BJ FOR_N {
#pragma unroll
                for (int e = 0; e < 4; ++e) { const float p = __builtin_amdgcn_exp2f(acc[ai][bj][m][n][e] - M); acc[ai][bj][m][n][e] = p; s += p; } }
            s += __shfl_xor(s, 16); s += __shfl_xor(s, 32);
            if (fq == 0) X[1024 + wc * 256 + rl] = s; }
        asm volatile("s_waitcnt lgkmcnt(0)" ::: "memory"); __builtin_amdgcn_s_barrier(); asm volatile("" ::: "memory");
        FOR_AI_M { const int rl = TROW; const float inv = __builtin_amdgcn_rcpf((X[1024 + rl] + X[1280 + rl]) + (X[1536 + rl] + X[1792 + rl]));
            FOR_BJ st8b(PX + ((size_t)u.pm * 256 + rl) * 1024 + u.pn * 256 + bj * 128 + c0, acc[ai][bj][m][0] * inv, acc[ai][bj][m][1] * inv); }
        asm volatile("s_waitcnt lgkmcnt(0)" ::: "memory"); __builtin_amdgcn_s_barrier(); asm volatile("" ::: "memory");
    }
};
struct EpiAbs { EPI_HDR
    bf16* out;
    __device__ __forceinline__ void operator()(EPI_ARGS) const {
        const int c0 = wc * 32 + fq * 8; const float sc = u.pm < 32 ? LOG2E * 0.0625f : 1.f;
        FOR_AI_M { const int row = u.pm * 256 + TROW;
            FOR_BJ st8b(out + (size_t)row * 1024 + u.pn * 256 + bj * 128 + c0, acc[ai][bj][m][0] * sc, acc[ai][bj][m][1] * sc); }
    }
};
struct EpiPlain { EPI_HDR
    bf16* out; int ld;
    __device__ __forceinline__ void operator()(EPI_ARGS) const {
        const int c0 = wc * 32 + fq * 8;
        FOR_AI_M { const int row = u.pm * 256 + TROW;
            FOR_BJ st8b(out + (size_t)row * ld + u.pn * 256 + bj * 128 + c0, acc[ai][bj][m][0], acc[ai][bj][m][1]); }
    }
};
struct EpiPlainNP { static constexpr bool PERM = false, AFTER_DRAIN = false;
    bf16* out; int ld;
    __device__ __forceinline__ void operator()(EPI_ARGS) const {
        FOR_AI_M { const int row = u.pm * 256 + TROW;
            FOR_BJ FOR_N { const f32x4 v = acc[ai][bj][m][n];
                *(u32x2*)(out + (size_t)row * ld + u.pn * 256 + bj * 128 + wc * 32 + n * 16 + fq * 4) = (u32x2){cvt_pk_bf16(v[0], v[1]), cvt_pk_bf16(v[2], v[3])}; } }
    }
};
struct EpiSwiGLU { EPI_HDR
    const u64* ss; bf16* HF;
    __device__ __forceinline__ void operator()(EPI_ARGS) const {
        const int c0 = wc * 32 + fq * 8;
        LOAD_RSTD8(rr, ss, u.pm * 256)
        FOR_AI_M { const int row = u.pm * 256 + TROW; const float r = rr[ai][m];
            const f32x4 o0 = silu4(acc[ai][0][m][0] * r) * (acc[ai][1][m][0] * r), o1 = silu4(acc[ai][0][m][1] * r) * (acc[ai][1][m][1] * r);
            st8b(HF + (size_t)row * DFF + u.pn * 128 + c0, o0, o1); }
    }
    __device__ __forceinline__ void quad(int rs, int pn, int tc, f32x4 v0, f32x4 v1, int g) const {
        const float r = rstd_of(ss[MP + rs]); const f32x4 o = silu4(v0 * r) * (v1 * r);
        *(u32x2*)(HF + (size_t)(MP + rs) * DFF + pn * 128 + tc) = (u32x2){cvt_pk_bf16(o[0], o[1]), cvt_pk_bf16(o[2], o[3])};
    }
};
struct EpiConvIn { EPI_HDR
    const u64* ss; bf16* BG; bf16* CI; float* out;
    __device__ __forceinline__ void operator()(EPI_ARGS) const {
        const int c0 = wc * 32 + fq * 8;
        LOAD_RSTD8(rr, ss, u.pm * 256)
        FOR_AI_M { const int row = u.pm * 256 + TROW; const float r = rr[ai][m];
            if (u.pn < 4) { FOR_BJ st8b(BG + (size_t)row * 1024 + u.pn * 256 + bj * 128 + c0, acc[ai][bj][m][0] * r, acc[ai][bj][m][1] * r); }
            else { const int col = (u.pn - 4) * 128 + c0; const f32x4 a = (acc[ai][0][m][0] * r) * (acc[ai][1][m][0] * r), b = (acc[ai][0][m][1] * r) * (acc[ai][1][m][1] * r);
                st8b(CI + (size_t)row * 1024 + col, a, b);
                if (row < MP) { const int t = row & 8191; if (t >= 8190) { float* d = out + O_CONVP + ((size_t)(row >> 13) * 2 + (t - 8190)) * 1024 + col; st4(d, a); st4(d + 4, b); } }
                else if (row < MREAL) { float* d = out + O_CONVS + ((size_t)(row - MP) * 2 + 1) * 1024 + col; st4(d, a); st4(d + 4, b); } } }
    }
    __device__ __forceinline__ void quad(int rs, int pn, int tc, f32x4 v0, f32x4 v1, int g) const {
        const float r = rstd_of(ss[MP + rs]); v0 = v0 * r; v1 = v1 * r;
        if (pn < 4) { bf16* d = BG + (size_t)(MP + rs) * 1024 + pn * 256 + tc; *(u32x2*)d = (u32x2){cvt_pk_bf16(v0[0], v0[1]), cvt_pk_bf16(v0[2], v0[3])}; *(u32x2*)(d + 128) = (u32x2){cvt_pk_bf16(v1[0], v1[1]), cvt_pk_bf16(v1[2], v1[3])}; }
        else { const f32x4 c = v0 * v1; const int col = (pn - 4) * 128 + tc; *(u32x2*)(CI + (size_t)(MP + rs) * 1024 + col) = (u32x2){cvt_pk_bf16(c[0], c[1]), cvt_pk_bf16(c[2], c[3])};
            st4(out + O_CONVS + ((size_t)rs * 2 + 1) * 1024 + col, c); }
    }
};
struct EpiSwaQKV { EPI_HDR
    const u64* ss; const float* CS; const float* SN; bf16* QS; bf16* KS; float* SWQ; float* out;
    __device__ __forceinline__ void operator()(EPI_ARGS) const {
        const int c0 = wc * 32 + fq * 8, pn = u.pn; const bool rot = ((wc & 1) == 0) && (fq < 2);
        LOAD_RSTD8(rr, ss, u.pm * 256)
        FOR_AI_M { const int row = u.pm * 256 + TROW; const float r = rr[ai][m]; const bool samp = row >= MP; const int pos = samp ? 8192 : (row & 8191);
            FOR_BJ { f32x4 v[2];
                FOR_N { v[n] = acc[ai][bj][m][n] * r;
                    if (pn < 5) { f32x4 pr;
#pragma unroll
                        for (int e = 0; e < 4; ++e) pr[e] = __shfl_xor(v[n][e], 16);
                        if (rot) { const f32x4 c = ld4(CS + (size_t)pos * 8 + 4 * n), s = ld4(SN + (size_t)pos * 8 + 4 * n); v[n] = (fq == 0) ? v[n] * c - pr * s : v[n] * c + pr * s; } } }
                const int tc = bj * 128 + c0;
                if (pn < 4) { const float qs = 0.125f * LOG2E; v[0] = v[0] * qs; v[1] = v[1] * qs;
                    if (!samp) st8b(QS + (size_t)row * 1024 + pn * 256 + tc, v[0], v[1]);
                    else if (row < MREAL) { float* d = SWQ + (size_t)(row - MP) * 1536 + pn * 256 + tc; st4(d, v[0]); st4(d + 4, v[1]); } }
                else if (pn == 4) {
                    if (!samp) { st8b(KS + (size_t)row * 256 + tc, v[0], v[1]); const int t = row & 8191;
                        if (t >= 8064) { float* d = out + O_SWKP + ((size_t)(row >> 13) * 128 + (t - 8064)) * 256 + tc; st4(d, v[0]); st4(d + 4, v[1]); } }
                    else if (row < MREAL) { float* d = SWQ + (size_t)(row - MP) * 1536 + 1024 + tc; st4(d, v[0]); st4(d + 4, v[1]); } }
                else {
                    if (!samp) { const int t = row & 8191; if (t >= 8064) { float* d = out + O_SWVP + ((size_t)(row >> 13) * 128 + (t - 8064)) * 256 + tc; st4(d, v[0]); st4(d + 4, v[1]); } }
                    else if (row < MREAL) { float* d = SWQ + (size_t)(row - MP) * 1536 + 1280 + tc; st4(d, v[0]); st4(d + 4, v[1]); } } } }
    }
    __device__ __forceinline__ void quad(int rs, int pn, int tc, f32x4 v0, f32x4 v1, int g) const {
        const float r = rstd_of(ss[MP + rs]); v0 = v0 * r; v1 = v1 * r;
        if (pn < 5) { f32x4 p0, p1;
#pragma unroll
            for (int e = 0; e < 4; ++e) { p0[e] = __shfl_xor(v0[e], 32); p1[e] = __shfl_xor(v1[e], 32); }
            if ((tc & 63) < 16) { const f32x4 c = ld4(CS + (size_t)8192 * 8 + (tc & 4)), s = ld4(SN + (size_t)8192 * 8 + (tc & 4));
                if ((tc & 8) == 0) { v0 = v0 * c - p0 * s; v1 = v1 * c - p1 * s; } else { v0 = v0 * c + p0 * s; v1 = v1 * c + p1 * s; } } }
        if (pn < 4) { const float qs = 0.125f * LOG2E; v0 = v0 * qs; v1 = v1 * qs; }
        float* d = SWQ + (size_t)rs * 1536 + (pn < 4 ? pn * 256 : (pn == 4 ? 1024 : 1280)) + tc; st4(d, v0); st4(d + 128, v1);
    }
};
struct EpiSwaVT { EPI_HDR
    const u64* ss; bf16* VT;
    __device__ __forceinline__ void operator()(EPI_ARGS) const {
        const int c0 = wc * 32 + fq * 8; const int b = u.pn >> 5, t0 = (u.pn & 31) * 256;
        f32x4 sc[2][2];
        FOR_BJ FOR_N { const u64* sp = ss + u.pn * 256 + bj * 128 + c0 + 4 * n;
#pragma unroll
            for (int e = 0; e < 4; ++e) sc[bj][n][e] = rstd_of(sp[e]); }
        FOR_AI_M { bf16* d = VT + ((size_t)(b * 256 + TROW)) * 8192 + t0 + c0;
            FOR_BJ st8b(d + bj * 128, acc[ai][bj][m][0] * sc[bj][0], acc[ai][bj][m][1] * sc[bj][1]); }
    }
};

struct DecMem { __device__ __forceinline__ void operator()(int L, Unit& u) const { u.pm = L >> 3; u.pn = L & 7; u.ao = (unsigned)u.pm * 256u * 1024u; u.bo = ((unsigned)(u.pm >> 1) * 2048u + (unsigned)u.pn * 256u) * 1024u; } };
struct DecMemT { __device__ __forceinline__ void operator()(int L, Unit& u) const { u.pm = L >> 1; u.pn = L & 1; u.ao = ((unsigned)(u.pm >> 2) * 2048u + 1024u + (unsigned)(u.pm & 3) * 256u) * 1024u; u.bo = ((unsigned)(u.pm >> 2) * 512u + (unsigned)u.pn * 256u) * 1024u; } };
struct DecAbs { __device__ __forceinline__ void operator()(int L, Unit& u) const { const unsigned kind = (unsigned)L >> 7, r = (unsigned)L & 127u, lb = r >> 4, h = (r >> 2) & 3u, t = r & 3u, lay = lb >> 1;
    if (kind == 0) { u.pm = (int)(lb * 4 + h); u.pn = (int)t; u.ao = (unsigned)(WS_MK / 2) + lb * 262144u + h * 256u; u.bo = (unsigned)(W_XQN / 2) + lay * 1048576u + t * 262144u + h * 256u; }
    else { u.pm = (int)(32 + lb * 4 + t); u.pn = (int)h; u.ao = (unsigned)(W_XO / 2) + lay * 1048576u + t * 262144u + h * 256u; u.bo = (unsigned)(WS_MV / 2) + lb * 262144u + h * 256u; } } };
struct DecGridB { DecGrid d; __device__ __forceinline__ void operator()(int L, Unit& u) const { d(L, u); u.bo += (unsigned)(u.pm >> 5) * 1048576u; } };
struct DecU { __device__ __forceinline__ void operator()(int L, Unit& u) const { const unsigned bhc = (unsigned)L >> 1, vh = L & 1; u.pm = L; u.pn = 0; u.ao = (bhc * 512u + vh * 256u) * 512u; u.bo = bhc * 131072u; } };
struct DecO { __device__ __forceinline__ void operator()(int L, Unit& u) const { const unsigned bhc = (unsigned)L >> 1, vh = L & 1; u.pm = L; u.pn = 0; u.ao = bhc * 256u * 512u; u.bo = (bhc * 512u + vh * 256u) * 512u; } };
struct DecXS { int layer; __device__ __forceinline__ void operator()(int L, Unit& u) const { u.pm = L >> 2; u.pn = L & 3; u.ao = (unsigned)u.pm * 256u * 1024u + (unsigned)u.pn * 256u; u.bo = ((unsigned)(layer * 2 + (u.pm >> 5)) * 256u) * 1024u + (unsigned)u.pn * 256u; } };
struct DecXPV { int layer; __device__ __forceinline__ void operator()(int L, Unit& u) const { u.pm = L >> 2; u.pn = L & 3; u.ao = (unsigned)u.pm * 256u * 1024u + (unsigned)u.pn * 256u; u.bo = ((unsigned)(layer * 2 + (u.pm >> 5)) * 1024u + (unsigned)u.pn * 256u) * 1024u; } };

__device__ __forceinline__ f32x4 mfma16(bf16x8 a, bf16x8 b, f32x4 c) { return __builtin_amdgcn_mfma_f32_16x16x32_bf16(a, b, c, 0, 0, 0); }
template <int RT = 8, class Epi>
__device__ __forceinline__ void sample_gemm(const Ctx& C, const bf16* A, int lda, int a_pn, const bf16* Bt, int ldb, unsigned b_pn, int K, int nunits, int skew, const Epi& E) {
    constexpr int NRB = 8 / RT;
    const int lane = olane(), r = lane & 15, g = lane >> 4, w = C.wave;
    const int first = (C.G - 1 - (int)blockIdx.x + skew) % C.G;
    int ks = K >> 3; asm volatile("" : "+s"(ks));
    LAS f32x4* P = (LAS f32x4*)(C.lds + RING_OFF);
    for (int su = first; su < nunits * NRB; su += C.G) { const int rb = su % NRB, sj = su / NRB, pn = sj >> 3, j = sj & 7;
        const bf16* ap = A + (size_t)(rb * 16 * RT + r) * lda + (size_t)pn * a_pn + w * ks + 8 * g;
        const bf16* bp0 = Bt + (size_t)pn * b_pn + (size_t)(16 * j + r) * ldb + w * ks + 8 * g; const bf16* bp1 = bp0 + (size_t)128 * ldb;
        f32x4 acc[RT][2];
#pragma unroll
        for (int rt = 0; rt < RT; ++rt) { acc[rt][0] = (f32x4){0.f, 0.f, 0.f, 0.f}; acc[rt][1] = (f32x4){0.f, 0.f, 0.f, 0.f}; }
#pragma unroll 4
        for (int k0 = 0; k0 < ks; k0 += 32) { const bf16x8 b0 = *(const bf16x8*)(bp0 + k0), b1 = *(const bf16x8*)(bp1 + k0); bf16x8 a[RT];
#pragma unroll
            for (int rt = 0; rt < RT; ++rt) a[rt] = *(const bf16x8*)(ap + (size_t)(16 * rt) * lda + k0);
#pragma unroll
            for (int rt = 0; rt < RT; ++rt) { acc[rt][0] = mfma16(b0, a[rt], acc[rt][0]); acc[rt][1] = mfma16(b1, a[rt], acc[rt][1]); } }
#pragma unroll
        for (int rt = 0; rt < RT; ++rt) { P[((w * RT + rt) * 2 + 0) * 64 + lane] = acc[rt][0]; P[((w * RT + rt) * 2 + 1) * 64 + lane] = acc[rt][1]; }
        __syncthreads();
        if (w < RT) {
            f32x4 v0 = P[((0 * RT + w) * 2 + 0) * 64 + lane], v1 = P[((0 * RT + w) * 2 + 1) * 64 + lane];
#pragma unroll
            for (int ww = 1; ww < 8; ++ww) { v0 += P[((ww * RT + w) * 2 + 0) * 64 + lane]; v1 += P[((ww * RT + w) * 2 + 1) * 64 + lane]; }
            E.quad(rb * 16 * RT + 16 * w + r, pn, 16 * j + 4 * g, v0, v1, g); }
        __syncthreads(); }
}


__device__ __forceinline__ void swa_unit(const Ctx& C, int unit, const bf16* QS, const bf16* KS, const bf16* VT, const float* sinks, bf16* AO) {
    const int kvh = unit & 3, qb = (unit >> 2) & 63, b = unit >> 8;
    const int lane_ = olane(); const int w = C.wave, l15 = lane_ & 15, g = lane_ >> 4, tid = w * 64 + lane_;
    const int head = kvh * 4 + (w >> 1);
    const float sink = sinks[head] * LOG2E;
    LAS unsigned char* KL = C.lds; LAS unsigned char* VL = C.lds + 40960;
    const int kstart = qb * 128 - 144;
    bf16x8 qf[4][2];
#pragma unroll
    for (int qt = 0; qt < 4; ++qt)
#pragma unroll
        for (int st = 0; st < 2; ++st) qf[qt][st] = *(const bf16x8*)(QS + ((size_t)b * 8192 + qb * 128 + (w & 1) * 64 + qt * 16 + l15) * 1024 + head * 64 + st * 32 + 8 * g);
    for (int c = tid; c < 2176; c += 512) { const int row = c >> 3, ch = c & 7, key = kstart + row;
        u32x4 v = (u32x4){0u, 0u, 0u, 0u}; if (key >= 0) v = *(const u32x4*)(KS + ((size_t)b * 8192 + key) * 256 + kvh * 64 + ch * 8);
        *(LAS u32x4*)(KL + row * 144 + ch * 16) = v; }
    for (int c = tid; c < 2176; c += 512) { const int d = c / 34, ch = c - d * 34, key0 = kstart + ch * 8;
        u32x4 v = (u32x4){0u, 0u, 0u, 0u}; if (key0 >= 0) v = *(const u32x4*)(VT + ((size_t)(b * 256 + kvh * 64 + d)) * 8192 + key0);
        *(LAS u32x4*)(VL + d * 560 + ch * 16) = v; }
    __syncthreads();
#pragma unroll 1
    for (int qt = 0; qt < 4; ++qt) {
        const int q0 = qb * 128 + (w & 1) * 64 + qt * 16, tb = (w & 1) * 4 + qt;
        const size_t qrow = (size_t)b * 8192 + q0 + l15;
        bf16x8 q0f = qf[0][0], q1f = qf[0][1];
        if (qt == 1) { q0f = qf[1][0]; q1f = qf[1][1]; } else if (qt == 2) { q0f = qf[2][0]; q1f = qf[2][1]; } else if (qt == 3) { q0f = qf[3][0]; q1f = qf[3][1]; }
        f32x4 s[10];
#pragma unroll
        for (int kt = 0; kt < 10; ++kt) { const LAS unsigned char* kp = KL + ((tb + kt) * 16 + l15) * 144 + g * 16;
            const bf16x8 k0 = *(const LAS bf16x8*)kp, k1 = *(const LAS bf16x8*)(kp + 64);
            f32x4 a = (f32x4){0.f, 0.f, 0.f, 0.f}; a = mfma16(k0, q0f, a); a = mfma16(k1, q1f, a); s[kt] = a; }
        float mx = sink;
#pragma unroll
        for (int kt = 0; kt < 10; ++kt)
#pragma unroll
            for (int e = 0; e < 4; ++e) { const int key = kstart + (tb + kt) * 16 + 4 * g + e, df = q0 + l15 - key; const bool ok = key >= 0 && df >= 0 && df <= 128;
                s[kt][e] = ok ? s[kt][e] : -3.0e38f; mx = fmaxf(mx, s[kt][e]); }
        mx = fmaxf(mx, __shfl_xor(mx, 16)); mx = fmaxf(mx, __shfl_xor(mx, 32));
        float sum = 0.f;
#pragma unroll
        for (int kt = 0; kt < 10; ++kt)
#pragma unroll
            for (int e = 0; e < 4; ++e) { const float p = __builtin_amdgcn_exp2f(s[kt][e] - mx); s[kt][e] = p; sum += p; }
        sum += __shfl_xor(sum, 16); sum += __shfl_xor(sum, 32);
        sum += __builtin_amdgcn_exp2f(sink - mx);
        const float inv = 1.f / sum;
        f32x4 o[4];
#pragma unroll
        for (int dt = 0; dt < 4; ++dt) o[dt] = (f32x4){0.f, 0.f, 0.f, 0.f};
#pragma unroll
        for (int ks = 0; ks < 5; ++ks) {
            const u32x4 pw = pack8(s[2 * ks], s[2 * ks + 1]); const bf16x8 pf = __builtin_bit_cast(bf16x8, pw);
            const int kb0 = (tb + 2 * ks) * 16 + 4 * g;
#pragma unroll
            for (int dt = 0; dt < 4; ++dt) { const LAS unsigned char* vp = VL + (dt * 16 + l15) * 560 + kb0 * 2;
                const u32x2 v0 = *(const LAS u32x2*)vp, v1 = *(const LAS u32x2*)(vp + 32);
                const u32x4 vw = (u32x4){v0.x, v0.y, v1.x, v1.y};
                o[dt] = mfma16(__builtin_bit_cast(bf16x8, vw), pf, o[dt]); } }
#pragma unroll
        for (int dt = 0; dt < 4; ++dt) { u32x2 wv; wv.x = cvt_pk_bf16(o[dt][0] * inv, o[dt][1] * inv); wv.y = cvt_pk_bf16(o[dt][2] * inv, o[dt][3] * inv);
            *(u32x2*)(AO + qrow * 1024 + head * 64 + dt * 16 + 4 * g) = wv; }
    }
    __syncthreads();
}

__device__ __forceinline__ void swa_sample_half(const Ctx& C, int unit, const float* SWQ, const float* ck, const float* cv, const float* sinks, float* out, bf16* AO) {
    LAS float* KV = (LAS float*)(C.lds);
    LAS float* SC = (LAS float*)(C.lds + 66560);
    const int b = unit >> 1, h2 = unit & 1, tid = otid(), lane = tid & 63, w = C.wave;
    const float* q = SWQ + (size_t)b * 1536;
    for (int pass = 0; pass < 2; ++pass) {
        const float* cache = (pass == 0 ? ck : cv) + (size_t)b * 128 * 256 + h2 * 128; float* oc = out + (pass == 0 ? O_SWKS : O_SWVS) + (size_t)b * 128 * 256 + h2 * 128;
        const float* nw = q + (pass == 0 ? 1024 : 1280) + h2 * 128;
        { f32x4 v[8];
#pragma unroll
          for (int i = 0; i < 8; ++i) { const int idx = tid + 512 * i; v[i] = ld4(cache + (size_t)(idx >> 5) * 256 + 4 * (idx & 31)); }
#pragma unroll
          for (int i = 0; i < 8; ++i) { const int idx = tid + 512 * i; *(LAS f32x4*)(KV + (idx >> 5) * 128 + 4 * (idx & 31)) = v[i]; } }
        if (tid < 32) { const f32x4 v = ld4(nw + 4 * tid); *(LAS f32x4*)(KV + 128 * 128 + 4 * tid) = v; st4(oc + (size_t)127 * 256 + 4 * tid, v); }
        __syncthreads();
        if (pass == 0) {
            const int jq = lane >> 4, dq = lane & 15, h = 8 * h2 + w; const f32x4 q4 = ld4(q + h * 64 + 4 * dq);
            for (int j0 = 0; j0 < 132; j0 += 4) { const int j = j0 + jq; const int jc = j < 129 ? j : 128;
                const f32x4 k4 = *(const LAS f32x4*)(KV + jc * 128 + (w >> 2) * 64 + 4 * dq);
                float p = (q4[0] * k4[0] + q4[1] * k4[1]) + (q4[2] * k4[2] + q4[3] * k4[3]);
                p += __shfl_xor(p, 1); p += __shfl_xor(p, 2); p += __shfl_xor(p, 4); p += __shfl_xor(p, 8);
                if (dq == 0 && j < 129) SC[w * 132 + j] = p; }
            LDS_WAIT(); asm volatile("" ::: "memory");
            { const float sink = sinks[h] * LOG2E;
                const float s0 = SC[w * 132 + lane], s1 = SC[w * 132 + 64 + lane], s2 = lane == 0 ? SC[w * 132 + 128] : -3.0e38f;
                const float mx = fmaxf(wave_max(fmaxf(fmaxf(s0, s1), s2)), sink);
                const float p0 = __builtin_amdgcn_exp2f(s0 - mx), p1 = __builtin_amdgcn_exp2f(s1 - mx), p2 = lane == 0 ? __builtin_amdgcn_exp2f(s2 - mx) : 0.f;
                const float inv = 1.f / (wave_sum(p0 + p1 + p2) + __builtin_amdgcn_exp2f(sink - mx));
                SC[w * 132 + lane] = p0 * inv; SC[w * 132 + 64 + lane] = p1 * inv; if (lane == 0) SC[w * 132 + 128] = p2 * inv; }
            __syncthreads();
        } else {
            const int d2 = lane & 31, jh = lane >> 5; float o0 = 0.f, o1 = 0.f;
#pragma unroll 4
            for (int j = jh; j < 129; j += 2) { const float p = SC[w * 132 + j]; const f32x2 v = *(const LAS f32x2*)(KV + j * 128 + (w >> 2) * 64 + 2 * d2); o0 += p * v.x; o1 += p * v.y; }
            o0 += __shfl_xor(o0, 32); o1 += __shfl_xor(o1, 32);
            if (jh == 0) *(unsigned*)(AO + (size_t)(MP + b) * 1024 + (8 * h2 + w) * 64 + 2 * d2) = cvt_pk_bf16(o0, o1);
            __syncthreads();
        }
    }
}
__device__ __forceinline__ void swa_state_copy(const Ctx& C, int b, const float* ck, const float* cv, float* out) {
    const int tid = otid();
    for (int pass = 0; pass < 2; ++pass) {
        const float* src = (pass == 0 ? ck : cv) + (size_t)b * 32768 + 256; float* dst = out + (pass == 0 ? O_SWKS : O_SWVS) + (size_t)b * 32768;
#pragma unroll 1
        for (int i0 = tid; i0 < 8128; i0 += 2048) { f32x4 v[4];
#pragma unroll
            for (int k = 0; k < 4; ++k) { const int i = i0 + 512 * k; v[k] = ld4(src + 4 * (size_t)(i < 8128 ? i : 8127)); }
#pragma unroll
            for (int k = 0; k < 4; ++k) { const int i = i0 + 512 * k; if (i < 8128) st4(dst + 4 * (size_t)i, v[k]); } }
    }
}

__device__ __forceinline__ void ret_sample_unit(const Ctx& C, int unit, const float* SQ, const float* state, const bf16* Gt, float* out, bf16* UB, LAS unsigned char* lb) {
    const int b = unit >> 2, h = unit & 3, tid = otid(), lane_ = tid & 63;
    LAS float* QK = (LAS float*)(lb);
    LAS float* RED = (LAS float*)(lb + 2048);
    LAS float* R2 = (LAS float*)(lb + 2048 + 8192);
    QK[tid] = SQ[(size_t)b * 4096 + (tid < 256 ? h * 256 + tid : 1024 + h * 256 + (tid - 256))];
    const int rg = tid >> 7, c4 = tid & 127;
    const f32x4 v4 = ld4(SQ + (size_t)b * 4096 + 2048 + h * 512 + 4 * c4);
    __syncthreads();
    const float gh = __builtin_amdgcn_exp2f(lg2g(h));
    const float* S = state + ((size_t)(b * 4 + h) * 256) * 512 + 4 * c4; float* So = out + O_RETS + ((size_t)(b * 4 + h) * 256) * 512 + 4 * c4;
    f32x4 a = (f32x4){0.f, 0.f, 0.f, 0.f};
    for (int it = 0; it < 64; it += 8) { f32x4 s[8];
#pragma unroll
        for (int k = 0; k < 8; ++k) s[k] = ld4(S + (size_t)((it + k) * 4 + rg) * 512);
#pragma unroll
        for (int k = 0; k < 8; ++k) { const int d = (it + k) * 4 + rg; const f32x4 sn = s[k] * gh + v4 * QK[256 + d]; st4(So + (size_t)d * 512, sn); a += sn * QK[d]; } }
    *(LAS f32x4*)(RED + rg * 512 + 4 * c4) = a;
    __syncthreads();
    f32x4 o = (f32x4){0.f, 0.f, 0.f, 0.f};
    if (tid < 128) { o = *(LAS f32x4*)(RED + 4 * tid) + *(LAS f32x4*)(RED + 512 + 4 * tid) + *(LAS f32x4*)(RED + 1024 + 4 * tid) + *(LAS f32x4*)(RED + 1536 + 4 * tid);
        const float s1 = wave_sum((o[0] + o[1]) + (o[2] + o[3])); if (lane_ == 0) R2[C.wave] = s1; }
    __syncthreads();
    const float mu = (R2[0] + R2[1]) * (1.f / 512.f);
    if (tid < 128) { const f32x4 dd = o - mu; const float s2 = wave_sum((dd[0] * dd[0] + dd[1] * dd[1]) + (dd[2] * dd[2] + dd[3] * dd[3])); if (lane_ == 0) R2[8 + C.wave] = s2; }
    __syncthreads();
    if (tid < 128) { const float rstd = __builtin_amdgcn_rsqf((R2[8] + R2[9]) * (1.f / 512.f) + EPS);
        const u32x2 gw = *(const u32x2*)(Gt + (size_t)(MP + b) * 2048 + h * 512 + 4 * tid);
        u32x2 wv; wv.x = cvt_pk_bf16(bflo(gw.x) * (o[0] - mu) * rstd, bfhi(gw.x) * (o[1] - mu) * rstd); wv.y = cvt_pk_bf16(bflo(gw.y) * (o[2] - mu) * rstd, bfhi(gw.y) * (o[3] - mu) * rstd);
        *(u32x2*)(UB + (size_t)(MP + b) * 2048 + h * 512 + 4 * tid) = wv; }
    __syncthreads();
}

__device__ __forceinline__ void xs_sample_unit(const Ctx& C, int unit, const bf16* QX, const float* cmk, const float* cmv, bf16* OX, LAS unsigned char* lb) {
    const int b = unit >> 2, h = unit & 3, tid = otid(), lane = tid & 63, w = C.wave;
    LAS float* SC = (LAS float*)(lb);
    LAS float* RED = (LAS float*)(lb + 1024);
    const u32x2 qw = *(const u32x2*)(QX + (size_t)(MP + b) * 1024 + h * 256 + 4 * lane);
    const f32x4 q4 = (f32x4){bflo(qw.x), bfhi(qw.x), bflo(qw.y), bfhi(qw.y)};
    const float* Kp = cmk + ((size_t)b * 256) * 1024 + h * 256 + 4 * lane; const float* Vp = cmv + ((size_t)b * 256) * 1024 + h * 256 + 4 * lane;
    for (int i0 = 0; i0 < 32; i0 += 8) { f32x4 k[8];
#pragma unroll
        for (int k8 = 0; k8 < 8; ++k8) k[k8] = ld4(Kp + (size_t)(w * 32 + i0 + k8) * 1024);
#pragma unroll
        for (int k8 = 0; k8 < 8; ++k8) { const float p = wave_sum((q4[0] * k[k8][0] + q4[1] * k[k8][1]) + (q4[2] * k[k8][2] + q4[3] * k[k8][3])); if (lane == 0) SC[w * 32 + i0 + k8] = p; } }
    f32x4 v[8];
#pragma unroll
    for (int k8 = 0; k8 < 8; ++k8) v[k8] = ld4(Vp + (size_t)(w * 32 + k8) * 1024);
    __syncthreads();
    const float mx = wave_max(fmaxf(fmaxf(SC[lane], SC[64 + lane]), fmaxf(SC[128 + lane], SC[192 + lane])));
    const float sum = wave_sum((__builtin_amdgcn_exp2f(SC[lane] - mx) + __builtin_amdgcn_exp2f(SC[64 + lane] - mx)) + (__builtin_amdgcn_exp2f(SC[128 + lane] - mx) + __builtin_amdgcn_exp2f(SC[192 + lane] - mx)));
    f32x4 a = (f32x4){0.f, 0.f, 0.f, 0.f};
#pragma unroll
    for (int i0 = 0; i0 < 32; i0 += 8) { f32x4 n[8];
        if (i0 + 8 < 32) {
#pragma unroll
            for (int k8 = 0; k8 < 8; ++k8) n[k8] = ld4(Vp + (size_t)(w * 32 + i0 + 8 + k8) * 1024); }
#pragma unroll
        for (int k8 = 0; k8 < 8; ++k8) a += v[k8] * __builtin_amdgcn_exp2f(SC[w * 32 + i0 + k8] - mx);
        if (i0 + 8 < 32) {
#pragma unroll
            for (int k8 = 0; k8 < 8; ++k8) v[k8] = n[k8]; } }
    *(LAS f32x4*)(RED + w * 256 + 4 * lane) = a;
    __syncthreads();
    if (tid < 64) { f32x4 o = (f32x4){0.f, 0.f, 0.f, 0.f};
#pragma unroll
        for (int k = 0; k < 8; ++k) o += *(LAS f32x4*)(RED + k * 256 + 4 * tid);
        const float inv = 1.f / sum; u32x2 wv; wv.x = cvt_pk_bf16(o[0] * inv, o[1] * inv); wv.y = cvt_pk_bf16(o[2] * inv, o[3] * inv);
        *(u32x2*)(OX + (size_t)(MP + b) * 1024 + h * 256 + 4 * tid) = wv; }
    __syncthreads();
}

__device__ __forceinline__ void conv_mix_rows(const Ctx& C, const Args& args, unsigned char* ws, int row0, int row1) {
    const int gw = C.vcu * 8 + C.wave, NGW = C.G * 8;
        const bf16* BG = (const bf16*)(ws + WS_Q); const bf16* CI = (const bf16*)(ws + WS_KB); bf16* UB = (bf16*)(ws + WS_UB); const float* cw = KIN(I_CW); const int lane_ = olane();
    for (int row = row0 + gw; row < row1; row += NGW) {
#pragma unroll
            for (int hf = 0; hf < 2; ++hf) { const int col = hf * 512 + 8 * lane_; float c0[8], c1[8], c2[8];
                if (row < MP) { const int t = row & 8191;
                    const u32x4 z = (u32x4){0u, 0u, 0u, 0u};
                    const u32x4 a0 = t >= 2 ? *(const u32x4*)(CI + (size_t)(row - 2) * 1024 + col) : z, a1 = t >= 1 ? *(const u32x4*)(CI + (size_t)(row - 1) * 1024 + col) : z, a2 = *(const u32x4*)(CI + (size_t)row * 1024 + col);
#pragma unroll
                    for (int k = 0; k < 4; ++k) { c0[2 * k] = bflo(a0[k]); c0[2 * k + 1] = bfhi(a0[k]); c1[2 * k] = bflo(a1[k]); c1[2 * k + 1] = bfhi(a1[k]); c2[2 * k] = bflo(a2[k]); c2[2 * k + 1] = bfhi(a2[k]); }
                } else { const int b = row - MP; const float* sc = KIN(I_SCONV) + (size_t)b * 2048 + col; const float* cn = args.out + O_CONVS + ((size_t)b * 2 + 1) * 1024 + col; float* co = args.out + O_CONVS + ((size_t)b * 2) * 1024 + col;
#pragma unroll
                    for (int k = 0; k < 8; ++k) { c0[k] = sc[k]; c1[k] = sc[1024 + k]; c2[k] = cn[k]; co[k] = c1[k]; } }
                const u32x4 bgv = *(const u32x4*)(BG + (size_t)row * 1024 + col); float o[8];
#pragma unroll
                for (int k = 0; k < 8; ++k) { const float bgk = (k & 1) ? bfhi(bgv[k >> 1]) : bflo(bgv[k >> 1]); o[k] = bgk * (cw[col + k] * c0[k] + cw[1024 + col + k] * c1[k] + cw[2048 + col + k] * c2[k]); }
                u32x4 r; r.x = cvt_pk_bf16(o[0], o[1]); r.y = cvt_pk_bf16(o[2], o[3]); r.z = cvt_pk_bf16(o[4], o[5]); r.w = cvt_pk_bf16(o[6], o[7]);
                *(u32x4*)(UB + (size_t)row * 1024 + col) = r; } }
}
__device__ __forceinline__ void conv_mix_sample(const Ctx& C, const Args& args, unsigned char* ws) {
    const int gw = C.vcu * 8 + C.wave, NGW = C.G * 8, lane_ = olane();
    const bf16* BG = (const bf16*)(ws + WS_Q); bf16* UB = (bf16*)(ws + WS_UB); const float* cw = KIN(I_CW);
    for (int item = gw; item < 256; item += NGW) { const int b = item >> 1, col = (item & 1) * 512 + 8 * lane_; const size_t row = (size_t)MP + b;
        const float* sc = KIN(I_SCONV) + (size_t)b * 2048 + col; const float* cn = args.out + O_CONVS + ((size_t)b * 2 + 1) * 1024 + col; float* co = args.out + O_CONVS + ((size_t)b * 2) * 1024 + col;
        const f32x4 a0 = ld4(sc), a1 = ld4(sc + 4), b0 = ld4(sc + 1024), b1 = ld4(sc + 1028), c0 = ld4(cn), c1 = ld4(cn + 4);
        const u32x4 bgv = *(const u32x4*)(BG + row * 1024 + col);
        const f32x4 w00 = ld4(cw + col), w01 = ld4(cw + col + 4), w10 = ld4(cw + 1024 + col), w11 = ld4(cw + 1024 + col + 4), w20 = ld4(cw + 2048 + col), w21 = ld4(cw + 2048 + col + 4);
        st4(co, b0); st4(co + 4, b1);
        const f32x4 o0 = (f32x4){bflo(bgv.x), bfhi(bgv.x), bflo(bgv.y), bfhi(bgv.y)} * (w00 * a0 + w10 * b0 + w20 * c0), o1 = (f32x4){bflo(bgv.z), bfhi(bgv.z), bflo(bgv.w), bfhi(bgv.w)} * (w01 * a1 + w11 * b1 + w21 * c1);
        *(u32x4*)(UB + row * 1024 + col) = pack8(o0, o1); }
}
__device__ __forceinline__ void pool_mix_rows(const Ctx& C, const Args& args, unsigned char* ws, int item0, int item1) {
    const int gw = C.vcu * 8 + C.wave, NGW = C.G * 8;
        const u64* ss = (const u64*)(ws + WS_SS) + (size_t)9 * MT; const bf16* XB = (const bf16*)(ws + WS_XB); const float* ng = KIN(I_NG) + 9 * 1024; bf16* UB = (bf16*)(ws + WS_UB); const int lane_ = olane();
    for (int item = item0 + gw; item < item1; item += NGW) { const int row = item >> 2, gi = item & 3, w = 2 << gi, col = gi * 256 + 4 * lane_;
            const f32x4 g4 = ld4(ng + col);
#define LDX(rr) ({ const u32x2 t_ = *(const u32x2*)(XB + (size_t)(rr) * 1024 + col); (f32x4){bflo(t_.x), bfhi(t_.x), bflo(t_.y), bfhi(t_.y)}; })
            const f32x4 hn = LDX(row) * rstd_of(ss[row]) * g4; f32x4 sum = hn; float cnt;
            if (row < MP) { const int t = row & 8191; const int n = (t + 1 < w) ? t + 1 : w; cnt = (float)n;
                for (int j = 1; j < n; ++j) sum += LDX(row - j) * rstd_of(ss[row - j]) * g4;
                if (t >= 8177) st4(args.out + O_POOLP + ((size_t)(row >> 13) * 15 + (t - 8177)) * 1024 + col, hn);
            } else { const int b = row - MP; cnt = (float)w; const float* sp = KIN(I_SPOOL) + (size_t)b * 15 * 1024 + col;
                for (int j = 1; j < w; ++j) sum += ld4(sp + (size_t)(15 - j) * 1024);
                st4(args.out + O_POOLS + ((size_t)b * 15 + 14) * 1024 + col, hn); }
#undef LDX
            const f32x4 dd = sum * (1.f / cnt) - hn; u32x2 wv; wv.x = cvt_pk_bf16(dd[0], dd[1]); wv.y = cvt_pk_bf16(dd[2], dd[3]);
            *(u32x2*)(UB + (size_t)row * 1024 + col) = wv; }
}
__device__ __forceinline__ void pool_mix_sample(const Ctx& C, const Args& args, unsigned char* ws) {
    const int gw = C.vcu * 8 + C.wave, NGW = C.G * 8, lane_ = olane();
    const u64* ss = (const u64*)(ws + WS_SS) + (size_t)9 * MT; const bf16* XB = (const bf16*)(ws + WS_XB); const float* ng = KIN(I_NG) + 9 * 1024; bf16* UB = (bf16*)(ws + WS_UB);
    for (int item = gw; item < 512; item += NGW) { const int b = item >> 2, gi = item & 3, w = 2 << gi, col = gi * 256 + 4 * lane_; const size_t row = (size_t)MP + b;
        const float* sp = KIN(I_SPOOL) + (size_t)b * 15 * 1024 + col;
        const f32x4 g4 = ld4(ng + col); const u32x2 xv = *(const u32x2*)(XB + row * 1024 + col); const u64 sv = ss[row];
        f32x4 st[15];
#pragma unroll
        for (int j = 1; j < 16; ++j) st[j - 1] = ld4(sp + (size_t)(15 - j) * 1024);
        const f32x4 hn = (f32x4){bflo(xv.x), bfhi(xv.x), bflo(xv.y), bfhi(xv.y)} * rstd_of(sv) * g4; f32x4 sum = hn;
#pragma unroll
        for (int j = 1; j < 16; ++j) if (j < w) sum += st[j - 1];
        st4(args.out + O_POOLS + ((size_t)b * 15 + 14) * 1024 + col, hn);
        const f32x4 dd = sum * (1.f / (float)w) - hn;
        *(u32x2*)(UB + row * 1024 + col) = (u32x2){cvt_pk_bf16(dd[0], dd[1]), cvt_pk_bf16(dd[2], dd[3])}; }
}
__device__ __forceinline__ void pool_state_copy(const Ctx& C, int b, const float* spool, float* out) {
    const int tid = otid(); const float* src = spool + ((size_t)b * 15 + 1) * 1024; float* dst = out + O_POOLS + (size_t)b * 15 * 1024; f32x4 v[7];
#pragma unroll
    for (int k = 0; k < 7; ++k) v[k] = ld4(src + 4 * (size_t)(tid + 512 * k));
#pragma unroll
    for (int k = 0; k < 7; ++k) st4(dst + 4 * (size_t)(tid + 512 * k), v[k]);
}
__device__ __forceinline__ void final_rows(const Ctx& C, const Args& args, unsigned char* ws, int row0, int row1) {
    const int gw = C.vcu * 8 + C.wave, NGW = C.G * 8;
        const u64* ss = (const u64*)(ws + WS_SS) + (size_t)12 * MT; const float* fg = KIN(I_FNG); const int lane_ = olane(); const bf16* XB = (const bf16*)(ws + WS_XB); float* xf = args.out;
        f32x4 gg[4];
#pragma unroll
        for (int hf = 0; hf < 2; ++hf) { gg[2 * hf] = ld4(fg + hf * 512 + 8 * lane_); gg[2 * hf + 1] = ld4(fg + hf * 512 + 8 * lane_ + 4); }
        for (int row = row0 + gw; row < row1; row += 2 * NGW) { const int row2 = (row + NGW < row1) ? row + NGW : row;
            u32x4 v[2], w[2];
#pragma unroll
            for (int hf = 0; hf < 2; ++hf) { v[hf] = *(const u32x4*)(XB + (size_t)row * 1024 + hf * 512 + 8 * lane_); w[hf] = *(const u32x4*)(XB + (size_t)row2 * 1024 + hf * 512 + 8 * lane_); }
            const float r = rstd_of(ss[row]), r2 = rstd_of(ss[row2]);
#pragma unroll
            for (int hf = 0; hf < 2; ++hf) { float* o = xf + (size_t)row * 1024 + hf * 512 + 8 * lane_;
                st4(o, (f32x4){bflo(v[hf].x), bfhi(v[hf].x), bflo(v[hf].y), bfhi(v[hf].y)} * r * gg[2 * hf]); st4(o + 4, (f32x4){bflo(v[hf].z), bfhi(v[hf].z), bflo(v[hf].w), bfhi(v[hf].w)} * r * gg[2 * hf + 1]); }
            if (row2 != row) {
#pragma unroll
                for (int hf = 0; hf < 2; ++hf) { float* o = xf + (size_t)row2 * 1024 + hf * 512 + 8 * lane_;
                    st4(o, (f32x4){bflo(w[hf].x), bfhi(w[hf].x), bflo(w[hf].y), bfhi(w[hf].y)} * r2 * gg[2 * hf]); st4(o + 4, (f32x4){bflo(w[hf].z), bfhi(w[hf].z), bflo(w[hf].w), bfhi(w[hf].w)} * r2 * gg[2 * hf + 1]); } } }
}


__device__ __forceinline__ f32x4 bf4(u32x2 t) { return (f32x4){bflo(t.x), bfhi(t.x), bflo(t.y), bfhi(t.y)}; }
__device__ __forceinline__ void pool_mix_runs(const Ctx& C, unsigned char* ws, float* out) {
    const int gw = C.vcu * 8 + C.wave, NGW = C.G * 8, lane_ = olane();
    const u64* ss = (const u64*)(ws + WS_SS) + (size_t)9 * MT; const bf16* XBp = (const bf16*)(ws + WS_XB); bf16* UB = (bf16*)(ws + WS_UB); const float* ng = KIN(I_NG) + 9 * 1024;
    for (int item = gw; item < (MP / 32) * 4; item += NGW) { const int gi = item & 3, row0 = (item >> 2) * 32, t0 = row0 & 8191, w = 2 << gi, col = gi * 256 + 4 * lane_;
        const f32x4 g4 = ld4(ng + col);
        f32x4 sum = (f32x4){0.f, 0.f, 0.f, 0.f};
        if (t0 > 0) {
            u32x2 a[16]; u64 sa[16];
#pragma unroll
            for (int j = 0; j < 16; ++j) { const int r = row0 - 1 - (j < w ? j : 0); a[j] = *(const u32x2*)(XBp + (size_t)r * 1024 + col); sa[j] = ss[r]; }
#pragma unroll
            for (int j = 0; j < 16; ++j) if (j < w) sum += bf4(a[j]) * (rstd_of(sa[j]) * g4);
        }
#pragma unroll 1
        for (int k0 = 0; k0 < 32; k0 += 8) { u32x2 a[8], o[8]; u64 sa[8], so[8];
#pragma unroll
            for (int k = 0; k < 8; ++k) { const int r = row0 + k0 + k, ro = (t0 + k0 + k - w >= 0) ? r - w : r; a[k] = *(const u32x2*)(XBp + (size_t)r * 1024 + col); sa[k] = ss[r]; o[k] = *(const u32x2*)(XBp + (size_t)ro * 1024 + col); so[k] = ss[ro]; }
#pragma unroll
            for (int k = 0; k < 8; ++k) { const int r = row0 + k0 + k, t = t0 + k0 + k; const f32x4 hn = bf4(a[k]) * (rstd_of(sa[k]) * g4);
                sum += hn; if (t - w >= 0) sum -= bf4(o[k]) * (rstd_of(so[k]) * g4);
                const float cnt = (float)((t + 1 < w) ? t + 1 : w); const f32x4 dd = sum * (1.f / cnt) - hn;
                *(u32x2*)(UB + (size_t)r * 1024 + col) = (u32x2){cvt_pk_bf16(dd[0], dd[1]), cvt_pk_bf16(dd[2], dd[3])};
                if (t >= 8177) st4(out + O_POOLP + ((size_t)(r >> 13) * 15 + (t - 8177)) * 1024 + col, hn); } }
    }
}
__device__ __forceinline__ void conv_mix_runs(const Ctx& C, unsigned char* ws) {
    const int gw = C.vcu * 8 + C.wave, NGW = C.G * 8, lane_ = olane();
    const bf16* BG = (const bf16*)(ws + WS_Q); const bf16* CI = (const bf16*)(ws + WS_KB); bf16* UB = (bf16*)(ws + WS_UB); const float* cw = KIN(I_CW);
    for (int run = gw; run < MP / 8; run += NGW) { const int row0 = run * 8, t0 = row0 & 8191;
#pragma unroll 1
        for (int hf = 0; hf < 2; ++hf) { const int col = hf * 512 + 8 * lane_;
            u32x4 ci[10], bgv[8]; const u32x4 z = (u32x4){0u, 0u, 0u, 0u};
#pragma unroll
            for (int k = 0; k < 10; ++k) ci[k] = (t0 + k - 2 >= 0) ? *(const u32x4*)(CI + (size_t)(row0 + k - 2) * 1024 + col) : z;
#pragma unroll
            for (int k = 0; k < 8; ++k) bgv[k] = *(const u32x4*)(BG + (size_t)(row0 + k) * 1024 + col);
            f32x4 w0[2], w1[2], w2[2];
#pragma unroll
            for (int q = 0; q < 2; ++q) { w0[q] = ld4(cw + col + 4 * q); w1[q] = ld4(cw + 1024 + col + 4 * q); w2[q] = ld4(cw + 2048 + col + 4 * q); }
#pragma unroll
            for (int k = 0; k < 8; ++k) { u32x4 r;
#pragma unroll
                for (int q = 0; q < 2; ++q) { const f32x4 c0 = bf4((u32x2){ci[k][2 * q], ci[k][2 * q + 1]}), c1 = bf4((u32x2){ci[k + 1][2 * q], ci[k + 1][2 * q + 1]}), c2 = bf4((u32x2){ci[k + 2][2 * q], ci[k + 2][2 * q + 1]});
                    const f32x4 o = bf4((u32x2){bgv[k][2 * q], bgv[k][2 * q + 1]}) * (w0[q] * c0 + w1[q] * c1 + w2[q] * c2);
                    r[2 * q] = cvt_pk_bf16(o[0], o[1]); r[2 * q + 1] = cvt_pk_bf16(o[2], o[3]); }
                *(u32x4*)(UB + (size_t)(row0 + k) * 1024 + col) = r; } }
    }
}


__device__ __forceinline__ void xattn_unit(const Ctx& C, int pm, int h, int lb  , const bf16* Q, const bf16* MK, const bf16* MVT, bf16* OX) {
    const int lane_ = olane(), w = C.wave, l15 = lane_ & 15, g = lane_ >> 4, tid = w * 64 + lane_;
    LAS unsigned char* KL = C.lds;
    {   u32x4 st[16];
#pragma unroll
        for (int i = 0; i < 16; ++i) { const int c = tid + 512 * i, row = c >> 5, ch = c & 31; st[i] = *(const u32x4*)(MK + ((size_t)lb * 256 + row) * 1024 + h * 256 + ch * 8); }
#pragma unroll
        for (int i = 0; i < 16; ++i) { const int c = tid + 512 * i, row = c >> 5, ch = c & 31; *(LAS u32x4*)(KL + row * 528 + ch * 16) = st[i]; } }
    __syncthreads();
    bf16x8 pf[2][8];
    float inv[2];
#pragma unroll
    for (int t = 0; t < 2; ++t) {
        bf16x8 qf[8];
#pragma unroll
        for (int ks = 0; ks < 8; ++ks) qf[ks] = *(const bf16x8*)(Q + ((size_t)pm * 256 + 32 * w + 16 * t + l15) * 1024 + h * 256 + ks * 32 + 8 * g);
        f32x4 sc[16];
#pragma unroll
        for (int kt = 0; kt < 16; ++kt) { f32x4 a0 = (f32x4){0.f, 0.f, 0.f, 0.f}; const LAS unsigned char* kp = KL + (kt * 16 + l15) * 528 + g * 16;
#pragma unroll
            for (int ks = 0; ks < 8; ++ks) a0 = mfma16(*(const LAS bf16x8*)(kp + ks * 64), qf[ks], a0);
            sc[kt] = a0; }
        float mx = -3.0e38f;
#pragma unroll
        for (int kt = 0; kt < 16; ++kt)
#pragma unroll
            for (int e = 0; e < 4; ++e) mx = fmaxf(mx, sc[kt][e]);
        mx = fmaxf(mx, __shfl_xor(mx, 16)); mx = fmaxf(mx, __shfl_xor(mx, 32));
        float z = 0.f;
#pragma unroll
        for (int kt = 0; kt < 16; ++kt)
#pragma unroll
            for (int e = 0; e < 4; ++e) { const float p = __builtin_amdgcn_exp2f(sc[kt][e] - mx); sc[kt][e] = p; z += p; }
        z += __shfl_xor(z, 16); z += __shfl_xor(z, 32);
        inv[t] = 1.f / z;
#pragma unroll
        for (int ks = 0; ks < 8; ++ks) pf[t][ks] = __builtin_bit_cast(bf16x8, pack8(sc[2 * ks], sc[2 * ks + 1]));
    }
    __syncthreads();
    {   u32x4 st[16];
#pragma unroll
        for (int i = 0; i < 16; ++i) { const int c = tid + 512 * i, row = c >> 5, ch = c & 31; st[i] = *(const u32x4*)(MVT + ((size_t)lb * 1024 + h * 256 + row) * 1024 + ch * 8); }
#pragma unroll
        for (int i = 0; i < 16; ++i) { const int c = tid + 512 * i, row = c >> 5, ch = c & 31; *(LAS u32x4*)(KL + row * 528 + ch * 16) = st[i]; } }
    __syncthreads();
    const int drow = 8 * (l15 >> 2) + (l15 & 3);
    bf16* o0p = OX + ((size_t)pm * 256 + 32 * w + l15) * 1024 + h * 256 + 8 * g; bf16* o1p = o0p + (size_t)16 * 1024;
#pragma unroll
    for (int dp = 0; dp < 8; ++dp) { f32x4 e0 = (f32x4){0.f, 0.f, 0.f, 0.f}, e1 = e0, f0 = e0, f1 = e0;
        const LAS unsigned char* vpe = KL + (32 * dp + drow) * 528 + g * 8; const LAS unsigned char* vpo = vpe + 4 * 528;
#pragma unroll
        for (int ks = 0; ks < 8; ++ks) { const u32x2 a = *(const LAS u32x2*)(vpe + ks * 64), b = *(const LAS u32x2*)(vpe + ks * 64 + 32), c2 = *(const LAS u32x2*)(vpo + ks * 64), d2 = *(const LAS u32x2*)(vpo + ks * 64 + 32);
            const bf16x8 ve = __builtin_bit_cast(bf16x8, (u32x4){a.x, a.y, b.x, b.y}), vo = __builtin_bit_cast(bf16x8, (u32x4){c2.x, c2.y, d2.x, d2.y});
            e0 = mfma16(ve, pf[0][ks], e0); e1 = mfma16(ve, pf[1][ks], e1); f0 = mfma16(vo, pf[0][ks], f0); f1 = mfma16(vo, pf[1][ks], f1); }
        st8b(o0p + 32 * dp, e0 * inv[0], f0 * inv[0]); st8b(o1p + 32 * dp, e1 * inv[1], f1 * inv[1]); }
    __syncthreads();
}

#define SSP(k) ((u64*)(ws + WS_SS) + (size_t)(k) * MT)
#define XBS ((bf16*)(ws + WS_XB) + (size_t)MP * 1024)
__device__ __forceinline__ void s_in0(const Ctx& C, unsigned char* ws) {
    EpiRetIn E{SSP(0), (const float*)(ws + T_CR), (const float*)(ws + T_SR), (bf16*)(ws + WS_Q), (bf16*)(ws + WS_KB), (bf16*)(ws + WS_APQ), (bf16*)(ws + WS_G), (float*)(ws + WS_SQ)};
    sample_gemm<8>(C, XBS, 1024, 0, (const bf16*)(ws + W_RET_IN), 1024, 262144u, 1024, 24 * 8, 0, E);
}
__device__ __forceinline__ void s_ret(const Ctx& C, unsigned char* ws, float* out, int un) {
    if (un < 512) ret_sample_unit(C, un, (const float*)(ws + WS_SQ), KIN(I_SRET), (const bf16*)(ws + WS_G), out, (bf16*)(ws + WS_UB), C.lds + EPIX_OFF); }
struct RetSide { Ctx C; unsigned char* ws; float* out; int slot, un;
    __device__ __forceinline__ void operator()(int ui) const { if (ui == slot) s_ret(C, ws, out, un); } };
__device__ __forceinline__ void s_out0(const Ctx& C, const Args& args, unsigned char* ws) {
    EpiResidual E{KIN(I_XP), KIN(I_XS), (bf16*)(ws + WS_XB), SSP(1)};
    sample_gemm<1>(C, (const bf16*)(ws + WS_UB) + (size_t)MP * 2048, 2048, 0, (const bf16*)(ws + W_RET_OUT), 2048, 256u * 2048u, 2048, 32, 0, E);
}
__device__ __forceinline__ void s_xq(const Ctx& C, unsigned char* ws, int L) {
    EpiScale E{SSP(3 * L + 1), LOG2E * 0.0625f, (bf16*)(ws + WS_Q), 1024};
    sample_gemm<2>(C, XBS, 1024, 0, (const bf16*)(ws + W_XQ + (size_t)L * 1048576 * 2), 1024, 262144u, 1024, 32, 0, E);
}
__device__ __forceinline__ void s_xo(const Ctx& C, unsigned char* ws, int L) {
    EpiResidual E{nullptr, nullptr, (bf16*)(ws + WS_XB), SSP(3 * L + 2)};
    sample_gemm<1>(C, (const bf16*)(ws + WS_OX) + (size_t)MP * 1024, 1024, 0, (const bf16*)(ws + W_XO + (size_t)L * 1048576 * 2), 1024, 262144u, 1024, 32, 0, E);
}
__device__ __forceinline__ void s_fin(const Ctx& C, unsigned char* ws, int L) {
    EpiSwiGLU E{SSP(3 * L + 2), (bf16*)(ws + WS_HF)};
    sample_gemm<8>(C, XBS, 1024, 0, (const bf16*)(ws + W_FIN + (size_t)L * 1024 * 5632 * 2), 1024, 262144u, 1024, 22 * 8, 0, E);
}
__device__ __forceinline__ void s_fout(const Ctx& C, unsigned char* ws, int L) {
    EpiResidual E{nullptr, nullptr, (bf16*)(ws + WS_XB), SSP(3 * L + 3)};
    sample_gemm<1>(C, (const bf16*)(ws + WS_HF) + (size_t)MP * DFF, DFF, 0, (const bf16*)(ws + W_FOUT + (size_t)L * 2816 * 1024 * 2), DFF, 256u * DFF, DFF, 32, 0, E);
}
__device__ __forceinline__ void s_in1(const Ctx& C, const Args& args, unsigned char* ws) {
    EpiSwaQKV E{SSP(3), (const float*)(ws + T_CS), (const float*)(ws + T_SN), (bf16*)(ws + WS_Q), (bf16*)(ws + WS_KB), (float*)(ws + WS_SQ), args.out};
    sample_gemm<2>(C, XBS, 1024, 0, (const bf16*)(ws + W_SWA_QKV), 1024, 262144u, 1024, 48, 0, E);
}
__device__ __forceinline__ void s_swa(const Ctx& C, const Args& args, unsigned char* ws) {
    for (int u = C.G - 1 - C.vcu; u < 256; u += C.G) swa_sample_half(C, u, (const float*)(ws + WS_SQ), KIN(I_CSK), KIN(I_CSV), KIN(I_SINK), args.out, (bf16*)(ws + WS_OX));
}
__device__ __forceinline__ void s_out1(const Ctx& C, unsigned char* ws) {
    EpiResidual E{nullptr, nullptr, (bf16*)(ws + WS_XB), SSP(4)};
    sample_gemm<2>(C, (const bf16*)(ws + WS_OX) + (size_t)MP * 1024, 1024, 0, (const bf16*)(ws + W_SWA_O), 1024, 262144u, 1024, 32, 0, E);
}
__device__ __forceinline__ void s_in2(const Ctx& C, const Args& args, unsigned char* ws) {
    EpiConvIn E{SSP(6), (bf16*)(ws + WS_Q), (bf16*)(ws + WS_KB), args.out};
    sample_gemm<4>(C, XBS, 1024, 0, (const bf16*)(ws + W_CONV_IN), 1024, 262144u, 1024, 96, 0, E);
}
__device__ __forceinline__ void s_out2(const Ctx& C, unsigned char* ws) {
    EpiResidual E{nullptr, nullptr, (bf16*)(ws + WS_XB), SSP(7)};
    sample_gemm<2>(C, (const bf16*)(ws + WS_UB) + (size_t)MP * 1024, 1024, 0, (const bf16*)(ws + W_CONV_OUT), 1024, 262144u, 1024, 32, 0, E);
}
__device__ __forceinline__ void s_out3(const Ctx& C, unsigned char* ws) {
    EpiResidual E{nullptr, nullptr, (bf16*)(ws + WS_XB), SSP(10)};
    sample_gemm<2>(C, (const bf16*)(ws + WS_UB) + (size_t)MP * 1024, 1024, 256, (const bf16*)(ws + W_POOL), 256, 65536u, 256, 32, 0, E);
}
template <int L> struct XsSide { Ctx C; unsigned char* ws; int u0, n, s0, s1, s2;
    __device__ __forceinline__ void run(int un) const {
        if (un < 512) xs_sample_unit(C, un, (const bf16*)(ws + WS_Q), KIN(I_CMK) + (size_t)L * 128 * 256 * 1024, KIN(I_CMV) + (size_t)L * 128 * 256 * 1024, (bf16*)(ws + WS_OX), C.lds + EPIX_OFF); }
    __device__ __forceinline__ void operator()(int ui) const {
        if (ui == s0 && n > 0) run(u0);
        if (ui == s1 && n > 1) run(u0 + 1);
        if (ui == s2 && n > 2) run(u0 + 2);
    }
};

enum { PH_PRO = 0, PH_SIN0, PH_R_IN, PH_R_PU, PH_R_SCAN, PH_R_O, PH_R_NORM, PH_R_OUT, PH_C0,
       PH_S_QKV = PH_C0 + 6, PH_S_ATT, PH_S_OUT, PH_C1, PH_V_IN = PH_C1 + 6, PH_V_MIX, PH_V_OUT, PH_C2, PH_P_MIX = PH_C2 + 6, PH_P_OUT, PH_C3, PH_E1 = PH_C3 + 6, PH_E2, PH_FINAL, NPH };

struct KS { unsigned char* ws; float* out; int lo, hi, G, bx; };
#if MK_ONE_LAUNCH
#define IN(k) ((k) <= DBG_LAST)
#else
#define IN(k) (K.lo <= (k) && (k) < K.hi)
#endif
#define AMP_HOOK(k) do { if (AMP_MASK != 0ull) { if (blockIdx.x == 0) { if (threadIdx.x == 0) { LAS unsigned long long* tp = (LAS unsigned long long*)(C.lds + MISC_OFF + 64); \
        const unsigned long long now = __builtin_amdgcn_s_memrealtime(), prev = *tp; \
        if ((AMP_MASK >> (k)) & 1ull) { const unsigned long long target = now + AMP_FACTOR * (now - prev); while (__builtin_amdgcn_s_memrealtime() < target) __builtin_amdgcn_s_sleep(8); } \
        *tp = __builtin_amdgcn_s_memrealtime(); } __syncthreads(); } } } while (0)
#define SEAM(k) do { if (MK_ONE_LAUNCH && IN(k) && IN((k) + 1)) { xcd_barrier(bar); AMP_HOOK(k); } } while (0)
#define ROT(n) ((K.bx + (n)) % K.G)

template <int L, int BASE>
__device__ __forceinline__ void common_layer(const Ctx& C, const Args& args, const KS& K, const XcdBarrier& bar) {
    unsigned char* ws = K.ws; LAS unsigned char* ring = C.lds + RING_OFF; const int G = K.G;
    u64* SS = (u64*)(ws + WS_SS); float* xf = K.out; bf16* XB = (bf16*)(ws + WS_XB);
    if (IN(BASE + 0)) {
        Gemm g{XB, (const bf16*)(ws + WS_WQK + (size_t)L * 2 * 1048576 * 2), 1024, 1024, 1024};
        pg8::Sched<DecGridB> S{256, G, K.bx, DecGridB{DecGrid{64, 4, 0u, 262144u, 0u, 0u, 0u, 262144u}}};
        EpiSoftmaxR E{SS + (size_t)(3 * L + 1) * MT, (bf16*)(ws + WS_PX), (LAS float*)(C.lds + EPIX_OFF)};
        pg8::gemm_phase<EpiSoftmaxR, pg8::Sched<DecGridB>>(ring, g, S, E, C.wave);
        if constexpr (L == 0) s_xq(C, ws, 0);
        else if constexpr (L == 1) s_swa(C, args, ws);
        else if constexpr (L == 2) conv_mix_sample(C, args, ws);
        else pool_mix_sample(C, args, ws);
    }
    SEAM(BASE + 0);
    if (IN(BASE + 1)) {
        Gemm g{(const bf16*)(ws + WS_PX), (const bf16*)(ws + WS_VWO + (size_t)L * 2 * 1048576 * 2), 1024, 1024, 1024};
        pg8::Sched<DecGridB> S{256, G, K.bx, DecGridB{DecGrid{64, 4, 0u, 262144u, 0u, 0u, 0u, 262144u}}};
        EpiResidual E{nullptr, nullptr, XB, SS + (size_t)(3 * L + 2) * MT};
        pg8::gemm_phase<EpiResidual, pg8::Sched<DecGridB>>(ring, g, S, E, C.wave);
        if constexpr (L == 1) s_out1(C, ws); else if constexpr (L == 2) s_out2(C, ws); else if constexpr (L == 3) s_out3(C, ws);
    }
    SEAM(BASE + 1);
    if constexpr (L >= 1) {
        if (IN(BASE + 3)) s_xq(C, ws, L);
        SEAM(BASE + 3);
    }
    if (IN(BASE + 4)) {
        Gemm g{XB, (const bf16*)(ws + W_FIN + (size_t)L * 1024 * 5632 * 2), 1024, 1024, 1024};
        const bool six = (G == 256) && K.bx < 128; const int sl = K.bx & 1;
        const XsSide<L> side = (G == 256) ? (six ? XsSide<L>{C, ws, K.bx, 1, 1 + 2 * sl, -1, -1} : XsSide<L>{C, ws, 128 + 3 * (K.bx - 128), 3, sl, 2 + sl, 4})
                                           : XsSide<L>{C, ws, 0, 0, -1, -1, -1};
        pg8::Sched<DecGrid, XsSide<L>> S{64 * 22, G, K.bx, DecGrid{64, 22, 0u, 262144u, 0u, 0u, 0u, 262144u}, side};
        EpiSwiGLU E{SS + (size_t)(3 * L + 2) * MT, (bf16*)(ws + WS_HF)};
        pg8::gemm_phase<EpiSwiGLU, pg8::Sched<DecGrid, XsSide<L>>>(ring, g, S, E, C.wave);
        if (G != 256) for (int un = C.vcu; un < 512; un += G) S.side.run(un);
    }
    SEAM(BASE + 4);
    if (IN(BASE + 5)) {
        Gemm g{(const bf16*)(ws + WS_HF), (const bf16*)(ws + W_FOUT + (size_t)L * 2816 * 1024 * 2), DFF, DFF, DFF};
        pg8::Sched<DecGrid> S{256, G, K.bx, DecGrid{64, 4, 0u, 256u * DFF, 0u, 0u, 0u, 256u * DFF}};
        if constexpr (L == 3) {
            if (G == 256) {
                EpiResFinal E{XB, SS + (size_t)12 * MT, KIN(I_FNG), xf, (unsigned*)(ws + WS_PC), (unsigned*)(ws + WS_CTL) + 4096};
                pg8::gemm_phase<EpiResFinal, pg8::Sched<DecGrid>>(ring, g, S, E, C.wave);
            } else {
                EpiResidual E{nullptr, nullptr, XB, SS + (size_t)12 * MT};
                pg8::gemm_phase<EpiResidual, pg8::Sched<DecGrid>>(ring, g, S, E, C.wave);
            }
        } else {
            EpiResidual E{nullptr, nullptr, XB, SS + (size_t)(3 * L + 3) * MT};
            pg8::gemm_phase<EpiResidual, pg8::Sched<DecGrid>>(ring, g, S, E, C.wave);
        }
        s_xo(C, ws, L);
    }
    SEAM(BASE + 5);
}

__global__ void __launch_bounds__(512, 2) hybrid_fwd(Args args) {
    extern __shared__ __attribute__((aligned(16))) unsigned char lds_raw[];
    Ctx C; C.lds = (LAS unsigned char*)lds_raw; C.wave = __builtin_amdgcn_readfirstlane((int)threadIdx.x >> 6);
    C.G = gridDim.x; { const int bx = blockIdx.x; C.vcu = (C.G % 8 == 0) ? (bx % 8) * (C.G / 8) + bx / 8 : bx; }
    unsigned char* ws = args.ws;
    volatile LAS unsigned* MISC = (volatile LAS unsigned*)(C.lds + MISC_OFF);
    for (int u = threadIdx.x; u < (LDS_BYTES - LDSCTL_OFF) / 4; u += 512) ((LAS unsigned*)(C.lds + LDSCTL_OFF))[u] = 0u;
    __syncthreads();
    XcdBarrier bar; bar.bar = (unsigned*)(ws + WS_CTL) + 4096; bar.x = 0; bar.st = nullptr;
    if (MK_ONE_LAUNCH) bar = xcd_barrier_post((unsigned*)(ws + WS_CTL) + 4096, MISC + 8);
    if (AMP_MASK != 0ull && threadIdx.x == 0) *(LAS unsigned long long*)(C.lds + MISC_OFF + 64) = __builtin_amdgcn_s_memrealtime();
    KS K; K.ws = ws; K.out = args.out; K.lo = args.ph_lo; K.hi = args.ph_hi; K.G = C.G; K.bx = (int)blockIdx.x;
    const int G = C.G;
#define SS ((u64*)(ws + WS_SS))
#define ST ((u64*)(ws + WS_ST))
#define XB ((bf16*)(ws + WS_XB))
#define ring (C.lds + RING_OFF)
    const int NGT = G * 512;

    if (IN(PH_PRO)) {
        if (DBG_LAST < 1000) { const int gt0 = C.vcu * 512 + otid(); GAS u32x4* o4 = (GAS u32x4*)args.out; for (size_t e = gt0; e < O_END / 4; e += (size_t)NGT) o4[e] = (u32x4){0u, 0u, 0u, 0u}; }
        p0_prologue(C, args); }
    SEAM(PH_PRO);
    if (IN(PH_SIN0)) { s_in0(C, ws); }
    SEAM(PH_SIN0);

    if (IN(PH_R_IN)) {
        {
            Gemm g{XB, (const bf16*)(ws + W_RET_IN), 1024, 1024, 1024};
            pg8::Sched<DecGrid, RetSide> S{1024, G, K.bx, DecGrid{64, 16, 0u, 262144u, 0u, 0u, 0u, 262144u}, RetSide{C, ws, args.out, K.bx & 3, C.vcu}};
            EpiRetIn E{SS, (const float*)(ws + T_CR), (const float*)(ws + T_SR), (bf16*)(ws + WS_Q), (bf16*)(ws + WS_KB), (bf16*)(ws + WS_APQ), (bf16*)(ws + WS_G), (float*)(ws + WS_SQ)};
            pg8::gemm_phase<EpiRetIn, pg8::Sched<DecGrid, RetSide>>(ring, g, S, E, C.wave);
        }
        {
            Gemm g{(const bf16*)(ws + W_RET_IN), XB, 1024, 1024, 1024};
            pg8::Sched<DecGrid> S{256, G, K.bx, DecGrid{4, 64, 1024u * 1024u, 262144u, 0u, 0u, 0u, 262144u}};
            EpiRetKT E{SS, (const float*)(ws + T_CRT), (const float*)(ws + T_SRT), (bf16*)(ws + WS_KT)};
            pg8::gemm_phase<EpiRetKT, pg8::Sched<DecGrid>>(ring, g, S, E, C.wave);
        }
        {
            Gemm g{(const bf16*)(ws + W_RET_IN), XB, 1024, 1024, 1024};
            pg8::Sched<DecGrid, RetSide> S{512, G, K.bx, DecGrid{8, 64, 4096u * 1024u, 262144u, 0u, 0u, 0u, 262144u}, RetSide{C, ws, args.out, (K.bx >> 2) & 1, C.vcu + G}};
            EpiRetVT E{SS, (bf16*)(ws + WS_VS)};
            pg8::gemm_phase<EpiRetVT, pg8::Sched<DecGrid, RetSide>>(ring, g, S, E, C.wave);
            for (int un = C.vcu + 2 * G; un < 512; un += G) s_ret(C, ws, args.out, un);
        }
    }
    SEAM(PH_R_IN);
    if (IN(PH_R_PU)) {
        {
            Gemm g{(const bf16*)(ws + WS_Q), (const bf16*)(ws + WS_KB), 1024, 1024, 256};
            pg8::Sched<DecGrid> S{256, G, K.bx, DecGrid{64, 4, 0u, 262144u, 256u, 0u, 262144u, 256u}};
            EpiP E{(bf16*)(ws + WS_APQ)};
            pg8::gemm_phase<EpiP, pg8::Sched<DecGrid>>(ring, g, S, E, C.wave);
        }
        {
            Gemm g{(const bf16*)(ws + WS_VS), (const bf16*)(ws + WS_KT), 512, 512, 256};
            pg8::Sched<DecU> S{512, G, K.bx, DecU{}};
            EpiU E{(bf16*)(ws + WS_U)};
            pg8::gemm_phase<EpiU, pg8::Sched<DecU>>(ring, g, S, E, C.wave);
        }
    }
    SEAM(PH_R_PU);
    if (IN(PH_R_SCAN)) {
        if (K.bx < 64 && G > 64) {
        {
            Gemm g{(const bf16*)(ws + WS_MEMN), (const bf16*)(ws + W_XKV), 1024, 1024, 1024};
            pg8::Sched<DecMem> S{64, G, K.bx, DecMem{}};
            EpiMemKV E{args.out, (bf16*)(ws + WS_MK), (bf16*)(ws + WS_MV)};
            pg8::gemm_phase<EpiMemKV, pg8::Sched<DecMem>>(ring, g, S, E, C.wave);
        }
        pool_state_copy(C, 2 * K.bx, KIN(I_SPOOL), args.out); pool_state_copy(C, 2 * K.bx + 1, KIN(I_SPOOL), args.out);
        } else {
        const bf16* U = (const bf16*)(ws + WS_U); bf16* VS = (bf16*)(ws + WS_VS); const int nsc = (G > 64) ? G - 64 : G, gt = ((G > 64) ? K.bx - 64 : K.bx) * 512 + otid(), NGT2 = nsc * 512;
        for (int item = gt; item < 131072; item += NGT2) { const int d8 = item & 31, v = (item >> 5) & 511, bh = item >> 14, h = bh & 3;
            const float gC = __builtin_amdgcn_exp2f(256.f * lg2g(h)); f32x4 s0 = (f32x4){0.f, 0.f, 0.f, 0.f}, s1 = s0;
            for (int c0 = 0; c0 < 32; c0 += 8) { u32x4 uu[8];
#pragma unroll
                for (int k = 0; k < 8; ++k) uu[k] = *(const u32x4*)(U + ((size_t)(bh * 32 + c0 + k) * 512 + v) * 256 + 8 * d8);
#pragma unroll
                for (int k = 0; k < 8; ++k) { *(u32x4*)(VS + ((size_t)(bh * 32 + c0 + k) * 512 + v) * 512 + 256 + 8 * d8) = pack8(s0, s1);
                    s0 = s0 * gC + (f32x4){bflo(uu[k].x), bfhi(uu[k].x), bflo(uu[k].y), bfhi(uu[k].y)}; s1 = s1 * gC + (f32x4){bflo(uu[k].z), bfhi(uu[k].z), bflo(uu[k].w), bfhi(uu[k].w)}; } }
#pragma unroll
            for (int e = 0; e < 4; ++e) { args.out[O_RETP + ((size_t)bh * 256 + 8 * d8 + e) * 512 + v] = s0[e]; args.out[O_RETP + ((size_t)bh * 256 + 8 * d8 + 4 + e) * 512 + v] = s1[e]; } }
        if (G <= 64) for (int b = K.bx; b < 128; b += G) pool_state_copy(C, b, KIN(I_SPOOL), args.out);
        }
    }
    SEAM(PH_R_SCAN);
    if (IN(PH_R_O)) {
        Gemm g{(const bf16*)(ws + WS_APQ), (const bf16*)(ws + WS_VS), 512, 512, 512};
        pg8::Sched<DecO> S{512, G, K.bx, DecO{}};
        if (G == 256) {
            EpiONorm E{(const bf16*)(ws + WS_G), (bf16*)(ws + WS_UB), ST, (unsigned*)(ws + WS_PC2), (unsigned*)(ws + WS_CTL) + 4096};
            pg8::gemm_phase<EpiONorm, pg8::Sched<DecO>>(ring, g, S, E, C.wave);
        } else {
            EpiO E{(bf16*)(ws + WS_O), ST};
            pg8::gemm_phase<EpiO, pg8::Sched<DecO>>(ring, g, S, E, C.wave);
        }
        {
            Gemm g2{(const bf16*)ws, (const bf16*)ws, 1024, 1024, 256};
            pg8::Sched<DecAbs> S2{256, G, K.bx, DecAbs{}};
            EpiAbs E2{(bf16*)(ws + WS_WQK)};
            pg8::gemm_phase<EpiAbs, pg8::Sched<DecAbs>>(ring, g2, S2, E2, C.wave);
        }
    }
    if (G != 256) SEAM(PH_R_O);
    if (IN(PH_R_NORM) && G != 256) {
        const bf16* O = (const bf16*)(ws + WS_O); const bf16* Gt = (const bf16*)(ws + WS_G); bf16* UB = (bf16*)(ws + WS_UB); const int lane_ = otid() & 63;
        const int gw = C.vcu * 8 + C.wave, NGW = G * 8;
        for (int row = gw; row < MP; row += NGW) { u32x4 ov[4], gv[4]; u64 st[8];
#pragma unroll
            for (int h = 0; h < 4; ++h) { const size_t o = (size_t)row * 2048 + h * 512 + 8 * lane_; ov[h] = *(const u32x4*)(O + o); gv[h] = *(const u32x4*)(Gt + o); st[2 * h] = ST[(size_t)row * 8 + 2 * h]; st[2 * h + 1] = ST[(size_t)row * 8 + 2 * h + 1]; }
#pragma unroll
            for (int h = 0; h < 4; ++h) { const float mu = from_fx(st[2 * h]) * (1.f / 512.f); const float var = fmaxf(from_fx(st[2 * h + 1]) * (1.f / 512.f) - mu * mu, 0.f);
                const float rstd = __builtin_amdgcn_rsqf(var + EPS); u32x4 r;
#pragma unroll
                for (int k = 0; k < 4; ++k) r[k] = cvt_pk_bf16(bflo(gv[h][k]) * (bflo(ov[h][k]) - mu) * rstd, bfhi(gv[h][k]) * (bfhi(ov[h][k]) - mu) * rstd);
                *(u32x4*)(UB + (size_t)row * 2048 + h * 512 + 8 * lane_) = r; } }
    }
    SEAM(PH_R_NORM);
    if (IN(PH_R_OUT)) {
        Gemm g{(const bf16*)(ws + WS_UB), (const bf16*)(ws + W_RET_OUT), 2048, 2048, 2048};
        pg8::Sched<DecGrid> S{256, G, K.bx, DecGrid{64, 4, 0u, 256u * 2048u, 0u, 0u, 0u, 256u * 2048u}};
        EpiResidual E{nullptr, nullptr, XB, SS + (size_t)1 * MT};
        pg8::gemm_phase<EpiResidual, pg8::Sched<DecGrid>>(ring, g, S, E, C.wave);
        s_out0(C, args, ws);
    }
    SEAM(PH_R_OUT);
    common_layer<0, PH_C0>(C, args, K, bar);

    if (IN(PH_S_QKV)) {
        {
            Gemm g{XB, (const bf16*)(ws + W_SWA_QKV), 1024, 1024, 1024};
            pg8::Sched<DecGrid> S{384, G, K.bx, DecGrid{64, 6, 0u, 262144u, 0u, 0u, 0u, 262144u}};
            EpiSwaQKV E{SS + (size_t)3 * MT, (const float*)(ws + T_CS), (const float*)(ws + T_SN), (bf16*)(ws + WS_Q), (bf16*)(ws + WS_KB), (float*)(ws + WS_SQ), args.out};
            pg8::gemm_phase<EpiSwaQKV, pg8::Sched<DecGrid>>(ring, g, S, E, C.wave);
        }
        {
            Gemm g{(const bf16*)(ws + W_SWA_QKV), XB, 1024, 1024, 1024};
            pg8::Sched<DecGrid> S{64, G, ROT(128), DecGrid{1, 64, 1280u * 1024u, 0u, 0u, 0u, 0u, 262144u}};
            EpiSwaVT E{SS + (size_t)3 * MT, (bf16*)(ws + WS_KT)};
            pg8::gemm_phase<EpiSwaVT, pg8::Sched<DecGrid>>(ring, g, S, E, C.wave);
        }
        if (G == 256) { if (K.bx >= 192) { swa_state_copy(C, (K.bx - 192) * 2, KIN(I_CSK), KIN(I_CSV), args.out); swa_state_copy(C, (K.bx - 192) * 2 + 1, KIN(I_CSK), KIN(I_CSV), args.out); } }
        else for (int b = C.vcu; b < 128; b += G) swa_state_copy(C, b, KIN(I_CSK), KIN(I_CSV), args.out);
        s_fin(C, ws, 0);
    }
    SEAM(PH_S_QKV);
    if (IN(PH_S_ATT)) {
        for (int un = C.vcu; un < 512; un += G) swa_unit(C, un, (const bf16*)(ws + WS_Q), (const bf16*)(ws + WS_KB), (const bf16*)(ws + WS_KT), KIN(I_SINK), (bf16*)(ws + WS_OX));
        s_fout(C, ws, 0);
    }
    SEAM(PH_S_ATT);
    if (IN(PH_S_OUT)) {
        Gemm g{(const bf16*)(ws + WS_OX), (const bf16*)(ws + W_SWA_O), 1024, 1024, 1024};
        pg8::Sched<DecGrid> S{256, G, K.bx, DecGrid{64, 4, 0u, 262144u, 0u, 0u, 0u, 262144u}};
        EpiResidual E{nullptr, nullptr, XB, SS + (size_t)4 * MT};
        pg8::gemm_phase<EpiResidual, pg8::Sched<DecGrid>>(ring, g, S, E, C.wave);
        s_in1(C, args, ws);
    }
    SEAM(PH_S_OUT);
    common_layer<1, PH_C1>(C, args, K, bar);

    if (IN(PH_V_IN)) {
        Gemm g{XB, (const bf16*)(ws + W_CONV_IN), 1024, 1024, 1024};
        pg8::Sched<DecGrid> S{768, G, K.bx, DecGrid{64, 12, 0u, 262144u, 0u, 0u, 0u, 262144u}};
        EpiConvIn E{SS + (size_t)6 * MT, (bf16*)(ws + WS_Q), (bf16*)(ws + WS_KB), args.out};
        pg8::gemm_phase<EpiConvIn, pg8::Sched<DecGrid>>(ring, g, S, E, C.wave);
        s_fin(C, ws, 1);
    }
    SEAM(PH_V_IN);
    if (IN(PH_V_MIX)) { conv_mix_runs(C, ws); s_fout(C, ws, 1); }
    SEAM(PH_V_MIX);
    if (IN(PH_V_OUT)) {
        Gemm g{(const bf16*)(ws + WS_UB), (const bf16*)(ws + W_CONV_OUT), 1024, 1024, 1024};
        pg8::Sched<DecGrid> S{256, G, K.bx, DecGrid{64, 4, 0u, 262144u, 0u, 0u, 0u, 262144u}};
        EpiResidual E{nullptr, nullptr, XB, SS + (size_t)7 * MT};
        pg8::gemm_phase<EpiResidual, pg8::Sched<DecGrid>>(ring, g, S, E, C.wave);
        s_in2(C, args, ws);
    }
    SEAM(PH_V_OUT);
    common_layer<2, PH_C2>(C, args, K, bar);

    if (IN(PH_P_MIX)) { pool_mix_runs(C, ws, args.out); s_fin(C, ws, 2); }
    SEAM(PH_P_MIX);
    if (IN(PH_P_OUT)) {
        Gemm g{(const bf16*)(ws + WS_UB), (const bf16*)(ws + W_POOL), 1024, 256, 256};
        pg8::Sched<DecGrid> S{256, G, K.bx, DecGrid{64, 4, 0u, 262144u, 256u, 0u, 0u, 65536u}};
        EpiResidual E{nullptr, nullptr, XB, SS + (size_t)10 * MT};
        pg8::gemm_phase<EpiResidual, pg8::Sched<DecGrid>>(ring, g, S, E, C.wave);
        s_fout(C, ws, 2);
    }
    SEAM(PH_P_OUT);
    common_layer<3, PH_C3>(C, args, K, bar);

    if (IN(PH_E1)) { if (G != 256) final_rows(C, args, ws, 0, MP); s_fin(C, ws, 3); }
    SEAM(PH_E1);
    if (IN(PH_E2)) { s_fout(C, ws, 3); }
    SEAM(PH_E2);
    if (IN(PH_FINAL)) {
        final_rows(C, args, ws, MP, MREAL);
        if (AMP_MASK != 0ull && MK_ONE_LAUNCH) { xcd_barrier(bar); AMP_HOOK(PH_FINAL); }
    }
}
#undef IN
#undef SEAM

extern "C" void kernel_launch(void* const* d_in, const int* in_sizes, int n_in, void* d_out, int out_size, void* d_ws, size_t ws_size, hipStream_t stream) {
    static int grid = 0;
    if (grid == 0) {
        if (n_in != 28 || (size_t)out_size != O_END || ws_size < WS_END) { fprintf(stderr, "kernel_launch: unexpected shapes (n_in %d out %d ws %zu need %zu)\n", n_in, out_size, ws_size, (size_t)WS_END); grid = -1; return; }
        int dev = 0, cus = 0, per_cu = 0;
        if (hipGetDevice(&dev) != hipSuccess || hipDeviceGetAttribute(&cus, hipDeviceAttributeMultiprocessorCount, dev) != hipSuccess) { grid = -1; return; }
        if (hipFuncSetAttribute((const void*)hybrid_fwd, hipFuncAttributeMaxDynamicSharedMemorySize, LDS_BYTES) != hipSuccess) { fprintf(stderr, "kernel_launch: hipFuncSetAttribute failed\n"); grid = -1; return; }
        if (hipOccupancyMaxActiveBlocksPerMultiprocessor(&per_cu, (const void*)hybrid_fwd, 512, LDS_BYTES) != hipSuccess || per_cu < 1) fprintf(stderr, "kernel_launch: occupancy query reports %d\n", per_cu);
        (void)hipGetLastError();
        grid = cus;
    }
    if (grid < 0) return;
    if (hipMemsetAsync((char*)d_ws, 0, 65536, stream) != hipSuccess) { fprintf(stderr, "kernel_launch: memset failed\n"); return; }
    Args a{};
    for (int i = 0; i < 28; ++i) a.in[i] = (const float*)d_in[i];
    a.out = (float*)d_out; a.ws = (unsigned char*)d_ws;
#if MK_ONE_LAUNCH
    a.ph_lo = 0; a.ph_hi = (DBG_LAST < 1000) ? DBG_LAST + 1 : NPH;
    hipLaunchKernelGGL(hybrid_fwd, dim3(grid), dim3(512), LDS_BYTES, stream, a);
#else
    for (int p = 0; p < NPH; ++p) { a.ph_lo = p; a.ph_hi = p + 1; hipLaunchKernelGGL(hybrid_fwd, dim3(grid), dim3(512), LDS_BYTES, stream, a); }
#endif
    const hipError_t le = hipPeekAtLastError();
    if (le != hipSuccess) fprintf(stderr, "kernel_launch: launch failed: %s\n", hipGetErrorName(le));
}
```
